# Optimizing an MI355X kernel written in HIP

```python
import math
import jax, jax.numpy as jnp
from jax import lax
import numpy as np


D_MODEL = 1024
BATCH = 4
SEQ = 4096
DEPTH = 4

D_MIX = D_MODEL
S5_WIDTH = D_MIX // 4
S5_GROUP = 16
S5_GROUPS = S5_WIDTH // S5_GROUP
S5_STATE = 64
RWKV_HEAD = 64
RWKV_WIDTH = 3 * D_MIX // 8
RWKV_HEADS = RWKV_WIDTH // RWKV_HEAD
RWKV_DECAY_RANK = 64
RWKV_A_RANK = 64
RWKV_GATE_RANK = 128
RWKV_GN_EPS = 64e-5
NA_HEAD = 64
NA_WIDTH = D_MIX - S5_WIDTH - RWKV_WIDTH
NA_HEADS = NA_WIDTH // NA_HEAD
GRID_W = 64
NA_KH = 8
NA_KW = 16
NA_QB = 16
NA_KB = NA_QB + NA_KW
IN_COLS = S5_WIDTH + 4 * RWKV_WIDTH + 3 * NA_WIDTH
N_EXPERTS = 32
TOP_K = 4
D_FF = D_MODEL
SWIGLU_ALPHA = 1.702
SWIGLU_LIMIT = 7.0
MOE_BLOCK = 256
RMS_EPS = 1e-6

kernel_name = 'hybrid_s5_rwkv7_natten_moe_encoder'


def rms_norm(x, g):
    xf = x.astype(jnp.float32)
    y = xf * lax.rsqrt(jnp.mean(xf * xf, axis=-1, keepdims=True) + RMS_EPS)
    return (y * g.astype(jnp.float32)).astype(x.dtype)


def modulate(h, shift, scale):
    return h * (1.0 + scale[:, None, :]) + shift[:, None, :]


def _ssm_combine(e1, e2):
    a1, b1 = e1
    a2, b2 = e2
    return a1 * a2, a2 * b1 + b2


def s5_mixer(u, lam_re, lam_im, log_dt, b_re, b_im, c_re, c_im, d_skip, glu_w):
    bsz, seq, _ = u.shape
    f32 = jnp.float32
    ug = u.astype(f32).reshape(bsz, seq, S5_GROUPS, S5_GROUP)
    y = d_skip.astype(f32) * ug
    for direction in range(2):
        lam = lax.complex(lam_re[direction].astype(f32), lam_im[direction].astype(f32))
        dt = jnp.exp(log_dt[direction].astype(f32))[:, None]
        lam_bar = jnp.exp(lam * dt)
        b_mat = lax.complex(b_re[direction].astype(f32), b_im[direction].astype(f32))
        b_bar = ((lam_bar - 1.0) / lam)[..., None] * b_mat
        bu = jnp.einsum('gph,bsgh->bsgp', b_bar, ug.astype(b_bar.dtype))
        a = jnp.broadcast_to(lam_bar, bu.shape)
        _, states = lax.associative_scan(_ssm_combine, (a, bu), axis=1, reverse=(direction == 1))
        c_mat = lax.complex(c_re[direction].astype(f32), c_im[direction].astype(f32))
        y = y + jnp.real(jnp.einsum('ghp,bsgp->bsgh', c_mat, states))
    y = jax.nn.gelu(y.reshape(bsz, seq, S5_WIDTH))
    out = y * jax.nn.sigmoid(y @ glu_w.astype(f32))
    return out.astype(u.dtype)


def centred_shift(t):
    prev = jnp.pad(t[:, :-1], ((0, 0), (1, 0), (0, 0)))
    nxt = jnp.pad(t[:, 1:], ((0, 0), (0, 1), (0, 0)))
    return 0.5 * (prev + nxt)


def wkv7_scan(r, w, k, v, a, b, reverse):
    def step(state, inp):
        rt, wt, kt, vt, at, bt = inp
        sa = jnp.einsum('bhij,bhj->bhi', state, at)
        state = state * wt[:, :, None, :] + sa[..., None] * bt[:, :, None, :] + vt[..., None] * kt[:, :, None, :]
        return state, jnp.einsum('bhij,bhj->bhi', state, rt)
    s0 = jnp.zeros(r.shape[1:] + (r.shape[-1],), jnp.float32)
    _, y = lax.scan(step, s0, (r, w, k, v, a, b), reverse=reverse)
    return y


def rwkv7_mixer(xr, mu, w0, w1, w2, a0, a1, a2, g1, g2, k_k, k_a, r_k, ln_w, ln_b):
    bsz, seq, _ = xr.shape
    f32 = jnp.float32
    xf = xr.astype(f32)
    xs = xf + (centred_shift(xf) - xf) * mu.astype(f32)
    r, k, v, z = jnp.split(xs, 4, axis=-1)
    heads = lambda t: t.reshape(bsz, seq, RWKV_HEADS, RWKV_HEAD)
    tmaj = lambda t: jnp.moveaxis(heads(t), 1, 0)
    gate = jax.nn.sigmoid(z @ g1.astype(f32)) @ g2.astype(f32)
    kk = heads(k * k_k.astype(f32))
    kk = (kk / jnp.maximum(jnp.linalg.norm(kk, axis=-1, keepdims=True), 1e-12)).reshape(bsz, seq, RWKV_WIDTH)
    y = 0.0
    for direction in range(2):
        w = -jax.nn.softplus(-(w0[direction].astype(f32) + jnp.tanh(z @ w1[direction].astype(f32)) @ w2[direction].astype(f32))) - 0.5
        decay = jnp.exp(-jnp.exp(w))
        a = jax.nn.sigmoid(a0[direction].astype(f32) + (z @ a1[direction].astype(f32)) @ a2[direction].astype(f32))
        k_dir = k * (1.0 + (a - 1.0) * k_a.astype(f32))
        y = y + wkv7_scan(tmaj(r), tmaj(decay), tmaj(k_dir), tmaj(v), tmaj(-kk), tmaj(kk * a), direction == 1)
    y = jnp.moveaxis(y, 0, 1)
    mean = jnp.mean(y, axis=-1, keepdims=True)
    var = jnp.mean(jnp.square(y - mean), axis=-1, keepdims=True)
    y = ((y - mean) * lax.rsqrt(var + RWKV_GN_EPS)).reshape(bsz, seq, RWKV_WIDTH)
    y = y * ln_w.astype(f32) + ln_b.astype(f32)
    bonus = jnp.sum(heads(r) * heads(k) * r_k.astype(f32), axis=-1, keepdims=True) * heads(v)
    out = (y + bonus.reshape(bsz, seq, RWKV_WIDTH)) * gate
    return out.astype(xr.dtype)


def na_mixer(q, k, v, q_g, k_g, rpb):
    bsz, seq, _ = q.shape
    rows = seq // GRID_W
    kh = min(NA_KH, rows)
    n_qb = GRID_W // NA_QB
    f32 = jnp.float32
    split_h = lambda t: t.reshape(bsz, seq, NA_HEADS, NA_HEAD)
    to_grid = lambda t: jnp.transpose(t.reshape(bsz, rows, GRID_W, NA_HEADS, NA_HEAD), (0, 3, 1, 2, 4))
    qg = to_grid(rms_norm(split_h(q), q_g).astype(f32) * (NA_HEAD ** -0.5))
    kg = to_grid(rms_norm(split_h(k), k_g).astype(f32))
    vg = to_grid(v.astype(f32))
    q_col = np.arange(GRID_W).reshape(n_qb, NA_QB)
    c_start = np.clip(q_col - NA_KW // 2, 0, GRID_W - NA_KW)
    kb0 = np.clip(q_col[:, 0] - NA_KW // 2, 0, GRID_W - NA_KB)
    k_col = kb0[:, None] + np.arange(NA_KB)
    kc = k_col[:, None, :]
    col_valid = (kc >= c_start[..., None]) & (kc < c_start[..., None] + NA_KW)
    dx_idx = np.clip(kc - q_col[..., None] + NA_KW - 1, 0, 2 * NA_KW - 2)
    rpb_cols = rpb.astype(f32)[:, :, dx_idx]
    valid = jnp.asarray(col_valid[:, :, None, :])

    def row_block(r):
        rs = jnp.clip(r - kh // 2, 0, rows - kh)
        q_row = lax.dynamic_index_in_dim(qg, r, axis=2, keepdims=False).reshape(bsz, NA_HEADS, n_qb, NA_QB, NA_HEAD)
        k_blk = lax.dynamic_slice_in_dim(kg, rs, kh, axis=2)[:, :, :, k_col]
        v_blk = lax.dynamic_slice_in_dim(vg, rs, kh, axis=2)[:, :, :, k_col]
        dy_idx = rs + jnp.arange(kh) - r + NA_KH - 1
        bias = jnp.transpose(rpb_cols[:, dy_idx], (0, 2, 3, 1, 4))
        s = jnp.einsum('bhnqd,bhynkd->bhnqyk', q_row, k_blk) + bias
        s = jnp.where(valid, s, -jnp.inf)
        p = jax.nn.softmax(s.reshape(s.shape[:4] + (kh * NA_KB,)), axis=-1).reshape(s.shape)
        o = jnp.einsum('bhnqyk,bhynkd->bhnqd', p, v_blk)
        return o.reshape(bsz, NA_HEADS, GRID_W, NA_HEAD)

    out = lax.map(row_block, jnp.arange(rows))
    out = jnp.transpose(out, (1, 0, 3, 2, 4)).reshape(bsz, seq, NA_WIDTH)
    return out.astype(q.dtype)


def clamped_swiglu(hdn):
    glu, lin = hdn[..., ::2], hdn[..., 1::2]
    glu = jnp.minimum(glu, SWIGLU_LIMIT)
    lin = jnp.clip(lin, -SWIGLU_LIMIT, SWIGLU_LIMIT)
    return glu * jax.nn.sigmoid(SWIGLU_ALPHA * glu) * (lin + 1.0)


def moe_ffn(h, router_w, router_b, w1, b1, w2, b2):
    bsz, seq, d = h.shape
    tokens = h.reshape(-1, d)
    n_tok = tokens.shape[0]
    logits = (tokens @ router_w + router_b).astype(jnp.float32)
    top_val, top_idx = lax.top_k(logits, TOP_K)
    gates = jax.nn.softmax(top_val, axis=-1)
    n_assign = n_tok * TOP_K
    n_blocks = -(-n_assign // MOE_BLOCK) + N_EXPERTS
    n_rows = n_blocks * MOE_BLOCK
    expert_flat = top_idx.reshape(-1)
    token_flat = jnp.repeat(jnp.arange(n_tok, dtype=jnp.int32), TOP_K)
    gate_flat = gates.reshape(-1)
    order = jnp.argsort(expert_flat)
    sorted_e = expert_flat[order]
    counts = jnp.bincount(expert_flat, length=N_EXPERTS)
    padded = ((counts + MOE_BLOCK - 1) // MOE_BLOCK) * MOE_BLOCK
    pad_end = jnp.cumsum(padded)
    pad_start = pad_end - padded
    start = jnp.cumsum(counts) - counts
    dest = pad_start[sorted_e] + (jnp.arange(n_assign) - start[sorted_e])
    row_tok = jnp.full((n_rows,), n_tok, jnp.int32).at[dest].set(token_flat[order])
    row_gate = jnp.zeros((n_rows,), jnp.float32).at[dest].set(gate_flat[order])
    block_e = jnp.minimum(jnp.searchsorted(pad_end, jnp.arange(n_blocks) * MOE_BLOCK, side='right'), N_EXPERTS - 1)
    tok_pad = jnp.concatenate([tokens, jnp.zeros((1, d), tokens.dtype)], axis=0)
    xb = tok_pad[row_tok].reshape(n_blocks, MOE_BLOCK, d)

    def expert_block(args):
        xblk, e = args
        hdn = xblk @ w1[e] + b1[e]
        return clamped_swiglu(hdn) @ w2[e] + b2[e]

    yb = lax.map(expert_block, (xb, block_e)).reshape(n_rows, d)
    yb = yb * row_gate[:, None].astype(yb.dtype)
    out = jax.ops.segment_sum(yb, row_tok, num_segments=n_tok + 1)[:n_tok]
    return out.reshape(bsz, seq, d)


def setup_inputs(seed: int = 0) -> dict:
    key = jax.random.key(seed)
    ks = iter(jax.random.split(key, 48))
    f32 = jnp.float32
    L = DEPTH

    def nrm(shape, scale):
        return scale * jax.random.normal(next(ks), shape, f32)

    def unif(shape, lo, hi):
        return jax.random.uniform(next(ks), shape, f32, lo, hi)

    n_idx = jnp.arange(S5_STATE, dtype=f32)
    return {
        'x': nrm((BATCH, SEQ, D_MODEL), 1.0),
        'c': nrm((BATCH, D_MODEL), 1.0),
        'ada_w': nrm((L, D_MODEL, 6 * D_MODEL), 0.5 * D_MODEL ** -0.5),
        'ada_b': nrm((L, 6 * D_MODEL), 0.02),
        'norm1_g': 1.0 + nrm((L, D_MODEL), 0.02),
        'norm2_g': 1.0 + nrm((L, D_MODEL), 0.02),
        'w_in': nrm((L, D_MODEL, IN_COLS), D_MODEL ** -0.5),
        'w_out': nrm((L, D_MIX, D_MODEL), D_MIX ** -0.5),
        's5_lam_re': -0.5 + nrm((L, 2, S5_GROUPS, S5_STATE), 0.01),
        's5_lam_im': math.pi * n_idx + nrm((L, 2, S5_GROUPS, S5_STATE), 0.01),
        's5_log_dt': unif((L, 2, S5_GROUPS), math.log(1e-3), math.log(1e-1)),
        's5_b_re': nrm((L, 2, S5_GROUPS, S5_STATE, S5_GROUP), (2 * S5_GROUP) ** -0.5),
        's5_b_im': nrm((L, 2, S5_GROUPS, S5_STATE, S5_GROUP), (2 * S5_GROUP) ** -0.5),
        's5_c_re': nrm((L, 2, S5_GROUPS, S5_GROUP, S5_STATE), (2 * S5_STATE) ** -0.5),
        's5_c_im': nrm((L, 2, S5_GROUPS, S5_GROUP, S5_STATE), (2 * S5_STATE) ** -0.5),
        's5_d': nrm((L, S5_GROUPS, S5_GROUP), 1.0),
        's5_glu_w': nrm((L, S5_WIDTH, S5_WIDTH), S5_WIDTH ** -0.5),
        'rwkv_mu': unif((L, 4 * RWKV_WIDTH), 0.0, 1.0),
        'rwkv_w0': unif((L, 2, RWKV_WIDTH), -6.0, 1.0),
        'rwkv_w1': nrm((L, 2, RWKV_WIDTH, RWKV_DECAY_RANK), RWKV_WIDTH ** -0.5),
        'rwkv_w2': nrm((L, 2, RWKV_DECAY_RANK, RWKV_WIDTH), 0.1 * RWKV_DECAY_RANK ** -0.5),
        'rwkv_a0': nrm((L, 2, RWKV_WIDTH), 0.5),
        'rwkv_a1': nrm((L, 2, RWKV_WIDTH, RWKV_A_RANK), RWKV_WIDTH ** -0.5),
        'rwkv_a2': nrm((L, 2, RWKV_A_RANK, RWKV_WIDTH), 0.1 * RWKV_A_RANK ** -0.5),
        'rwkv_g1': nrm((L, RWKV_WIDTH, RWKV_GATE_RANK), RWKV_WIDTH ** -0.5),
        'rwkv_g2': nrm((L, RWKV_GATE_RANK, RWKV_WIDTH), RWKV_GATE_RANK ** -0.5),
        'rwkv_k_k': 0.85 + nrm((L, RWKV_WIDTH), 0.02),
        'rwkv_k_a': 1.0 + nrm((L, RWKV_WIDTH), 0.02),
        'rwkv_r_k': nrm((L, RWKV_HEADS, RWKV_HEAD), 0.1),
        'rwkv_ln_w': 1.0 + nrm((L, RWKV_WIDTH), 0.02),
        'rwkv_ln_b': nrm((L, RWKV_WIDTH), 0.02),
        'na_q_g': 1.0 + nrm((L, NA_HEAD), 0.02),
        'na_k_g': 1.0 + nrm((L, NA_HEAD), 0.02),
        'na_rpb': nrm((L, NA_HEADS, 2 * NA_KH - 1, 2 * NA_KW - 1), 0.1),
        'router_w': nrm((L, D_MODEL, N_EXPERTS), D_MODEL ** -0.5),
        'router_b': nrm((L, N_EXPERTS), 0.01),
        'exp_w1': nrm((L, N_EXPERTS, D_MODEL, 2 * D_FF), D_MODEL ** -0.5),
        'exp_b1': nrm((L, N_EXPERTS, 2 * D_FF), 0.02),
        'exp_w2': nrm((L, N_EXPERTS, D_FF, D_MODEL), D_FF ** -0.5),
        'exp_b2': nrm((L, N_EXPERTS, D_MODEL), 0.02),
    }


def reference(x, c, ada_w, ada_b, norm1_g, norm2_g, w_in, w_out,
              s5_lam_re, s5_lam_im, s5_log_dt, s5_b_re, s5_b_im, s5_c_re, s5_c_im, s5_d, s5_glu_w,
              rwkv_mu, rwkv_w0, rwkv_w1, rwkv_w2, rwkv_a0, rwkv_a1, rwkv_a2, rwkv_g1, rwkv_g2,
              rwkv_k_k, rwkv_k_a, rwkv_r_k, rwkv_ln_w, rwkv_ln_b,
              na_q_g, na_k_g, na_rpb,
              router_w, router_b, exp_w1, exp_b1, exp_w2, exp_b2):
    cond = jax.nn.silu(c)
    rwkv_lo = S5_WIDTH
    na_lo = S5_WIDTH + 4 * RWKV_WIDTH
    for l in range(DEPTH):
        mod = cond @ ada_w[l] + ada_b[l]
        shift_mix, scale_mix, gate_mix, shift_ffn, scale_ffn, gate_ffn = jnp.split(mod, 6, axis=-1)
        h = modulate(rms_norm(x, norm1_g[l]), shift_mix, scale_mix)
        proj = h @ w_in[l]
        q_na, k_na, v_na = jnp.split(proj[..., na_lo:], 3, axis=-1)
        mixed = jnp.concatenate([
            s5_mixer(proj[..., :rwkv_lo], s5_lam_re[l], s5_lam_im[l], s5_log_dt[l], s5_b_re[l], s5_b_im[l],
                     s5_c_re[l], s5_c_im[l], s5_d[l], s5_glu_w[l]),
            rwkv7_mixer(proj[..., rwkv_lo:na_lo], rwkv_mu[l], rwkv_w0[l], rwkv_w1[l], rwkv_w2[l], rwkv_a0[l],
                        rwkv_a1[l], rwkv_a2[l], rwkv_g1[l], rwkv_g2[l], rwkv_k_k[l], rwkv_k_a[l], rwkv_r_k[l],
                        rwkv_ln_w[l], rwkv_ln_b[l]),
            na_mixer(q_na, k_na, v_na, na_q_g[l], na_k_g[l], na_rpb[l]),
        ], axis=-1)
        x = x + gate_mix[:, None, :] * (mixed @ w_out[l])
        h = modulate(rms_norm(x, norm2_g[l]), shift_ffn, scale_ffn)
        x = x + gate_ffn[:, None, :] * moe_ffn(h, router_w[l], router_b[l], exp_w1[l], exp_b1[l], exp_w2[l], exp_b2[l])
    return x
```

```cpp
#include <hip/hip_runtime.h>
#include <cstdio>
#include <cstdint>

#define LAS __attribute__((address_space(3)))
typedef unsigned short bf16_t;
typedef short bf16x8 __attribute__((ext_vector_type(8)));
typedef short s16x4 __attribute__((ext_vector_type(4)));
typedef float f32x4 __attribute__((ext_vector_type(4)));
typedef float f32x2 __attribute__((ext_vector_type(2)));
typedef unsigned u32x4 __attribute__((ext_vector_type(4)));
typedef unsigned u32x2 __attribute__((ext_vector_type(2)));

#ifndef MK_LAUNCH_PER_PHASE
#define MK_LAUNCH_PER_PHASE 0
#endif

constexpr int T = 16384, D = 1024, NL = 4, SEQ = 4096, NE = 32, CAP = 16384;
constexpr int NPROJ = 3072;
constexpr int NTHREADS = 512;
constexpr size_t MiB = 1u << 20;
constexpr size_t O_CTL = 0, CTL_BYTES = 1 * MiB;
constexpr size_t O_MOD = 1 * MiB;
constexpr size_t O_S5M = 1 * MiB + 512 * 1024;
constexpr size_t O_WIN = 2 * MiB;
constexpr size_t O_WOUT = 26 * MiB;
constexpr size_t O_W1C = 34 * MiB;
constexpr size_t O_W2B = 36 * MiB;
constexpr size_t O_WGLU = 42 * MiB;
constexpr size_t O_WS5S = 43 * MiB;
constexpr size_t O_WS5Y = 75 * MiB;
constexpr size_t O_EW1 = 235 * MiB;
constexpr size_t O_EW2 = 747 * MiB;
constexpr size_t O_H1 = 1003 * MiB;
constexpr size_t O_PROJ = 1035 * MiB;
constexpr size_t O_ZS = 1131 * MiB;
constexpr size_t O_HID = 1143 * MiB;
constexpr size_t O_QN = 1155 * MiB;
constexpr size_t O_KN = 1167 * MiB;
constexpr size_t O_R = 1179 * MiB;
constexpr size_t O_K = 1203 * MiB;
constexpr size_t O_V = 1227 * MiB;
constexpr size_t O_A = 1251 * MiB;
constexpr size_t O_GATE = 1275 * MiB;
constexpr size_t O_DEC = 1299 * MiB;
constexpr size_t O_KD = 1347 * MiB;
constexpr size_t O_BV = 1395 * MiB;
constexpr size_t O_YS = 1443 * MiB;
constexpr size_t O_KT = O_YS + 40 * MiB;
constexpr size_t O_XR = O_YS + 8 * MiB;
constexpr size_t O_RKB = 1491 * MiB;
constexpr size_t O_AS5 = 1492 * MiB;
constexpr size_t O_SLOC = 1502 * MiB;
constexpr size_t O_YG = 1506 * MiB;
constexpr size_t O_MIX = 1514 * MiB;
constexpr size_t O_SLOT = 1546 * MiB;
constexpr size_t O_GV = 1547 * MiB;
constexpr size_t O_XS = 1548 * MiB;
constexpr size_t O_HH = 2572 * MiB;
constexpr size_t O_PHI = O_HH, O_GM = O_HH + 32 * MiB, O_PSIT = O_HH + 64 * MiB, O_YLT = O_HH + 128 * MiB, O_SB = O_HH + 192 * MiB;
constexpr size_t WS_END = 3596 * MiB;
constexpr int CW_BAR = 4096;
constexpr int CW_CNT = 8192;
constexpr int LDS_BYTES = 147456;
constexpr int LDS_MISC = 147456 - 256;
constexpr int LDS_X = 131072;

struct P { const float* in[40]; float* out; unsigned char* ws; int lo, hi; };

typedef __bf16 bf16x2_t __attribute__((ext_vector_type(2)));
__device__ __forceinline__ unsigned cvt_pk_bf16(float lo, float hi) { const f32x2 v = {lo, hi}; return __builtin_bit_cast(unsigned, __builtin_convertvector(v, bf16x2_t)); }
__device__ __forceinline__ float bf2f(bf16_t v) { return __uint_as_float(((unsigned)v) << 16); }
__device__ __forceinline__ bf16_t f2bf(float f) { unsigned u = __float_as_uint(f); u += 0x7FFFu + ((u >> 16) & 1u); return (bf16_t)(u >> 16); }
__device__ __forceinline__ float wsum(float v) {
#pragma unroll
    for (int o = 32; o > 0; o >>= 1) v += __shfl_xor(v, o);
    return v; }
__device__ __forceinline__ float wmaxf(float v) {
#pragma unroll
    for (int o = 32; o > 0; o >>= 1) v = fmaxf(v, __shfl_xor(v, o));
    return v; }
__device__ __forceinline__ int wmini(int v) {
#pragma unroll
    for (int o = 32; o > 0; o >>= 1) v = min(v, __shfl_xor(v, o));
    return v; }
__device__ __forceinline__ float frcp(float x) { return __builtin_amdgcn_rcpf(x); }
__device__ __forceinline__ float sigmoidf_(float x) { return frcp(1.0f + __expf(-x)); }
__device__ __forceinline__ float gelu_tanh(float x) { const float u = 0.7978845608f * (x + 0.044715f * x * x * x); return x * frcp(1.0f + __expf(-2.0f * u)); }

__device__ __forceinline__ f32x4 bf4_to_f32(u32x2 v) { f32x4 r; r[0] = __uint_as_float(v.x << 16); r[1] = __uint_as_float(v.x & 0xFFFF0000u); r[2] = __uint_as_float(v.y << 16); r[3] = __uint_as_float(v.y & 0xFFFF0000u); return r; }
__device__ __forceinline__ u32x2 f32_to_bf4(f32x4 v) { u32x2 w; w.x = cvt_pk_bf16(v[0], v[1]); w.y = cvt_pk_bf16(v[2], v[3]); return w; }
__device__ __forceinline__ unsigned f2h_bits(float f) { return (unsigned)__builtin_bit_cast(unsigned short, (_Float16)f); }
__device__ __forceinline__ float h2f_bits(unsigned h) { return (float)__builtin_bit_cast(_Float16, (unsigned short)h); }
__device__ __forceinline__ u32x2 f32_to_h4(f32x4 v) { u32x2 w; w.x = f2h_bits(v[0]) | (f2h_bits(v[1]) << 16); w.y = f2h_bits(v[2]) | (f2h_bits(v[3]) << 16); return w; }
__device__ __forceinline__ f32x4 h4_to_f32(u32x2 w) { f32x4 r; r[0] = h2f_bits(w.x & 0xFFFFu); r[1] = h2f_bits(w.x >> 16); r[2] = h2f_bits(w.y & 0xFFFFu); r[3] = h2f_bits(w.y >> 16); return r; }
__device__ __forceinline__ float hsum4(f32x4 v) { return (v[0] + v[1]) + (v[2] + v[3]); }
template <int CTRL> __device__ __forceinline__ float dpp_add(float v) { return v + __builtin_bit_cast(float, __builtin_amdgcn_update_dpp(0, __builtin_bit_cast(int, v), CTRL, 0xF, 0xF, true)); }
__device__ __forceinline__ float row16_sum(float v) { v = dpp_add<0xB1>(v); v = dpp_add<0x4E>(v); v = dpp_add<0x124>(v); v = dpp_add<0x128>(v); return v; }

template <int CTRL> __device__ __forceinline__ float dpp_mov(float v) { return __builtin_bit_cast(float, __builtin_amdgcn_update_dpp(0, __builtin_bit_cast(int, v), CTRL, 0xF, 0xF, true)); }
template <int CTRL> __device__ __forceinline__ int dpp_movi(int v) { return __builtin_amdgcn_update_dpp(0, v, CTRL, 0xF, 0xF, true); }
__device__ __forceinline__ void swap16(float& a, float& b) { asm volatile("s_nop 1\n\tv_permlane16_swap_b32 %0, %1\n\ts_nop 0" : "+v"(a), "+v"(b)); }
__device__ __forceinline__ void swap32(float& a, float& b) { asm volatile("s_nop 1\n\tv_permlane32_swap_b32 %0, %1\n\ts_nop 0" : "+v"(a), "+v"(b)); }
__device__ __forceinline__ float xchg16(float send, int lane) { float a = send, b = send; swap16(a, b); return (lane & 16) ? a : b; }
__device__ __forceinline__ float xchg32(float send, int lane) { float a = send, b = send; swap32(a, b); return (lane & 32) ? a : b; }
__device__ __forceinline__ float wave_sum_all(float v) { v = row16_sum(v); { float a = v, b = v; swap16(a, b); v = a + b; } { float a = v, b = v; swap32(a, b); v = a + b; } return v; }
__device__ __forceinline__ float wave_max_all(float v) { v = fmaxf(v, dpp_mov<0xB1>(v)); v = fmaxf(v, dpp_mov<0x4E>(v)); v = fmaxf(v, dpp_mov<0x124>(v)); v = fmaxf(v, dpp_mov<0x128>(v));
    { float a = v, b = v; swap16(a, b); v = fmaxf(a, b); } { float a = v, b = v; swap32(a, b); v = fmaxf(a, b); } return v; }
__device__ __forceinline__ int wave_min_all(int v) { v = min(v, dpp_movi<0xB1>(v)); v = min(v, dpp_movi<0x4E>(v)); v = min(v, dpp_movi<0x124>(v)); v = min(v, dpp_movi<0x128>(v));
    { float a = __builtin_bit_cast(float, v), b = a; swap16(a, b); v = min(__builtin_bit_cast(int, a), __builtin_bit_cast(int, b)); } { float a = __builtin_bit_cast(float, v), b = a; swap32(a, b); v = min(__builtin_bit_cast(int, a), __builtin_bit_cast(int, b)); } return v; }


#define LDS_BARRIER() do { asm volatile("s_waitcnt lgkmcnt(0)" ::: "memory"); __builtin_amdgcn_s_barrier(); asm volatile("" ::: "memory"); } while (0)

#define XB_TMO      128
#define XB_XCNT(j)  (256  + 64 * (j))
#define XB_XSUB(j)  (1280 + 64 * (j))
#define XB_XGEN(j)  (2304 + 64 * (j))
#define XB_TOP      3328
#define XB_TOPGEN   3392
#define XCD_BAR_WORDS 3456
#define XB_SPIN_CAP (1u << 22)
__device__ __forceinline__ unsigned xb_ld(unsigned* p)              { return __hip_atomic_load(p, __ATOMIC_RELAXED, __HIP_MEMORY_SCOPE_AGENT); }
__device__ __forceinline__ unsigned xb_add(unsigned* p, unsigned v) { return __hip_atomic_fetch_add(p, v, __ATOMIC_RELAXED, __HIP_MEMORY_SCOPE_AGENT); }
__device__ __forceinline__ unsigned xb_xcc_id() { return (unsigned)__builtin_amdgcn_s_getreg((3 << 11) | 20) & 0xFu; }
#define XB_SPIN(cond, bar) do { unsigned _sp = 0; while (cond) { __builtin_amdgcn_s_sleep(1); \
    if ((++_sp & 255u) == 0u) { if (xb_ld(&(bar)[XB_TMO])) break; if (_sp > XB_SPIN_CAP) { atomicAdd(&(bar)[XB_TMO], 1u); break; } } } } while (0)
struct XcdBarrier { unsigned* bar; unsigned x; volatile LAS unsigned* st; };
__device__ __forceinline__ XcdBarrier xcd_barrier_post(unsigned* bar, volatile LAS unsigned* st) {
    XcdBarrier b; b.bar = bar; b.x = xb_xcc_id(); b.st = st;
    if (threadIdx.x == 0) (void)xb_add(&bar[XB_XCNT(b.x)], 1u);
    return b;
}
__device__ __forceinline__ void xcd_barrier_complete(unsigned* bar, unsigned x, unsigned& nloc, unsigned& nx) {
    const unsigned G = gridDim.x * gridDim.y * gridDim.z;
    unsigned sum, cnt, mine, sp = 0u;
    for (;;) {
        sum = 0u; cnt = 0u; mine = 0u;
#pragma unroll
        for (unsigned j = 0; j < 16; ++j) { const unsigned c = xb_ld(&bar[XB_XCNT(j)]); sum += c; cnt += (c > 0u) ? 1u : 0u; mine = (j == x) ? c : mine; }
        if (sum == G) break;
        __builtin_amdgcn_s_sleep(1);
        if ((++sp & 255u) == 0u) { if (xb_ld(&bar[XB_TMO])) break; if (sp > XB_SPIN_CAP) { atomicAdd(&bar[XB_TMO], 1u); break; } }
    }
    nloc = mine > 0u ? mine : 1u; nx = cnt > 0u ? cnt : 1u;
}
__device__ __forceinline__ void xcd_barrier(const XcdBarrier& b) {
    asm volatile("s_waitcnt vmcnt(0)" ::: "memory");
    __syncthreads();
    if (threadIdx.x == 0) {
        unsigned* bar = b.bar;
        __builtin_amdgcn_s_waitcnt(0);
        unsigned nloc = b.st[0], nx = b.st[1];
        if (nloc == 0u) { xcd_barrier_complete(bar, b.x, nloc, nx); b.st[0] = nloc; b.st[1] = nx; }
        const unsigned old = xb_add(&bar[XB_XSUB(b.x)], 1u);
        const unsigned gen = old / nloc;
        if (old + 1u == (gen + 1u) * nloc) {
            __builtin_amdgcn_fence(__ATOMIC_RELEASE, "agent");
            asm volatile("s_waitcnt vmcnt(0)" ::: "memory");
            const unsigned og = xb_add(&bar[XB_TOP], 1u);
            const unsigned tg = og / nx;
            if (og + 1u == (tg + 1u) * nx) xb_add(&bar[XB_TOPGEN], 1u);
            else XB_SPIN(xb_ld(&bar[XB_TOPGEN]) == tg, bar);
            __builtin_amdgcn_fence(__ATOMIC_ACQUIRE, "agent");
            xb_add(&bar[XB_XGEN(b.x)], 1u);
            asm volatile("s_waitcnt vmcnt(0)" ::: "memory");
        } else {
            XB_SPIN(xb_ld(&bar[XB_XGEN(b.x)]) == gen, bar);
            __builtin_amdgcn_fence(__ATOMIC_ACQUIRE, "agent");
            asm volatile("s_waitcnt vmcnt(0)" ::: "memory");
        }
    }
    __syncthreads();
}

namespace pg8 {
constexpr int BM = 256, BK = 64, HALF = 128, HTB = HALF * BK * 2, STAGE_BYTES = 8 * HTB, NXCD = 8, WGM = 8;
__host__ __device__ __forceinline__ int lds_byte(int r, int c) { const int st = (r >> 4) * 2 + (c >> 5), rr = r & 15, cc = c & 31, ob = rr * 64 + cc * 2; return st * 1024 + (ob ^ (((ob >> 9) & 1) << 5)); }
__host__ __device__ __forceinline__ void stage_rc(int b, int& R, int& C) { const int st = b / 1024, sb = b % 1024, swz = sb ^ (((sb >> 9) & 1) << 5); R = (st >> 1) * 16 + swz / 64; C = (st & 1) * 32 + (swz % 64) / 2; }
__host__ __device__ __forceinline__ int perm32(int rho) { const int n = rho >> 4, i = rho & 15; return 8 * (i >> 2) + 4 * n + (i & 3); }

struct Unit { const char* a; const char* b; int orow, ocol, aux; };

template <class Epi, class Sched>
__device__ __forceinline__ void gemm_phase(LAS unsigned char* lds, const int K, const int lda, const int ldb, const Sched& S, const Epi& E, const int tid_in) {
    const int tid = tid_in, wid = __builtin_amdgcn_readfirstlane(tid >> 6), lane = tid & 63, wr = wid >> 2, wc = wid & 3, fr = lane & 15, fq = lane >> 4;
    const int nt = K / BK;
    constexpr bool GA = Sched::GATHER;
    unsigned voffA[2], voffB[2]; int rowA[2]; unsigned gc[2][2], gn[2][2];
#pragma unroll
    for (int i = 0; i < 2; ++i) { int R, C; stage_rc(tid * 16 + i * 8192, R, C); const int Rb = Epi::PERM ? ((R & ~31) + perm32(R & 31)) : R;
        voffA[i] = GA ? (unsigned)C * 2u : (unsigned)(R * lda + C) * 2u; voffB[i] = (unsigned)(Rb * ldb + C) * 2u; rowA[i] = R; }
#define PG8_GLOAD(g, ui_) do { if constexpr (GA) { _Pragma("unroll") for (int h_ = 0; h_ < 2; ++h_) _Pragma("unroll") for (int i_ = 0; i_ < 2; ++i_) g[h_][i_] = S.tok_off((ui_), h_ * 128 + rowA[i_]) + voffA[i_]; } } while (0)
#define PG8_STAGE_A(bufoff, base, kb, h, g) do { if constexpr (GA) { _Pragma("unroll") for (int _i = 0; _i < 2; ++_i) \
        __builtin_amdgcn_global_load_lds((const unsigned*)((const char*)(base) + (kb) + g[h][_i]), (LAS unsigned*)(lds + (bufoff) + ldsw + _i * 8192), 16, 0, 0); } \
        else PG8_STAGE(bufoff, (base) + (kb) + (h) * hstepA, voffA); } while (0)
    const size_t kstep = (size_t)(BK * 2);
    const size_t hstepA = (size_t)HALF * lda * 2, hstepB = (size_t)HALF * ldb * 2;
    const unsigned ldsw = (unsigned)wid * 1024u;
    const int aoff = lds_byte(wr * 64 + fr, fq * 8), boff = lds_byte(wc * 32 + fr, fq * 8);
#define PG8_SA(b, h) (((b) * 2 + (h)) * HTB)
#define PG8_SB(b, h) ((4 + (b) * 2 + (h)) * HTB)
#define PG8_STAGE(bufoff, gbase, voff) do { _Pragma("unroll") for (int _i = 0; _i < 2; ++_i) \
        __builtin_amdgcn_global_load_lds((const unsigned*)((const char*)(gbase) + (voff)[_i]), (LAS unsigned*)(lds + (bufoff) + ldsw + _i * 8192), 16, 0, 0); } while (0)
#define PG8_LDA(dst, b, h) do { _Pragma("unroll") for (int m = 0; m < 4; ++m) _Pragma("unroll") for (int k = 0; k < 2; ++k) dst[m][k] = *(const LAS bf16x8*)(lds + PG8_SA(b, h) + aoff + m * 2048 + k * 1024); } while (0)
#define PG8_LDB(dst, b, h) do { _Pragma("unroll") for (int n = 0; n < 2; ++n) _Pragma("unroll") for (int k = 0; k < 2; ++k) dst[n][k] = *(const LAS bf16x8*)(lds + PG8_SB(b, h) + boff + n * 2048 + k * 1024); } while (0)
#define PG8_MMA(ai, bj, At, Bt) do { __builtin_amdgcn_s_setprio(1); _Pragma("unroll") for (int m = 0; m < 4; ++m) _Pragma("unroll") for (int n = 0; n < 2; ++n) _Pragma("unroll") for (int k = 0; k < 2; ++k) \
        acc[ai][bj][m][n] = __builtin_amdgcn_mfma_f32_16x16x32_bf16(Bt[n][k], At[m][k], acc[ai][bj][m][n], 0, 0, 0); __builtin_amdgcn_s_setprio(0); } while (0)
#define PG8_WAIT_V(n) asm volatile("s_waitcnt vmcnt(" #n ")" ::: "memory")
#define PG8_WAIT_L(n) asm volatile("s_waitcnt lgkmcnt(" #n ")" ::: "memory")
#define PG8_BAR __builtin_amdgcn_s_barrier()
#define PG8_SCHED __builtin_amdgcn_sched_barrier(0)
    Unit cur, nxt; int ui = 0;
    if (!S.next(0, cur)) return;
    f32x4 acc[2][2][4][2];
#pragma unroll
    for (int a = 0; a < 2; ++a)
#pragma unroll
        for (int b = 0; b < 2; ++b)
#pragma unroll
            for (int m = 0; m < 4; ++m)
#pragma unroll
                for (int n = 0; n < 2; ++n) acc[a][b][m][n] = (f32x4){0.f, 0.f, 0.f, 0.f};
    bf16x8 At[4][2], B0[2][2], B1[2][2];
    const char* cA = cur.a; const char* cB = cur.b;
    PG8_GLOAD(gc, 0);
    PG8_STAGE(PG8_SB(0, 0), cB, voffB); PG8_STAGE(PG8_SB(0, 1), cB + hstepB, voffB); PG8_STAGE_A(PG8_SA(0, 0), cA, 0, 0, gc); PG8_STAGE_A(PG8_SA(0, 1), cA, 0, 1, gc);
    if (wr == 1) PG8_BAR;
    PG8_WAIT_V(2); PG8_BAR;
    PG8_STAGE(PG8_SB(1, 0), cB + kstep, voffB); PG8_STAGE_A(PG8_SA(1, 0), cA, kstep, 0, gc); PG8_STAGE(PG8_SB(1, 1), cB + hstepB + kstep, voffB);
    PG8_WAIT_V(6); PG8_BAR;
    for (;;) {
        const bool has_next = S.next(ui + 1, nxt);
        const char* nA = has_next ? nxt.a : cA; const char* nB = has_next ? nxt.b : cB;
        if constexpr (GA) { if (has_next) PG8_GLOAD(gn, ui + 1); else {
#pragma unroll
            for (int h_ = 0; h_ < 2; ++h_)
#pragma unroll
                for (int i_ = 0; i_ < 2; ++i_) gn[h_][i_] = gc[h_][i_]; } }
#pragma unroll 1
        for (int t = 0; t < nt; t += 2) {
            const bool last = (t == nt - 2);
            const size_t k1 = (size_t)(t + 1) * kstep, k2 = last ? (size_t)0 : (size_t)(t + 2) * kstep, k3 = k2 + kstep;
            const char* a2 = last ? nA : cA; const char* b2 = last ? nB : cB;
            unsigned g2[2][2];
#pragma unroll
            for (int h_ = 0; h_ < 2; ++h_)
#pragma unroll
                for (int i_ = 0; i_ < 2; ++i_) g2[h_][i_] = GA ? (last ? gn[h_][i_] : gc[h_][i_]) : 0u;
            PG8_LDB(B0, 0, 0); PG8_LDB(B1, 0, 1); PG8_SCHED; PG8_LDA(At, 0, 0); PG8_STAGE_A(PG8_SA(1, 1), cA, k1, 1, gc);
            PG8_WAIT_V(8); PG8_WAIT_L(0); PG8_BAR; PG8_MMA(0, 0, At, B0); PG8_MMA(0, 1, At, B1); PG8_BAR; PG8_SCHED;
            PG8_LDA(At, 0, 1); PG8_STAGE(PG8_SB(0, 0), b2 + k2, voffB); PG8_STAGE(PG8_SB(0, 1), b2 + k2 + hstepB, voffB); PG8_STAGE_A(PG8_SA(0, 0), a2, k2, 0, g2);
            PG8_WAIT_V(8); PG8_WAIT_L(0); PG8_BAR; PG8_MMA(1, 0, At, B0); PG8_MMA(1, 1, At, B1); PG8_BAR; PG8_SCHED;
            PG8_LDB(B0, 1, 0); PG8_LDB(B1, 1, 1); PG8_SCHED; PG8_LDA(At, 1, 0); PG8_STAGE_A(PG8_SA(0, 1), a2, k2, 1, g2);
            PG8_WAIT_V(8); PG8_WAIT_L(0); PG8_BAR; PG8_MMA(0, 0, At, B0); PG8_MMA(0, 1, At, B1); PG8_BAR; PG8_SCHED;
            PG8_LDA(At, 1, 1); PG8_STAGE(PG8_SB(1, 0), b2 + k3, voffB); PG8_STAGE(PG8_SB(1, 1), b2 + k3 + hstepB, voffB); PG8_STAGE_A(PG8_SA(1, 0), a2, k3, 0, g2);
            PG8_WAIT_V(8); PG8_WAIT_L(0); PG8_BAR; PG8_MMA(1, 0, At, B0); PG8_MMA(1, 1, At, B1); PG8_BAR; PG8_SCHED;
        }
        if (wr == 0) PG8_BAR;
        E(acc, cur, wr, wc, fr, fq);
        if constexpr (Epi::DRAIN) __builtin_amdgcn_s_waitcnt(0x0F70);
        if (!has_next) break;
#pragma unroll
        for (int a = 0; a < 2; ++a)
#pragma unroll
            for (int b = 0; b < 2; ++b)
#pragma unroll
                for (int m = 0; m < 4; ++m)
#pragma unroll
                    for (int n = 0; n < 2; ++n) acc[a][b][m][n] = (f32x4){0.f, 0.f, 0.f, 0.f};
        cur = nxt; cA = nA; cB = nB; ++ui;
        if constexpr (GA) {
#pragma unroll
            for (int h_ = 0; h_ < 2; ++h_)
#pragma unroll
                for (int i_ = 0; i_ < 2; ++i_) gc[h_][i_] = gn[h_][i_]; }
        if (wr == 1) PG8_BAR;
    }
    PG8_WAIT_V(0);
    PG8_BAR;
#undef PG8_SA
#undef PG8_SB
#undef PG8_STAGE
#undef PG8_STAGE_A
#undef PG8_GLOAD
#undef PG8_LDA
#undef PG8_LDB
#undef PG8_MMA
#undef PG8_WAIT_V
#undef PG8_WAIT_L
#undef PG8_BAR
#undef PG8_SCHED
}

struct GridOrder {
    static constexpr bool GATHER = false; __device__ __forceinline__ unsigned tok_off(int, int) const { return 0u; }
    const char* A; const char* B; size_t tA, tB; int nM, nN, nwg, G, c;
    __device__ __forceinline__ void init(const void* A_, int lda, const void* B_, int ldb, int M, int N, int G_, int blk, int off) {
        A = (const char*)A_; B = (const char*)B_; tA = (size_t)256 * lda * 2; tB = (size_t)256 * ldb * 2; nM = M / BM; nN = N / BM; nwg = nM * nN; G = G_; c = (blk - off + G_) % G_; }
    __device__ __forceinline__ bool next(int i, Unit& u) const {
        const long L = (long)i * G + c; if (L >= nwg) return false;
        int wgid = (int)L; { const int q = nwg / NXCD, r = nwg % NXCD, xcd = wgid % NXCD, off = wgid / NXCD; wgid = (xcd < r ? xcd * (q + 1) : r * (q + 1) + (xcd - r) * q) + off; }
        const int nig = WGM * nN, gid = wgid / nig, fm = gid * WGM, gsz = (nM - fm) < WGM ? (nM - fm) : WGM;
        const int pm = fm + ((wgid % nig) % gsz), pn = (wgid % nig) / gsz;
        u.a = A + (size_t)pm * tA; u.b = B + (size_t)pn * tB; u.orow = pm * BM; u.ocol = pn * BM; u.aux = 0; return true;
    }
};
}
using pg8::Unit;

#define EPI_LOOP_ROWS for (int ai = 0; ai < 2; ++ai) _Pragma("unroll") for (int m = 0; m < 4; ++m)
template <bool DRAIN_> struct EpiBf16T {
    static constexpr bool PERM = true, DRAIN = DRAIN_;
    bf16_t* O; int ldc; const float* bias; int ncols;
    int biasld;
    __device__ __forceinline__ void operator()(const f32x4 (&acc)[2][2][4][2], const Unit& u, int wr, int wc, int fr, int fq) const {
        const int row0 = u.orow + wr * 64 + fr, col0 = u.ocol + wc * 32 + 8 * fq;
        f32x4 bv[2][2];
#pragma unroll
        for (int bj = 0; bj < 2; ++bj)
#pragma unroll
            for (int n = 0; n < 2; ++n) bv[bj][n] = bias ? *(const f32x4*)(bias + (size_t)u.aux * biasld + col0 + bj * 128 + 4 * n) : (f32x4){0.f, 0.f, 0.f, 0.f};
#pragma unroll
        EPI_LOOP_ROWS { bf16_t* rowp = O + (size_t)(row0 + ai * 128 + m * 16) * ldc + col0;
#pragma unroll
            for (int bj = 0; bj < 2; ++bj) { if (col0 + bj * 128 < ncols) { const f32x4 v0 = acc[ai][bj][m][0] + bv[bj][0], v1 = acc[ai][bj][m][1] + bv[bj][1];
                u32x4 w; w.x = cvt_pk_bf16(v0[0], v0[1]); w.y = cvt_pk_bf16(v0[2], v0[3]); w.z = cvt_pk_bf16(v1[0], v1[1]); w.w = cvt_pk_bf16(v1[2], v1[3]);
                *(u32x4*)(rowp + bj * 128) = w; } } }
    }
};
struct EpiLvl1 {
    static constexpr bool PERM = true, DRAIN = false;
    bf16_t* O;
    __device__ __forceinline__ void operator()(const f32x4 (&acc)[2][2][4][2], const Unit& u, int wr, int wc, int fr, int fq) const {
        const int row0 = u.orow + wr * 64 + fr, col0 = u.ocol + wc * 32 + 8 * fq;
#pragma unroll
        EPI_LOOP_ROWS { bf16_t* rowp = O + (size_t)(row0 + ai * 128 + m * 16) * 384 + col0;
#pragma unroll
            for (int bj = 0; bj < 2; ++bj) { const int c = col0 + bj * 128; if (c < 384) { f32x4 v0 = acc[ai][bj][m][0], v1 = acc[ai][bj][m][1];
#pragma unroll
                for (int j = 0; j < 4; ++j) {
                    if (c < 128) { v0[j] = 1.0f - 2.0f * frcp(__expf(2.0f * fminf(fmaxf(v0[j], -15.f), 15.f)) + 1.0f); v1[j] = 1.0f - 2.0f * frcp(__expf(2.0f * fminf(fmaxf(v1[j], -15.f), 15.f)) + 1.0f); }
                    else if (c >= 256) { v0[j] = sigmoidf_(v0[j]); v1[j] = sigmoidf_(v1[j]); } }
                u32x4 w; w.x = cvt_pk_bf16(v0[0], v0[1]); w.y = cvt_pk_bf16(v0[2], v0[3]); w.z = cvt_pk_bf16(v1[0], v1[1]); w.w = cvt_pk_bf16(v1[2], v1[3]);
                *(u32x4*)(rowp + bj * 128) = w; } } }
    }
};
struct EpiLvl2 {
    static constexpr bool PERM = false, DRAIN = false;
    const float* w0; const float* a0; const float* k_a;
    unsigned char* ws;
    template <int BJ, int N_>
    __device__ __forceinline__ void part(const f32x4 (&acc)[2][2][4][2], int row0, int col0) const {
        const int c = col0 + BJ * 128 + N_ * 16;
        const int seg = c / 384, cc = c - seg * 384;
        if (seg < 2) {
            bf16_t* DEC = (bf16_t*)(ws + O_DEC) + (size_t)seg * T * 384;
            const f32x4 w0v = *(const f32x4*)(w0 + seg * 384 + cc);
#pragma unroll
            for (int ai = 0; ai < 2; ++ai)
#pragma unroll
                for (int m = 0; m < 4; ++m) { const size_t ro = (size_t)(row0 + ai * 128 + m * 16) * 384 + cc; f32x4 o;
#pragma unroll
                    for (int j = 0; j < 4; ++j) { const float pre = w0v[j] + acc[ai][BJ][m][N_][j]; o[j] = __expf(-0.60653065971f * sigmoidf_(pre)); }
                    *(u32x2*)(DEC + ro) = f32_to_h4(o); }
        } else if (seg < 4) {
            const int d = seg - 2; const f32x4 a0v = *(const f32x4*)(a0 + d * 384 + cc), kav = *(const f32x4*)(k_a + cc);
            const bf16_t* Kb = (const bf16_t*)(ws + O_K); const bf16_t* Ab = (const bf16_t*)(ws + O_A);
            bf16_t* KD = (bf16_t*)(ws + O_KD) + (size_t)d * T * 384; bf16_t* BV = (bf16_t*)(ws + O_BV) + (size_t)d * T * 384;
            u32x2 kraw[2][4], araw[2][4];
#pragma unroll
            for (int ai = 0; ai < 2; ++ai)
#pragma unroll
                for (int m = 0; m < 4; ++m) { const size_t ro = (size_t)(row0 + ai * 128 + m * 16) * 384 + cc; kraw[ai][m] = *(const u32x2*)(Kb + ro); araw[ai][m] = *(const u32x2*)(Ab + ro); }
#pragma unroll
            for (int ai = 0; ai < 2; ++ai)
#pragma unroll
                for (int m = 0; m < 4; ++m) { const size_t ro = (size_t)(row0 + ai * 128 + m * 16) * 384 + cc; const f32x4 kv = bf4_to_f32(kraw[ai][m]), av = bf4_to_f32(araw[ai][m]); f32x4 okd, obv;
#pragma unroll
                    for (int j = 0; j < 4; ++j) { const float as = sigmoidf_(a0v[j] + acc[ai][BJ][m][N_][j]); okd[j] = kv[j] * (1.0f + (as - 1.0f) * kav[j]); obv[j] = -av[j] * as; }
                    *(u32x2*)(KD + ro) = f32_to_bf4(okd); *(u32x2*)(BV + ro) = f32_to_bf4(obv); }
        } else if (seg == 4) {
            bf16_t* GATE = (bf16_t*)(ws + O_GATE);
#pragma unroll
            for (int ai = 0; ai < 2; ++ai)
#pragma unroll
                for (int m = 0; m < 4; ++m) { const size_t ro = (size_t)(row0 + ai * 128 + m * 16) * 384 + cc; *(u32x2*)(GATE + ro) = f32_to_bf4(acc[ai][BJ][m][N_]); }
        }
    }
    __device__ __forceinline__ void operator()(const f32x4 (&acc)[2][2][4][2], const Unit& u, int wr, int wc, int fr, int fq) const {
        const int row0 = u.orow + wr * 64 + fr, col0 = u.ocol + wc * 32 + 4 * fq;
        part<0, 0>(acc, row0, col0); part<0, 1>(acc, row0, col0); part<1, 0>(acc, row0, col0); part<1, 1>(acc, row0, col0);
    }
};
struct EpiF32 {
    static constexpr bool PERM = false, DRAIN = false;
    float* C; int ldc;
    __device__ __forceinline__ void operator()(const f32x4 (&acc)[2][2][4][2], const Unit& u, int wr, int wc, int fr, int fq) const {
        const int row0 = u.orow + wr * 64 + fr, col0 = u.ocol + wc * 32 + 4 * fq;
#pragma unroll
        EPI_LOOP_ROWS { float* rowp = C + (size_t)(row0 + ai * 128 + m * 16) * ldc + col0;
#pragma unroll
            for (int bj = 0; bj < 2; ++bj)
#pragma unroll
                for (int n = 0; n < 2; ++n) *(f32x4*)(rowp + bj * 128 + n * 16) = acc[ai][bj][m][n]; }
    }
};
struct EpiS5Y {
    static constexpr bool PERM = true, DRAIN = false;
    bf16_t* YG;
    __device__ __forceinline__ void operator()(const f32x4 (&acc)[2][2][4][2], const Unit& u, int wr, int wc, int fr, int fq) const {
        const int row0 = u.orow + wr * 64 + fr, col0 = u.ocol + wc * 32 + 8 * fq;
#pragma unroll
        EPI_LOOP_ROWS { const int chunk = row0 + ai * 128 + m * 16;
#pragma unroll
            for (int bj = 0; bj < 2; ++bj) { const int nn = col0 + bj * 128, t = nn >> 4, ho = nn & 15; const f32x4 v0 = acc[ai][bj][m][0], v1 = acc[ai][bj][m][1];
                u32x4 w; w.x = cvt_pk_bf16(gelu_tanh(v0[0]), gelu_tanh(v0[1])); w.y = cvt_pk_bf16(gelu_tanh(v0[2]), gelu_tanh(v0[3])); w.z = cvt_pk_bf16(gelu_tanh(v1[0]), gelu_tanh(v1[1])); w.w = cvt_pk_bf16(gelu_tanh(v1[2]), gelu_tanh(v1[3]));
                *(u32x4*)(YG + (size_t)(chunk * 64 + t) * 256 + u.aux * 16 + ho) = w; } }
    }
};
struct EpiGlu {
    static constexpr bool PERM = true, DRAIN = false;
    const bf16_t* YG; bf16_t* MIX;
    __device__ __forceinline__ void operator()(const f32x4 (&acc)[2][2][4][2], const Unit& u, int wr, int wc, int fr, int fq) const {
        const int row0 = u.orow + wr * 64 + fr, col0 = u.ocol + wc * 32 + 8 * fq;
        u32x4 yraw[2][4][2];
#pragma unroll
        EPI_LOOP_ROWS {
#pragma unroll
            for (int bj = 0; bj < 2; ++bj) yraw[ai][m][bj] = *(const u32x4*)(YG + (size_t)(row0 + ai * 128 + m * 16) * 256 + col0 + bj * 128); }
#pragma unroll
        EPI_LOOP_ROWS { const size_t row = (size_t)(row0 + ai * 128 + m * 16);
#pragma unroll
            for (int bj = 0; bj < 2; ++bj) { const int c = col0 + bj * 128; const u32x4 yv = yraw[ai][m][bj]; const f32x4 v0 = acc[ai][bj][m][0], v1 = acc[ai][bj][m][1];
                float y[8]; y[0] = __uint_as_float(yv.x << 16); y[1] = __uint_as_float(yv.x & 0xFFFF0000u); y[2] = __uint_as_float(yv.y << 16); y[3] = __uint_as_float(yv.y & 0xFFFF0000u);
                y[4] = __uint_as_float(yv.z << 16); y[5] = __uint_as_float(yv.z & 0xFFFF0000u); y[6] = __uint_as_float(yv.w << 16); y[7] = __uint_as_float(yv.w & 0xFFFF0000u);
                u32x4 w; w.x = cvt_pk_bf16(y[0] * sigmoidf_(v0[0]), y[1] * sigmoidf_(v0[1])); w.y = cvt_pk_bf16(y[2] * sigmoidf_(v0[2]), y[3] * sigmoidf_(v0[3]));
                w.z = cvt_pk_bf16(y[4] * sigmoidf_(v1[0]), y[5] * sigmoidf_(v1[1])); w.w = cvt_pk_bf16(y[6] * sigmoidf_(v1[2]), y[7] * sigmoidf_(v1[3]));
                *(u32x4*)(MIX + row * 1024 + c) = w; } }
    }
};
struct EpiWout {
    static constexpr bool PERM = false, DRAIN = false;
    bf16_t* X; const float* gate;
    __device__ __forceinline__ void operator()(const f32x4 (&acc)[2][2][4][2], const Unit& u, int wr, int wc, int fr, int fq) const {
        const int row0 = u.orow + wr * 64 + fr, col0 = u.ocol + wc * 32 + 4 * fq; const int b = u.orow >> 12;
        f32x4 gv[2][2];
#pragma unroll
        for (int bj = 0; bj < 2; ++bj)
#pragma unroll
            for (int n = 0; n < 2; ++n) gv[bj][n] = *(const f32x4*)(gate + (size_t)b * 6144 + col0 + bj * 128 + n * 16);
        u32x2 old[2][4][2][2];
#pragma unroll
        for (int ai = 0; ai < 2; ++ai)
#pragma unroll
            for (int m = 0; m < 4; ++m)
#pragma unroll
                for (int bj = 0; bj < 2; ++bj)
#pragma unroll
                    for (int n = 0; n < 2; ++n) old[ai][m][bj][n] = *(const u32x2*)(X + (size_t)(row0 + ai * 128 + m * 16) * 1024 + col0 + bj * 128 + n * 16);
#pragma unroll
        for (int ai = 0; ai < 2; ++ai)
#pragma unroll
            for (int m = 0; m < 4; ++m)
#pragma unroll
                for (int bj = 0; bj < 2; ++bj)
#pragma unroll
                    for (int n = 0; n < 2; ++n) *(u32x2*)(X + (size_t)(row0 + ai * 128 + m * 16) * 1024 + col0 + bj * 128 + n * 16) = f32_to_bf4(bf4_to_f32(old[ai][m][bj][n]) + gv[bj][n] * acc[ai][bj][m][n]);
    }
};
struct EpiSwiglu {
    static constexpr bool PERM = true, DRAIN = false;
    bf16_t* HH; const float* b1;
    __device__ __forceinline__ void operator()(const f32x4 (&acc)[2][2][4][2], const Unit& u, int wr, int wc, int fr, int fq) const {
        const int row0 = u.orow + wr * 64 + fr, col0 = u.ocol + wc * 32 + 8 * fq;
        f32x4 bv[2][2];
#pragma unroll
        for (int bj = 0; bj < 2; ++bj)
#pragma unroll
            for (int n = 0; n < 2; ++n) bv[bj][n] = *(const f32x4*)(b1 + (size_t)u.aux * 2048 + col0 + bj * 128 + 4 * n);
#pragma unroll
        EPI_LOOP_ROWS { bf16_t* rowp = HH + (size_t)(row0 + ai * 128 + m * 16) * 1024 + (col0 >> 1);
#pragma unroll
            for (int bj = 0; bj < 2; ++bj) { const f32x4 v0 = acc[ai][bj][m][0] + bv[bj][0], v1 = acc[ai][bj][m][1] + bv[bj][1];
                float o[4];
#pragma unroll
                for (int j = 0; j < 4; ++j) { const float g = fminf(j < 2 ? v0[2 * j] : v1[2 * j - 4], 7.0f); const float li = fminf(fmaxf(j < 2 ? v0[2 * j + 1] : v1[2 * j - 3], -7.0f), 7.0f);
                    o[j] = g * sigmoidf_(1.702f * g) * (li + 1.0f); }
                u32x2 w; w.x = cvt_pk_bf16(o[0], o[1]); w.y = cvt_pk_bf16(o[2], o[3]);
                *(u32x2*)(rowp + bj * 64) = w; } }
    }
};

struct S5SOrder {
    static constexpr bool GATHER = false; __device__ __forceinline__ unsigned tok_off(int, int) const { return 0u; }
    const char* A; const char* B; int G, c;
    __device__ __forceinline__ bool next(int i, Unit& u) const { const int L = i * G + c; if (L >= 16) return false;
        u.a = A + (size_t)L * 256 * 1280 * 2; u.b = B + (size_t)L * 256 * 1024 * 2; u.orow = L * 256; u.ocol = 0; u.aux = L; return true; }
};
struct S5YOrder {
    static constexpr bool GATHER = false; __device__ __forceinline__ unsigned tok_off(int, int) const { return 0u; }
    const char* A; const char* B; int G, c;
    __device__ __forceinline__ bool next(int i, Unit& u) const { const int L = i * G + c; if (L >= 64) return false; const int g = L >> 2, pn = L & 3;
        u.a = A + (size_t)g * 256 * 1280 * 2; u.b = B + (size_t)(g * 1024 + pn * 256) * 1280 * 2; u.orow = 0; u.ocol = pn * 256; u.aux = g; return true; }
};
template <bool GATHER_> struct MoeOrderT {
    static constexpr bool GATHER = GATHER_;
    const LAS int* pre; const char* A; const char* B; int G, c, npn; size_t tB; const LAS unsigned* tokl;
    __device__ __forceinline__ unsigned tok_off(int ui, int r) const { return tokl[ui * 256 + r]; }
    __device__ __forceinline__ bool next(int i, Unit& u) const {
        int rbg, pn;
        if (G == 256) { const int xcd = c & 7, j = c >> 3; if (npn == 8) { rbg = i * 32 + xcd * 4 + (j & 3); pn = j >> 2; } else { rbg = i * 64 + xcd * 8 + (j & 7); pn = j >> 3; } }
        else { const int L = i * G + c; rbg = L / npn; pn = L - rbg * npn; }
        if (rbg >= pre[32]) return false;
        int e = 0;
#pragma unroll 1
        for (int s = 16; s > 0; s >>= 1) if (pre[e + s] <= rbg) e += s;
        const int rb = rbg - pre[e];
        u.a = GATHER_ ? A : A + (size_t)(e * 64 + rb) * (256 * 1024 * 2); u.b = B + (size_t)(e * npn + pn) * tB; u.orow = (e * 64 + rb) * 256; u.ocol = pn * 256; u.aux = e; return true;
    }
};
constexpr int CONV_EARLY2 = 256;
constexpr int CONV_EARLY = 336;
constexpr int MOE_NTAB = 14;

#define WSP(off, type) ((type*)(p.ws + (off)))

__device__ __forceinline__ void ph_mod(const P& p, unsigned char* lds, int tid, int blk, int G) {
    float* cond = (float*)lds;
    float* red = cond + 4096;
    for (int i = tid; i < 4096; i += NTHREADS) { const float c = p.in[1][i]; cond[i] = c / (1.0f + __expf(-c)); }
    __syncthreads();
    float* MOD = WSP(O_MOD, float);
    for (int item = blk; item < 256; item += G) {
        const int l = item >> 6, cb = item & 63;
        const int col = tid % 96, part = tid / 96;
        if (part < 5) {
            float a0 = 0.f, a1 = 0.f, a2 = 0.f, a3 = 0.f;
            const int d0 = part * 205, d1 = min(1024, d0 + 205);
            const float* w = p.in[2] + (size_t)l * 1024 * 6144 + cb * 96 + col;
            for (int db = d0; db < d1; db += 32) {
                float wv[32];
#pragma unroll
                for (int u = 0; u < 32; ++u) { const int d = min(db + u, d1 - 1); wv[u] = w[(size_t)d * 6144]; }
#pragma unroll
                for (int u = 0; u < 32; ++u) { const int d = db + u; const float x = d < d1 ? wv[u] : 0.f; const int dc = min(d, 1023); a0 += cond[dc] * x; a1 += cond[1024 + dc] * x; a2 += cond[2048 + dc] * x; a3 += cond[3072 + dc] * x; } }
            red[(part * 4 + 0) * 96 + col] = a0; red[(part * 4 + 1) * 96 + col] = a1; red[(part * 4 + 2) * 96 + col] = a2; red[(part * 4 + 3) * 96 + col] = a3;
        }
        __syncthreads();
        if (tid < 384) { const int b = tid / 96, c2 = tid % 96; float s = 0.f;
            for (int q = 0; q < 5; ++q) s += red[(q * 4 + b) * 96 + c2];
            MOD[(size_t)(l * 4 + b) * 6144 + cb * 96 + c2] = s + p.in[3][l * 6144 + cb * 96 + c2]; }
        __syncthreads();
    }
}

struct ConvTile { const float* src; bf16_t* dst; int N, kt, nt; };
__device__ __forceinline__ void conv_load(const ConvTile& t, int tid, f32x4 (&r)[8]) {
#pragma unroll
    for (int i = 0; i < 8; ++i) { const int idx = i * NTHREADS + tid, kk = idx >> 6, n = t.nt * 256 + (idx & 63) * 4;
        r[i] = (f32x4){0.f, 0.f, 0.f, 0.f};
        if (n < t.N) r[i] = __builtin_nontemporal_load((const f32x4*)(t.src + (size_t)(t.kt * 64 + kk) * t.N + n)); }
}
__device__ __forceinline__ void conv_to_lds(int tid, const f32x4 (&r)[8], float* tile) {
#pragma unroll
    for (int i = 0; i < 8; ++i) { const int idx = i * NTHREADS + tid, kk = idx >> 6, n4 = (idx & 63) * 4; float* d = tile + kk * 257 + n4; d[0] = r[i][0]; d[1] = r[i][1]; d[2] = r[i][2]; d[3] = r[i][3]; }
}
__device__ __forceinline__ void conv_from_lds(const ConvTile& t, int tid, const float* tile) {
    const int n = tid >> 1, kh = tid & 1; bf16_t* d = t.dst + (size_t)(t.nt * 256 + n) * 1024 + t.kt * 64 + kh * 32;
#pragma unroll
    for (int q = 0; q < 4; ++q) { float f[8];
#pragma unroll
        for (int j = 0; j < 8; ++j) f[j] = tile[(kh * 32 + q * 8 + j) * 257 + n];
        u32x4 w; w.x = cvt_pk_bf16(f[0], f[1]); w.y = cvt_pk_bf16(f[2], f[3]); w.z = cvt_pk_bf16(f[4], f[5]); w.w = cvt_pk_bf16(f[6], f[7]);
        *(u32x4*)(d + q * 8) = w; }
}
__device__ __forceinline__ bool conv_tile_a(const P& p, int g, ConvTile& t) {
    if (g < NL * 192) { const int l = g / 192, r = g % 192; t.src = p.in[6] + (size_t)l * 1024 * 2944; t.dst = WSP(O_WIN, bf16_t) + (size_t)l * 3072 * 1024; t.N = 2944; t.kt = r / 12; t.nt = r % 12; return true; }
    g -= NL * 192;
    if (g < NL * 64) { const int l = g >> 6, r = g & 63; t.src = p.in[7] + (size_t)l * 1024 * 1024; t.dst = WSP(O_WOUT, bf16_t) + (size_t)l * 1024 * 1024; t.N = 1024; t.kt = r >> 2; t.nt = r & 3; return true; }
    return false;
}
__device__ __forceinline__ bool conv_tile_b(const P& p, int l, int g, ConvTile& t) {
    if (g < 4096) { const int e = g >> 7, r = g & 127; t.src = p.in[36] + (size_t)(l * NE + e) * 1024 * 2048; t.dst = WSP(O_EW1, bf16_t) + (size_t)(l * NE + e) * 2048 * 1024; t.N = 2048; t.kt = r >> 3; t.nt = r & 7; return true; }
    g -= 4096;
    if (g < 2048) { const int e = g >> 6, r = g & 63; t.src = p.in[38] + (size_t)(l * NE + e) * 1024 * 1024; t.dst = WSP(O_EW2, bf16_t) + (size_t)(l * NE + e) * 1024 * 1024; t.N = 1024; t.kt = r >> 2; t.nt = r & 3; return true; }
    return false;
}
template <bool LIST_B> __device__ __forceinline__ void ph_convert(const P& p, int l, unsigned char* lds, int tid, int cblk, int CG, int g0, int g1) {
    float* tile = (float*)lds;
    ConvTile ta, tb, tc, tn; f32x4 ra[8], rb[8], rc[8];
    int g = g0 + cblk;
#define CONV_NEXT(t, has) do { has = g < g1 && (LIST_B ? conv_tile_b(p, l, g, t) : conv_tile_a(p, g, t)); g += CG; } while (0)
    bool ha, hb, hc, hn;
    CONV_NEXT(ta, ha); CONV_NEXT(tb, hb); CONV_NEXT(tc, hc);
    if (ha) conv_load(ta, tid, ra);
    if (hb) conv_load(tb, tid, rb);
    if (hc) conv_load(tc, tid, rc);
#define CONV_STEP(t, r, h) do { conv_to_lds(tid, r, tile); CONV_NEXT(tn, hn); if (hn) conv_load(tn, tid, r); LDS_BARRIER(); conv_from_lds(t, tid, tile); LDS_BARRIER(); t = tn; h = hn; } while (0)
#pragma unroll 1
    while (ha) {
        CONV_STEP(ta, ra, ha);
        if (!hb) break;
        CONV_STEP(tb, rb, hb);
        if (!hc) break;
        CONV_STEP(tc, rc, hc);
    }
#undef CONV_NEXT
#undef CONV_STEP
}
__device__ __forceinline__ void ph_smallw(const P& p, int tid, int blk, int G) {
    bf16_t* W1C = WSP(O_W1C, bf16_t); bf16_t* W2B = WSP(O_W2B, bf16_t); bf16_t* WGLU = WSP(O_WGLU, bf16_t);
    const int gt = blk * NTHREADS + tid, gs = G * NTHREADS;
    for (int idx = gt; idx < NL * 512 * 384; idx += gs) { const int l = idx / (512 * 384), r = idx % (512 * 384), n = r / 384, k = r % 384; float v = 0.f;
        if (n < 64) v = p.in[19][((size_t)(l * 2 + 0) * 384 + k) * 64 + n];
        else if (n < 128) v = p.in[19][((size_t)(l * 2 + 1) * 384 + k) * 64 + n - 64];
        else if (n < 192) v = p.in[22][((size_t)(l * 2 + 0) * 384 + k) * 64 + n - 128];
        else if (n < 256) v = p.in[22][((size_t)(l * 2 + 1) * 384 + k) * 64 + n - 192];
        else if (n < 384) v = p.in[24][((size_t)l * 384 + k) * 128 + n - 256];
        W1C[idx] = f2bf(v); }
    for (int idx = gt; idx < NL * 2048 * 384; idx += gs) { const int l = idx / (2048 * 384), r = idx % (2048 * 384), n = r / 384, k = r % 384; float v = 0.f;
        if (n < 1920) { const int seg = n / 384, cc = n % 384;
            if (seg == 0) { if (k < 64) v = p.in[20][((size_t)(l * 2 + 0) * 64 + k) * 384 + cc]; }
            else if (seg == 1) { if (k >= 64 && k < 128) v = p.in[20][((size_t)(l * 2 + 1) * 64 + k - 64) * 384 + cc]; }
            else if (seg == 2) { if (k >= 128 && k < 192) v = p.in[23][((size_t)(l * 2 + 0) * 64 + k - 128) * 384 + cc]; }
            else if (seg == 3) { if (k >= 192 && k < 256) v = p.in[23][((size_t)(l * 2 + 1) * 64 + k - 192) * 384 + cc]; }
            else { if (k >= 256) v = p.in[25][((size_t)l * 128 + k - 256) * 384 + cc]; } }
        W2B[idx] = f2bf(v); }
    for (int idx = gt; idx < NL * 256 * 256; idx += gs) { const int l = idx >> 16, n = (idx >> 8) & 255, k = idx & 255; WGLU[idx] = f2bf(p.in[16][((size_t)l * 256 + k) * 256 + n]); }
}
__device__ __forceinline__ void cpowz(double zre, double zim, int n, float& ore, float& oim) {
    const float mag = __expf((float)(zre * (double)n));
    double rev = zim * (double)n * 0.15915494309189535; rev -= rint(rev);
    const float r = (float)rev;
    ore = mag * __builtin_amdgcn_cosf(r); oim = mag * __builtin_amdgcn_sinf(r);
}
__device__ __forceinline__ void ph_s5ops(const P& p, unsigned char* lds, int tid, int blk, int G) {
    double* zr = (double*)lds;
    double* zi = zr + 128;
    float* qre = (float*)(zi + 128);
    float* qim = qre + 128;
    float* bbr = qim + 128;
    float* bbi = bbr + 2048;
    float* ccr = bbi + 2048;
    float* cci = ccr + 2048;
    float* pwr = cci + 2048;
    float* pwi = pwr + 320;
    float* kt = pwi + 320;
    for (int item = blk; item < NL * 16 * 64; item += G) {
        const int l = item >> 10, g = (item >> 6) & 15, j = item & 63;
        if (tid < 128) { const int dir = tid >> 6, pp = tid & 63; const int li = ((l * 2 + dir) * 16 + g) * 64 + pp;
            const double lre = (double)p.in[8][li], lim = (double)p.in[9][li]; const double dt = exp((double)p.in[10][(l * 2 + dir) * 16 + g]);
            const double zre = lre * dt, zim = lim * dt; zr[tid] = zre; zi[tid] = zim;
            float er, ei; cpowz(zre, zim, 1, er, ei);
            const double nr = (double)er - 1.0, ni = (double)ei, den = lre * lre + lim * lim;
            qre[tid] = (float)((nr * lre + ni * lim) / den); qim[tid] = (float)((ni * lre - nr * lim) / den);
            if (j == 0) { float m64r, m64i; cpowz(zre, zim, 64, m64r, m64i); float* S5M = WSP(O_S5M, float); S5M[(size_t)li * 2] = m64r; S5M[(size_t)li * 2 + 1] = m64i; } }
        __syncthreads();
        for (int i = tid; i < 2048; i += NTHREADS) { const int dir = i >> 10, pp = (i >> 4) & 63;
            const size_t gi = ((size_t)((l * 2 + dir) * 16 + g) * 64 + pp) * 16 + (i & 15);
            const float br = p.in[11][gi], bi = p.in[12][gi], qr = qre[dir * 64 + pp], qi = qim[dir * 64 + pp];
            bbr[i] = qr * br - qi * bi; bbi[i] = qr * bi + qi * br;
            const int ho = (i >> 6) & 15, p2 = i & 63;
            const size_t ci = ((size_t)((l * 2 + dir) * 16 + g) * 16 + ho) * 64 + p2;
            ccr[i] = p.in[13][ci]; cci[i] = p.in[14][ci]; }
        if (tid < 320) { const int tb = tid >> 6, pp = tid & 63; float a, b;
            if (tb < 2) cpowz(zr[tb * 64 + pp], zi[tb * 64 + pp], j, a, b);
            else if (tb == 2) cpowz(zr[pp], zi[pp], j + 1, a, b);
            else if (tb == 3) cpowz(zr[64 + pp], zi[64 + pp], 64 - j, a, b);
            else cpowz(zr[pp], zi[pp], 63 - j, a, b);
            pwr[tid] = a; pwi[tid] = b; }
        __syncthreads();
        bf16_t* Wy = WSP(O_WS5Y, bf16_t) + (size_t)(l * 16 + g) * 1024 * 1280;
        bf16_t* Ws = WSP(O_WS5S, bf16_t) + (size_t)(l * 16 + g) * 256 * 1024;
        if (tid < 128) { const int dir = tid >> 6, ln = tid & 63, i16 = ln & 15, kq = ln >> 4;
            f32x4 acc = {0.f, 0.f, 0.f, 0.f};
#pragma unroll 4
            for (int st = 0; st < 16; ++st) { const int pp = 4 * st + kq;
                const float cr = ccr[(dir * 16 + i16) * 64 + pp], ci = cci[(dir * 16 + i16) * 64 + pp], wr_ = pwr[dir * 64 + pp], wi_ = pwi[dir * 64 + pp];
                const float tr = cr * wr_ - ci * wi_, ti = cr * wi_ + ci * wr_;
                acc = __builtin_amdgcn_mfma_f32_16x16x4f32(tr, bbr[(dir * 64 + pp) * 16 + i16], acc, 0, 0, 0);
                acc = __builtin_amdgcn_mfma_f32_16x16x4f32(-ti, bbi[(dir * 64 + pp) * 16 + i16], acc, 0, 0, 0); }
            float* KT = WSP(O_KT, float) + ((size_t)((l * 16 + g) * 2 + dir) * 64 + j) * 256;
#pragma unroll
            for (int r = 0; r < 4; ++r) KT[(4 * kq + r) * 16 + i16] = acc[r]; }
        { const int kp = tid & 255, dir = kp >> 7, comp = (kp >> 6) & 1, pp = kp & 63; const float wr_ = pwr[(2 + dir) * 64 + pp], wi_ = pwi[(2 + dir) * 64 + pp];
#pragma unroll
          for (int q = 0; q < 8; ++q) { const int ho = (tid >> 8) * 8 + q; const float cr = ccr[(dir * 16 + ho) * 64 + pp], ci = cci[(dir * 16 + ho) * 64 + pp];
              const float gr = cr * wr_ - ci * wi_, gi = cr * wi_ + ci * wr_;
              Wy[(size_t)(j * 16 + ho) * 1280 + 1024 + kp] = f2bf(comp == 0 ? gr : -gi); } }
        { const int kp = tid & 255, dir = kp >> 7, comp = (kp >> 6) & 1, pp = kp & 63; const int tb = dir == 0 ? 4 : 1; const float wr_ = pwr[tb * 64 + pp], wi_ = pwi[tb * 64 + pp];
          float f[8];
#pragma unroll
          for (int q = 0; q < 8; ++q) { const int hi = (tid >> 8) * 8 + q; const float br = bbr[(dir * 64 + pp) * 16 + hi], bi = bbi[(dir * 64 + pp) * 16 + hi];
              f[q] = comp == 0 ? (wr_ * br - wi_ * bi) : (wr_ * bi + wi_ * br); }
          u32x4 w; w.x = cvt_pk_bf16(f[0], f[1]); w.y = cvt_pk_bf16(f[2], f[3]); w.z = cvt_pk_bf16(f[4], f[5]); w.w = cvt_pk_bf16(f[6], f[7]);
          *(u32x4*)(Ws + (size_t)kp * 1024 + j * 16 + (tid >> 8) * 8) = w; }
        __syncthreads();
    }
}

__device__ __forceinline__ void ph_s5fill(const P& p, int tid, int blk, int G, int l0, int l1) {
    const float* KT = WSP(O_KT, float);
    for (int item = blk; item < (l1 - l0) * 16 * 64; item += G) {
        const int l = l0 + (item >> 10), g = (item >> 6) & 15, t = item & 63;
        bf16_t* Wy = WSP(O_WS5Y, bf16_t) + (size_t)(l * 16 + g) * 1024 * 1280;
        const float* kf = KT + (size_t)((l * 16 + g) * 2 + 0) * 64 * 256; const float* kr = KT + (size_t)((l * 16 + g) * 2 + 1) * 64 * 256;
        f32x4 va[4][2], vb[4][2];
#pragma unroll
        for (int r = 0; r < 4; ++r) { const int idx = r * NTHREADS + tid, ho = idx >> 7, k8 = idx & 127, sI = k8 >> 1, hi0 = (k8 & 1) * 8;
            const float* qa = kf + (size_t)max(t - sI, 0) * 256 + ho * 16 + hi0; const float* qb = kr + (size_t)max(sI - t, 0) * 256 + ho * 16 + hi0;
            va[r][0] = *(const f32x4*)qa; va[r][1] = *(const f32x4*)(qa + 4); vb[r][0] = *(const f32x4*)qb; vb[r][1] = *(const f32x4*)(qb + 4); }
#pragma unroll
        for (int r = 0; r < 4; ++r) { const int idx = r * NTHREADS + tid, ho = idx >> 7, k8 = idx & 127, sI = k8 >> 1, hi0 = (k8 & 1) * 8;
            const float fa = sI <= t ? 1.0f : 0.f, fb = sI >= t ? 1.0f : 0.f;
            f32x4 v0 = va[r][0] * fa + vb[r][0] * fb, v1 = va[r][1] * fa + vb[r][1] * fb;
            const float dd = sI == t ? p.in[15][(l * 16 + g) * 16 + ho] : 0.f; const int dpos = ho - hi0;
#pragma unroll
            for (int e = 0; e < 4; ++e) { v0[e] += (dpos == e) ? dd : 0.f; v1[e] += (dpos == e + 4) ? dd : 0.f; }
            u32x4 w; w.x = cvt_pk_bf16(v0[0], v0[1]); w.y = cvt_pk_bf16(v0[2], v0[3]); w.z = cvt_pk_bf16(v1[0], v1[1]); w.w = cvt_pk_bf16(v1[2], v1[3]);
            *(u32x4*)(Wy + (size_t)(t * 16 + ho) * 1280 + sI * 16 + hi0) = w; }
    }
}

__device__ __forceinline__ void ph_combine_norm(const P& p, int lsrc, int ldst, int lane, int wave, int blk, int G, bf16_t* xrdst) {
    const float* MOD = WSP(O_MOD, float);
    const bf16_t* Y = WSP(O_XS, bf16_t); const int* SLOT = WSP(O_SLOT, int); const float* GV = WSP(O_GV, float);
    bf16_t* H1 = WSP(O_H1, bf16_t);
    f32x4 gw[4], gfv[4], shv[4], scv[4]; int bcur = -1;
    if (ldst < NL) {
#pragma unroll
        for (int i = 0; i < 4; ++i) gw[i] = *(const f32x4*)(p.in[4] + ldst * 1024 + i * 256 + lane * 4); }
    for (int row = blk * 8 + wave; row < T; row += G * 8) {
        const int b = row >> 12;
        if (b != bcur) { bcur = b;
#pragma unroll
            for (int i = 0; i < 4; ++i) { const int c = i * 256 + lane * 4;
                if (lsrc >= 0) gfv[i] = *(const f32x4*)(MOD + (size_t)(lsrc * 4 + b) * 6144 + 5120 + c);
                if (ldst < NL) { shv[i] = *(const f32x4*)(MOD + (size_t)(ldst * 4 + b) * 6144 + c); scv[i] = *(const f32x4*)(MOD + (size_t)(ldst * 4 + b) * 6144 + 1024 + c) + 1.0f; } } }
        f32x4 x[4];
        if (lsrc < 0) {
#pragma unroll
            for (int i = 0; i < 4; ++i) x[i] = *(const f32x4*)(p.in[0] + (size_t)row * 1024 + i * 256 + lane * 4);
        } else { u32x2 xb[4];
#pragma unroll
            for (int i = 0; i < 4; ++i) xb[i] = *(const u32x2*)(WSP(O_XR, bf16_t) + (size_t)row * 1024 + i * 256 + lane * 4);
#pragma unroll
            for (int i = 0; i < 4; ++i) x[i] = bf4_to_f32(xb[i]); }
        if (lsrc >= 0) {
            f32x4 acc[4] = {{0.f, 0.f, 0.f, 0.f}, {0.f, 0.f, 0.f, 0.f}, {0.f, 0.f, 0.f, 0.f}, {0.f, 0.f, 0.f, 0.f}};
#pragma unroll
            for (int k = 0; k < 4; ++k) { const int slot = SLOT[row * 4 + k]; const float gk = GV[row * 4 + k]; const bf16_t* yr = Y + (size_t)slot * 1024;
#pragma unroll
                for (int i = 0; i < 4; ++i) { const u32x2 v = *(const u32x2*)(yr + i * 256 + lane * 4);
                    acc[i][0] += gk * __uint_as_float(v.x << 16); acc[i][1] += gk * __uint_as_float(v.x & 0xFFFF0000u); acc[i][2] += gk * __uint_as_float(v.y << 16); acc[i][3] += gk * __uint_as_float(v.y & 0xFFFF0000u); } }
#pragma unroll
            for (int i = 0; i < 4; ++i) x[i] = x[i] + gfv[i] * acc[i];
        }
        if (ldst < NL) {
#pragma unroll
            for (int i = 0; i < 4; ++i) { const u32x2 w = f32_to_bf4(x[i]); *(u32x2*)(xrdst + (size_t)row * 1024 + i * 256 + lane * 4) = w; x[i] = bf4_to_f32(w); }
        } else {
#pragma unroll
            for (int i = 0; i < 4; ++i) *(f32x4*)(p.out + (size_t)row * 1024 + i * 256 + lane * 4) = x[i];
        }
        if (ldst < NL) {
            float ss = 0.f;
#pragma unroll
            for (int i = 0; i < 4; ++i) ss += x[i][0] * x[i][0] + x[i][1] * x[i][1] + x[i][2] * x[i][2] + x[i][3] * x[i][3];
            ss = wave_sum_all(ss); const float rstd = rsqrtf(ss * (1.0f / 1024.0f) + 1e-6f);
#pragma unroll
            for (int i = 0; i < 4; ++i) { const int c = i * 256 + lane * 4;
                const f32x4 h = x[i] * rstd * gw[i] * scv[i] + shv[i];
                u32x2 w; w.x = cvt_pk_bf16(h[0], h[1]); w.y = cvt_pk_bf16(h[2], h[3]); *(u32x2*)(H1 + (size_t)row * 1024 + c) = w; }
        }
    }
}

__device__ __forceinline__ void ph_prepass(const P& p, int l, int lane, int wave, int blk, int G) {
    const bf16_t* PROJ = WSP(O_PROJ, bf16_t);
    bf16_t* ZS = WSP(O_ZS, bf16_t); bf16_t* QN = WSP(O_QN, bf16_t); bf16_t* KN = WSP(O_KN, bf16_t); bf16_t* AS5 = WSP(O_AS5, bf16_t);
    bf16_t* R = WSP(O_R, bf16_t); bf16_t* K = WSP(O_K, bf16_t); bf16_t* V = WSP(O_V, bf16_t); bf16_t* A = WSP(O_A, bf16_t); float* RKB = WSP(O_RKB, float);
    const float* mu = p.in[17] + l * 1536; const float* k_k = p.in[26] + l * 384; const float* r_k = p.in[28] + l * 384;
    const int r4 = lane >> 4, j4 = (lane & 15) * 4;
    const f32x4 qg = *(const f32x4*)(p.in[31] + l * 64 + j4), kg = *(const f32x4*)(p.in[32] + l * 64 + j4);
    const int c0 = r4 * 64 + j4, c1 = min(4 + r4, 5) * 64 + j4;
    f32x4 muv[2][4], kkv[2], rkv2[2];
#pragma unroll
    for (int pass = 0; pass < 2; ++pass) { const int c = pass ? c1 : c0;
#pragma unroll
        for (int part = 0; part < 4; ++part) muv[pass][part] = *(const f32x4*)(mu + part * 384 + c);
        kkv[pass] = *(const f32x4*)(k_k + c); rkv2[pass] = *(const f32x4*)(r_k + c); }
#pragma unroll 1
    for (int run = blk * 8 + wave; run < T / 8; run += G * 8) {
        const int base = run * 8, t0 = base & 4095;
        u32x2 rows[4][2][4], aux[2][5];
#define PP_ROW(slot, tk, valid) do { _Pragma("unroll") for (int part_ = 0; part_ < 4; ++part_) { const bf16_t* s0_ = PROJ + (size_t)(tk) * NPROJ + 256 + part_ * 384; \
            rows[slot][0][part_] = (valid) ? *(const u32x2*)(s0_ + c0) : (u32x2){0u, 0u}; rows[slot][1][part_] = (valid) ? *(const u32x2*)(s0_ + c1) : (u32x2){0u, 0u}; } } while (0)
#define PP_AUX(slot, tk) do { const bf16_t* s0_ = PROJ + (size_t)(tk) * NPROJ; aux[slot][0] = *(const u32x2*)(s0_ + lane * 4); aux[slot][1] = *(const u32x2*)(s0_ + 1792 + c0); aux[slot][2] = *(const u32x2*)(s0_ + 2176 + c0); \
            aux[slot][3] = *(const u32x2*)(s0_ + 1792 + c1); aux[slot][4] = *(const u32x2*)(s0_ + 2176 + c1); } while (0)
        PP_ROW(0, base - 1, t0 > 0); PP_ROW(1, base, true); PP_ROW(2, base + 1, true); PP_AUX(0, base);
#pragma unroll
        for (int it = 0; it < 8; ++it) {
            const int tok = base + it; const int sp = it & 3, sc = (it + 1) & 3, sn = (it + 2) & 3, snn = (it + 3) & 3;
            if (it < 7) { PP_ROW(snn, tok + 2, t0 + it + 2 <= 4095); PP_AUX((it + 1) & 1, tok + 1); }
            { const int g = lane >> 2, hi0 = (lane & 3) * 4; *(u32x2*)(AS5 + ((size_t)g * 256 + (tok >> 6)) * 1280 + (tok & 63) * 16 + hi0) = aux[it & 1][0]; }
#pragma unroll
            for (int pass = 0; pass < 2; ++pass) {
                const int hd_ = pass * 4 + r4; const bool act = hd_ < 6; const int hd = act ? hd_ : 5; const int c = hd * 64 + j4;
                f32x4 xs[4];
#pragma unroll
                for (int part = 0; part < 4; ++part) { const f32x4 cur = bf4_to_f32(rows[sc][pass][part]), pv = bf4_to_f32(rows[sp][pass][part]), nx = bf4_to_f32(rows[sn][pass][part]);
                    xs[part] = cur + ((pv + nx) * 0.5f - cur) * muv[pass][part]; }
                const f32x4 kr = xs[1] * kkv[pass];
                const float n2 = row16_sum(hsum4(kr * kr)); const float rk = row16_sum(hsum4(xs[0] * xs[1] * rkv2[pass]));
                const f32x4 qv = bf4_to_f32(aux[it & 1][1 + 2 * pass]), kv = bf4_to_f32(aux[it & 1][2 + 2 * pass]);
                const float mq = row16_sum(hsum4(qv * qv)) * (1.0f / 64.0f), mk = row16_sum(hsum4(kv * kv)) * (1.0f / 64.0f);
                if (act) { const size_t o = (size_t)tok * 384 + c;
                    *(u32x2*)(R + o) = f32_to_bf4(xs[0]); *(u32x2*)(K + o) = f32_to_bf4(xs[1]); *(u32x2*)(V + o) = f32_to_bf4(xs[2]); *(u32x2*)(ZS + o) = f32_to_bf4(xs[3]);
                    *(u32x2*)(A + o) = f32_to_bf4(kr * (-1.0f / fmaxf(sqrtf(n2), 1e-12f)));
                    if ((lane & 15) == 0) RKB[tok * 8 + hd] = rk;
                    *(u32x2*)(QN + o) = f32_to_bf4(qv * (rsqrtf(mq + 1e-6f) * 0.125f) * qg); *(u32x2*)(KN + o) = f32_to_bf4(kv * rsqrtf(mk + 1e-6f) * kg); }
            }
        }
#undef PP_ROW
#undef PP_AUX
    }
}

__device__ __forceinline__ void ph_na(const P& p, int l, unsigned char* lds, int tid, int lane, int wave, int blk, int G) {
    float* rpb = (float*)lds;
    unsigned char* vb = lds + 11264 + wave * 4608;
    { float rv[6];
#pragma unroll
      for (int k = 0; k < 6; ++k) { const int i = k * NTHREADS + tid; rv[k] = p.in[33][l * 2790 + (i < 2790 ? i : 0)]; }
#pragma unroll
      for (int k = 0; k < 6; ++k) { const int i = k * NTHREADS + tid; if (i < 2790) rpb[i] = rv[k]; } }
    __syncthreads();
    const bf16_t* QN = WSP(O_QN, bf16_t); const bf16_t* KN = WSP(O_KN, bf16_t); const bf16_t* PROJ = WSP(O_PROJ, bf16_t); bf16_t* MIX = WSP(O_MIX, bf16_t);
    const int q16 = lane & 15, g = lane >> 4;
    const unsigned vaddr = (unsigned)(size_t)(LAS unsigned char*)vb + (unsigned)((4 * g + (q16 >> 2)) * 144 + (q16 & 3) * 8);
    for (int unit = blk * 8 + wave; unit < 6144; unit += G * 8) {
        const int nb = unit & 3, r = (unit >> 2) & 63, bh = unit >> 8, h = bh % 6, b = bh / 6;
        const int rs = min(max(r - 4, 0), 56), kb0 = min(max(16 * nb - 8, 0), 32);
        const int tq = b * 4096 + r * 64 + 16 * nb + q16;
        const bf16x8 qf0 = *(const bf16x8*)(QN + (size_t)tq * 384 + h * 64 + 8 * g), qf1 = *(const bf16x8*)(QN + (size_t)tq * 384 + h * 64 + 32 + 8 * g);
        f32x4 s[16];
        bf16x8 kf[2][4][2];
#define NA_KLOAD(set, gi) do { _Pragma("unroll") for (int jj = 0; jj < 4; ++jj) { const int j_ = (gi) * 4 + jj; const int tk = b * 4096 + (rs + (j_ >> 1)) * 64 + kb0 + (j_ & 1) * 16 + q16; \
            const bf16_t* kp = KN + (size_t)tk * 384 + h * 64 + 8 * g; kf[set][jj][0] = *(const bf16x8*)kp; kf[set][jj][1] = *(const bf16x8*)(kp + 32); } } while (0)
        NA_KLOAD(0, 0);
        u32x4 vr[2][4];
#define NA_VLOAD(set, s2_) do { const int tv = b * 4096 + (rs + (s2_)) * 64 + kb0 + (lane >> 1); const bf16_t* vp = PROJ + (size_t)tv * NPROJ + 2560 + h * 64 + (lane & 1) * 32; \
            vr[set][0] = *(const u32x4*)vp; vr[set][1] = *(const u32x4*)(vp + 8); vr[set][2] = *(const u32x4*)(vp + 16); vr[set][3] = *(const u32x4*)(vp + 24); } while (0)
#pragma unroll
        for (int gi = 0; gi < 4; ++gi) {
            if (gi < 3) NA_KLOAD((gi + 1) & 1, gi + 1); else NA_VLOAD(0, 0);
#pragma unroll
            for (int jj = 0; jj < 4; ++jj) { f32x4 z = {0.f, 0.f, 0.f, 0.f};
                z = __builtin_amdgcn_mfma_f32_16x16x32_bf16(kf[gi & 1][jj][0], qf0, z, 0, 0, 0); z = __builtin_amdgcn_mfma_f32_16x16x32_bf16(kf[gi & 1][jj][1], qf1, z, 0, 0, 0); s[gi * 4 + jj] = z; }
            __builtin_amdgcn_sched_barrier(0); }
        const int qc = 16 * nb + q16, cst = min(max(qc - 8, 0), 48);
        float mx = -3.0e38f;
#pragma unroll
        for (int j = 0; j < 16; ++j)
#pragma unroll
            for (int i = 0; i < 4; ++i) { const int kc = kb0 + (j & 1) * 16 + 4 * g + i; const bool valid = (kc >= cst) && (kc < cst + 16);
                const int dy = rs + (j >> 1) - r + 7, dx = min(max(kc - qc + 15, 0), 30);
                const float v = valid ? s[j][i] + rpb[(h * 15 + dy) * 31 + dx] : -3.0e38f; s[j][i] = v; mx = fmaxf(mx, v); }
        { float a = mx, b = mx; swap16(a, b); mx = fmaxf(a, b); } { float a = mx, b = mx; swap32(a, b); mx = fmaxf(a, b); }
        float sum = 0.f;
#pragma unroll
        for (int j = 0; j < 16; ++j)
#pragma unroll
            for (int i = 0; i < 4; ++i) { const float e = __expf(s[j][i] - mx); s[j][i] = e; sum += e; }
        { float a = sum, b = sum; swap16(a, b); sum = a + b; } { float a = sum, b = sum; swap32(a, b); sum = a + b; }
        const float inv = 1.0f / sum;
        f32x4 o[4] = {{0.f, 0.f, 0.f, 0.f}, {0.f, 0.f, 0.f, 0.f}, {0.f, 0.f, 0.f, 0.f}, {0.f, 0.f, 0.f, 0.f}};
#pragma unroll
        for (int s2 = 0; s2 < 8; ++s2) {
            if (s2 < 7) NA_VLOAD((s2 + 1) & 1, s2 + 1);
            unsigned char* vw = vb + (lane >> 1) * 144 + (lane & 1) * 64;
            *(u32x4*)vw = vr[s2 & 1][0]; *(u32x4*)(vw + 16) = vr[s2 & 1][1]; *(u32x4*)(vw + 32) = vr[s2 & 1][2]; *(u32x4*)(vw + 48) = vr[s2 & 1][3];
            s16x4 lo[4], hi[4];
            asm volatile("s_waitcnt lgkmcnt(0)\n\t"
                         "ds_read_b64_tr_b16 %0, %8\n\tds_read_b64_tr_b16 %1, %8 offset:32\n\tds_read_b64_tr_b16 %2, %8 offset:64\n\tds_read_b64_tr_b16 %3, %8 offset:96\n\t"
                         "ds_read_b64_tr_b16 %4, %8 offset:2304\n\tds_read_b64_tr_b16 %5, %8 offset:2336\n\tds_read_b64_tr_b16 %6, %8 offset:2368\n\tds_read_b64_tr_b16 %7, %8 offset:2400\n\t"
                         "s_waitcnt lgkmcnt(0)"
                         : "=&v"(lo[0]), "=&v"(lo[1]), "=&v"(lo[2]), "=&v"(lo[3]), "=&v"(hi[0]), "=&v"(hi[1]), "=&v"(hi[2]), "=&v"(hi[3]) : "v"(vaddr) : "memory");
            bf16x8 pa;
            { const f32x4 a = s[2 * s2] * inv, c = s[2 * s2 + 1] * inv; u32x4 w; w.x = cvt_pk_bf16(a[0], a[1]); w.y = cvt_pk_bf16(a[2], a[3]); w.z = cvt_pk_bf16(c[0], c[1]); w.w = cvt_pk_bf16(c[2], c[3]); pa = __builtin_bit_cast(bf16x8, w); }
#pragma unroll
            for (int nt = 0; nt < 4; ++nt) { bf16x8 bfr; bfr[0] = lo[nt][0]; bfr[1] = lo[nt][1]; bfr[2] = lo[nt][2]; bfr[3] = lo[nt][3]; bfr[4] = hi[nt][0]; bfr[5] = hi[nt][1]; bfr[6] = hi[nt][2]; bfr[7] = hi[nt][3];
                o[nt] = __builtin_amdgcn_mfma_f32_16x16x32_bf16(pa, bfr, o[nt], 0, 0, 0); }
        }
#undef NA_KLOAD
#undef NA_VLOAD
#pragma unroll
        for (int nt = 0; nt < 4; ++nt)
#pragma unroll
            for (int i = 0; i < 4; ++i) MIX[(size_t)(b * 4096 + r * 64 + 16 * nb + 4 * g + i) * 1024 + 640 + h * 64 + 16 * nt + q16] = f2bf(o[nt][i]);
    }
    __syncthreads();
}

__device__ __forceinline__ void ph_s5carry(const P& p, int l, int tid, int blk) {
    if (blk >= 16) return;
    const int g = blk, b = tid >> 7, dir = (tid >> 6) & 1, pp = tid & 63;
    const int li = ((l * 2 + dir) * 16 + g) * 64 + pp;
    const float mr = WSP(O_S5M, float)[(size_t)li * 2], mi = WSP(O_S5M, float)[(size_t)li * 2 + 1];
    const float* SL = WSP(O_SLOC, float) + (size_t)g * 256 * 256; bf16_t* AS = WSP(O_AS5, bf16_t) + (size_t)g * 256 * 1280;
    float hr = 0.f, hi = 0.f;
#pragma unroll 1
    for (int c0 = 0; c0 < 64; c0 += 16) {
        float sr[16], si[16];
#pragma unroll
        for (int u = 0; u < 16; ++u) { const int cc = c0 + u, c = dir == 0 ? cc : 63 - cc, chunk = b * 64 + c;
            sr[u] = SL[(size_t)chunk * 256 + dir * 128 + pp]; si[u] = SL[(size_t)chunk * 256 + dir * 128 + 64 + pp]; }
#pragma unroll
        for (int u = 0; u < 16; ++u) { const int cc = c0 + u, c = dir == 0 ? cc : 63 - cc, chunk = b * 64 + c;
            AS[(size_t)chunk * 1280 + 1024 + dir * 128 + pp] = f2bf(hr); AS[(size_t)chunk * 1280 + 1024 + dir * 128 + 64 + pp] = f2bf(hi);
            const float nr = mr * hr - mi * hi + sr[u], ni = mr * hi + mi * hr + si[u]; hr = nr; hi = ni; }
    }
}

constexpr int XB = 8192;
#define XOFF(row, col) ((row) * 128 + (((((col) >> 3) ^ (((row) >> 1) & 7))) << 4) + ((col) & 7) * 2)
__device__ __forceinline__ void nt2(const LAS unsigned char* X, const LAS unsigned char* Y, int tm, int tn0, int m16, int g, f32x4 (&acc)[2]) {
    const int ra_ = 16 * tm + m16;
    const bf16x8 a0 = *(const LAS bf16x8*)(X + XOFF(ra_, 8 * g)), a1 = *(const LAS bf16x8*)(X + XOFF(ra_, 32 + 8 * g));
#pragma unroll
    for (int q = 0; q < 2; ++q) { const int rb_ = 16 * (tn0 + q) + m16;
        const bf16x8 b0 = *(const LAS bf16x8*)(Y + XOFF(rb_, 8 * g)), b1 = *(const LAS bf16x8*)(Y + XOFF(rb_, 32 + 8 * g));
        acc[q] = __builtin_amdgcn_mfma_f32_16x16x32_bf16(a0, b0, acc[q], 0, 0, 0); acc[q] = __builtin_amdgcn_mfma_f32_16x16x32_bf16(a1, b1, acc[q], 0, 0, 0); }
}
struct XF { bf16x8 a0, a1, b00, b01, b10, b11; };
__device__ __forceinline__ void xload(XF& f, const LAS unsigned char* X, const LAS unsigned char* Y, int tm, int tn0, int m16, int g) {
    const int ra_ = 16 * tm + m16, rb0_ = 16 * tn0 + m16, rb1_ = rb0_ + 16;
    f.a0 = *(const LAS bf16x8*)(X + XOFF(ra_, 8 * g)); f.a1 = *(const LAS bf16x8*)(X + XOFF(ra_, 32 + 8 * g));
    f.b00 = *(const LAS bf16x8*)(Y + XOFF(rb0_, 8 * g)); f.b01 = *(const LAS bf16x8*)(Y + XOFF(rb0_, 32 + 8 * g));
    f.b10 = *(const LAS bf16x8*)(Y + XOFF(rb1_, 8 * g)); f.b11 = *(const LAS bf16x8*)(Y + XOFF(rb1_, 32 + 8 * g)); }
__device__ __forceinline__ void xmma(const XF& f, f32x4 (&acc)[2]) {
    acc[0] = __builtin_amdgcn_mfma_f32_16x16x32_bf16(f.a0, f.b00, (f32x4){0.f, 0.f, 0.f, 0.f}, 0, 0, 0); acc[1] = __builtin_amdgcn_mfma_f32_16x16x32_bf16(f.a0, f.b10, (f32x4){0.f, 0.f, 0.f, 0.f}, 0, 0, 0);
    acc[0] = __builtin_amdgcn_mfma_f32_16x16x32_bf16(f.a1, f.b01, acc[0], 0, 0, 0); acc[1] = __builtin_amdgcn_mfma_f32_16x16x32_bf16(f.a1, f.b11, acc[1], 0, 0, 0); }
#define X1_L(f, Xb, Yb) xload(f, BUF(Yb), BUF(Xb), tm, tn0, m16, g)
#define X1_M(f, acc) xmma(f, acc)
#define X1_PROD(Xb, Yb) do { acc[0] = (f32x4){0.f, 0.f, 0.f, 0.f}; acc[1] = (f32x4){0.f, 0.f, 0.f, 0.f}; nt2(BUF(Yb), BUF(Xb), tm, tn0, m16, g, acc); } while (0)
#define X1_Q(q, mrow) _Pragma("unroll") for (int q = 0; q < 2; ++q) { const int mrow = 16 * (tn0 + q) + m16; (void)mrow;
#define X1_END }
#define X1_ST4(buf, mrow, v4) (*(LAS u32x2*)(BUF(buf) + XOFF(mrow, nc0)) = f32_to_bf4(v4))
#define X1_LD4(buf, mrow) bf4_to_f32(*(const LAS u32x2*)(BUF(buf) + XOFF(mrow, nc0)))
__device__ __forceinline__ void ph_x1(const P& p, unsigned char* lds_, int tid, int lane, int wave, int ublk, int ustride, int u0, int u1) {
    LAS unsigned char* LB = (LAS unsigned char*)lds_;
#define BUF(i) (LB + (i) * XB)
    LAS float* Gm = (LAS float*)BUF(8);
    LAS float* gC = (LAS float*)(LB + LDS_X);
    const int m16 = lane & 15, g = lane >> 4, tm = wave >> 1, tn0 = (wave & 1) * 2, nc0 = 16 * tm + 4 * g;
    const int half = tid >> 8, s0 = ((tid & 255) >> 4) * 4, j4 = (tid & 15) * 4;
    u32x2 inr[3][4];
#define X1_LOAD(unit) do { const int ch_ = (unit) >> 6, c_ = (unit) & 63, b_ = ch_ / 12, h_ = (ch_ % 12) >> 1, dir_ = ch_ & 1; \
        const bf16_t* f0_ = half ? WSP(O_KD, bf16_t) + (size_t)dir_ * T * 384 : WSP(O_A, bf16_t); const bf16_t* f2_ = half ? WSP(O_V, bf16_t) : WSP(O_BV, bf16_t) + (size_t)dir_ * T * 384; const bf16_t* f1_ = half ? WSP(O_R, bf16_t) : WSP(O_DEC, bf16_t) + (size_t)dir_ * T * 384; \
        _Pragma("unroll") for (int r_ = 0; r_ < 4; ++r_) { const int t_ = dir_ ? (4095 - (64 * c_ + s0 + r_)) : (64 * c_ + s0 + r_); const size_t o_ = (size_t)(b_ * 4096 + t_) * 384 + h_ * 64 + j4; \
            inr[0][r_] = *(const u32x2*)(f0_ + o_); inr[2][r_] = *(const u32x2*)(f2_ + o_); inr[1][r_] = *(const u32x2*)(f1_ + o_); } } while (0)
    int unit = u0 + ublk;
    if (unit < u1) X1_LOAD(unit);
#pragma unroll 1
    for (; unit < u1; unit += ustride) {
        if (half == 0) {
#pragma unroll
            for (int r = 0; r < 4; ++r) *(LAS f32x4*)(Gm + (s0 + r) * 68 + j4) = h4_to_f32(inr[1][r]); }
        LDS_BARRIER();
        { const int jch = tid & 63, seg = tid >> 6; LAS float* segT = (LAS float*)BUF(11);
          float gv[8];
#pragma unroll
          for (int u = 0; u < 8; ++u) gv[u] = Gm[(seg * 8 + u) * 68 + jch];
#pragma unroll
          for (int u = 1; u < 8; ++u) gv[u] = gv[u] * gv[u - 1];
          segT[seg * 64 + jch] = gv[7];
          LDS_BARRIER();
          float pre = 1.0f;
#pragma unroll
          for (int u = 0; u < 7; ++u) { const float tv = segT[u * 64 + jch]; if (u < seg) pre *= tv; }
#pragma unroll
          for (int u = 0; u < 8; ++u) Gm[(seg * 8 + u) * 68 + jch] = gv[u] * pre;
          if (seg == 7) gC[jch] = gv[7] * pre; }
        LDS_BARRIER();
        { f32x4 gg[4], gp;
#pragma unroll
          for (int r = 0; r < 4; ++r) gg[r] = *(const LAS f32x4*)(Gm + (s0 + r) * 68 + j4);
          gp = s0 > 0 ? *(const LAS f32x4*)(Gm + (s0 - 1) * 68 + j4) : (f32x4){1.f, 1.f, 1.f, 1.f};
          f32x4 m0[4], m2[4], m1[4];
#pragma unroll
          for (int r = 0; r < 4; ++r) { f32x4 gi; gi[0] = frcp(gg[r][0]); gi[1] = frcp(gg[r][1]); gi[2] = frcp(gg[r][2]); gi[3] = frcp(gg[r][3]);
              const f32x4 i0 = bf4_to_f32(inr[0][r]), i2 = bf4_to_f32(inr[2][r]);
              if (half == 0) { m0[r] = i0 * (r == 0 ? gp : gg[r - 1]); m2[r] = i2 * gi; m1[r] = m0[r]; }
              else { m0[r] = i0 * gi; m1[r] = bf4_to_f32(inr[1][r]) * gg[r]; m2[r] = i2; } }
          const int bA = half ? 2 : 0, bAT = half ? 6 : 4;
#pragma unroll
          for (int r = 0; r < 4; ++r) *(LAS u32x2*)(BUF(bA) + XOFF(s0 + r, j4)) = f32_to_bf4(m0[r]);
#pragma unroll
          for (int q = 0; q < 4; ++q) *(LAS u32x2*)(BUF(bAT) + XOFF(j4 + q, s0)) = f32_to_bf4((f32x4){m0[0][q], m0[1][q], m0[2][q], m0[3][q]});
          if (half == 0) {
#pragma unroll
              for (int r = 0; r < 4; ++r) *(LAS u32x2*)(BUF(1) + XOFF(s0 + r, j4)) = f32_to_bf4(m2[r]);
#pragma unroll
              for (int q = 0; q < 4; ++q) *(LAS u32x2*)(BUF(5) + XOFF(j4 + q, s0)) = f32_to_bf4((f32x4){m2[0][q], m2[1][q], m2[2][q], m2[3][q]});
          } else {
#pragma unroll
              for (int r = 0; r < 4; ++r) *(LAS u32x2*)(BUF(3) + XOFF(s0 + r, j4)) = f32_to_bf4(m1[r]);
#pragma unroll
              for (int q = 0; q < 4; ++q) *(LAS u32x2*)(BUF(7) + XOFF(j4 + q, s0)) = f32_to_bf4((f32x4){m2[0][q], m2[1][q], m2[2][q], m2[3][q]});
          } }
        LDS_BARRIER();
        { const int un = unit + ustride; if (un < u1) X1_LOAD(un); }
        XF fa, fb, fc, fd; f32x4 acc[2], acb[2], acd[2], ace[2];
        X1_L(fa, 0, 1); X1_L(fb, 1, 0); X1_L(fc, 2, 0);
        X1_M(fa, acc); X1_M(fb, acb); X1_M(fc, acd);
        X1_L(fa, 3, 1); X1_L(fb, 3, 2);
        X1_Q(q, mrow) f32x4 v, w, vt, vk;
#pragma unroll
            for (int i = 0; i < 4; ++i) { v[i] = (nc0 + i) < mrow ? acc[q][i] : 0.f; w[i] = v[i] + ((nc0 + i) == mrow ? 1.0f : 0.f); vt[i] = mrow < (nc0 + i) ? acb[q][i] : 0.f; vk[i] = mrow < (nc0 + i) ? acd[q][i] : 0.f; }
            X1_ST4(8, mrow, v); X1_ST4(13, mrow, w); X1_ST4(9, mrow, vt); X1_ST4(10, mrow, vk); X1_END
        X1_M(fa, acc); X1_M(fb, acb);
        X1_Q(q, mrow) f32x4 v, w;
#pragma unroll
            for (int i = 0; i < 4; ++i) { v[i] = (nc0 + i) <= mrow ? acc[q][i] : 0.f; w[i] = (nc0 + i) <= mrow ? acb[q][i] : 0.f; }
            X1_ST4(11, mrow, v); X1_ST4(12, mrow, w); X1_END
        LDS_BARRIER();
#define X1_DSTAGE(pi, pti, po, pto, wantP, li, lpt, lo, hasL) do { \
            if (wantP) X1_L(fa, pi, pti); X1_L(fb, pti, pi); if (hasL) X1_L(fc, li, lpt); \
            f32x4 lold[2]; if (hasL) { X1_Q(q, mrow) lold[q] = X1_LD4(li, mrow); X1_END } \
            if (wantP) X1_M(fa, acc); X1_M(fb, acb); if (hasL) X1_M(fc, acd); \
            X1_Q(q, mrow) if (wantP) X1_ST4(po, mrow, acc[q]); X1_ST4(pto, mrow, acb[q]); if (hasL) X1_ST4(lo, mrow, acd[q] + lold[q]); X1_END } while (0)
        X1_DSTAGE(8, 9, 0, 1, true, 0, 0, 0, false); LDS_BARRIER();
        X1_DSTAGE(0, 1, 8, 9, true, 13, 1, 2, true); LDS_BARRIER();
        X1_DSTAGE(8, 9, 0, 1, true, 2, 9, 13, true); LDS_BARRIER();
        X1_DSTAGE(0, 1, 8, 9, true, 13, 1, 2, true); LDS_BARRIER();
        X1_DSTAGE(8, 9, 0, 1, false, 2, 9, 13, true); LDS_BARRIER();
        { X1_L(fc, 13, 1); f32x4 lold[2]; X1_Q(q, mrow) lold[q] = X1_LD4(13, mrow); X1_END X1_M(fc, acd); X1_Q(q, mrow) X1_ST4(2, mrow, acd[q] + lold[q]); X1_END }
        LDS_BARRIER();
        X1_L(fa, 4, 2); X1_L(fb, 10, 2); X1_M(fa, acc); X1_M(fb, acb);
        X1_Q(q, mrow) X1_ST4(8, mrow, acc[q]); X1_ST4(9, mrow, acb[q]); X1_END
        LDS_BARRIER();
        const int udir = (unit >> 6) & 1;
        { bf16_t* PHI = WSP(O_PHI, bf16_t) + (size_t)unit * 4096; bf16_t* GMo = WSP(O_GM, bf16_t) + (size_t)unit * 4096;
          X1_L(fa, 5, 8); X1_L(fb, 5, 9); X1_L(fc, 11, 8); X1_L(fd, 11, 9);
          f32x4 ek[2], gr[2], hk[2];
          X1_Q(q, mrow) ek[q] = X1_LD4(6, mrow); gr[q] = X1_LD4(3, mrow); hk[q] = X1_LD4(12, mrow); X1_END
          X1_M(fa, acc); X1_M(fb, acb); X1_M(fc, acd); X1_M(fd, ace);
          X1_Q(q, mrow) f32x4 v; const float gc = gC[mrow];
#pragma unroll
              for (int i = 0; i < 4; ++i) v[i] = gc * (acc[q][i] + ((nc0 + i) == mrow ? 1.0f : 0.f));
              *(u32x2*)(PHI + mrow * 64 + nc0) = f32_to_bf4(v);
              X1_ST4(0, mrow, acb[q] + ek[q]);
              *(u32x2*)(GMo + (udir ? 63 - mrow : mrow) * 64 + nc0) = f32_to_bf4(acd[q] + gr[q]);
              X1_ST4(1, mrow, ace[q] + hk[q]); X1_END }
        LDS_BARRIER();
        { float* PSIT = WSP(O_PSIT, float) + (size_t)unit * 4096; bf16_t* YLT = WSP(O_YLT, bf16_t) + (size_t)unit * 4096;
          const f32x4 gc4 = *(const LAS f32x4*)(gC + nc0);
          X1_L(fa, 7, 0); X1_L(fb, 1, 7); X1_M(fa, acc); X1_M(fb, acb);
          X1_Q(q, mrow) *(f32x4*)(PSIT + mrow * 64 + nc0) = acc[q] * gc4;
              *(u32x2*)(YLT + (udir ? 63 - mrow : mrow) * 64 + nc0) = f32_to_bf4(acb[q]); X1_END }
    }
#undef BUF
#undef X1_LOAD
#undef X1_DSTAGE
}
__device__ __forceinline__ void ph_x2a(const P& p, LAS unsigned char* lds, int tid, int lane, int wave, int blk) {
    if (blk >= 48) return;
    constexpr int SLOT = 24576, NSLOT = 5;
    const int ch = blk;
    const char* PHI = (const char*)(WSP(O_PHI, bf16_t) + (size_t)ch * 64 * 4096); const char* PSIT = (const char*)(WSP(O_PSIT, float) + (size_t)ch * 64 * 4096);
    if (wave >= 4) {
        const int lw = wave - 4;
        unsigned so[6];
#pragma unroll
        for (int q = 0; q < 6; ++q) { const int piece = lw + 4 * q;
            if (piece < 8) { const int row = piece * 8 + (lane >> 3), cp = lane & 7; so[q] = (unsigned)(row * 128 + ((cp ^ (row & 7)) << 4)); }
            else { const int row = (piece - 8) * 4 + (lane >> 4), cp = lane & 15; so[q] = (unsigned)(row * 256 + ((cp ^ (row & 15)) << 4)); } }
#define X2A_ISSUE(c) do { const int cc_ = (c) < 64 ? (c) : 63; const int sl_ = (c) % NSLOT; \
        _Pragma("unroll") for (int q = 0; q < 6; ++q) { const int piece = lw + 4 * q; \
            const char* src_ = piece < 8 ? PHI + (size_t)cc_ * 8192 + so[q] : PSIT + (size_t)cc_ * 16384 + so[q]; \
            __builtin_amdgcn_global_load_lds((const unsigned*)src_, (LAS unsigned*)(lds + sl_ * SLOT + piece * 1024), 16, 0, 0); } } while (0)
        X2A_ISSUE(0); X2A_ISSUE(1); X2A_ISSUE(2); X2A_ISSUE(3);
        asm volatile("s_waitcnt vmcnt(18)" ::: "memory");
        __builtin_amdgcn_s_barrier(); asm volatile("" ::: "memory");
#pragma unroll 1
        for (int c = 0; c < 64; ++c) {
            X2A_ISSUE(c + 4);
            asm volatile("s_waitcnt vmcnt(18)" ::: "memory");
            __builtin_amdgcn_s_barrier(); asm volatile("" ::: "memory");
        }
        asm volatile("s_waitcnt vmcnt(0)" ::: "memory");
#undef X2A_ISSUE
    } else {
        const int vt = wave, m16 = lane & 15, g = lane >> 4;
        u32x4* SB = (u32x4*)(p.ws + O_SB) + (size_t)ch * 64 * 512 + vt * 128 + lane;
        f32x4 D[4] = {{0.f, 0.f, 0.f, 0.f}, {0.f, 0.f, 0.f, 0.f}, {0.f, 0.f, 0.f, 0.f}, {0.f, 0.f, 0.f, 0.f}};
        __builtin_amdgcn_s_barrier(); asm volatile("" ::: "memory");
#pragma unroll 1
        for (int c = 0; c < 64; ++c) {
            const LAS unsigned char* sl = lds + (c % NSLOT) * SLOT;
            bf16x8 bk[2];
#pragma unroll
            for (int ks = 0; ks < 2; ++ks) { u32x4 w; w.x = cvt_pk_bf16(D[2 * ks][0], D[2 * ks][1]); w.y = cvt_pk_bf16(D[2 * ks][2], D[2 * ks][3]); w.z = cvt_pk_bf16(D[2 * ks + 1][0], D[2 * ks + 1][1]); w.w = cvt_pk_bf16(D[2 * ks + 1][2], D[2 * ks + 1][3]);
                bk[ks] = __builtin_bit_cast(bf16x8, w); SB[(size_t)c * 512 + ks * 64] = w; }
#pragma unroll
            for (int tj = 0; tj < 4; ++tj) { const int row = 16 * tj + m16, rx = row & 7;
                u32x2 f[2][2];
#pragma unroll
                for (int ks = 0; ks < 2; ++ks)
#pragma unroll
                    for (int hh = 0; hh < 2; ++hh) { const int o = 64 * ks + 8 * g + 32 * hh; f[ks][hh] = *(const LAS u32x2*)(sl + row * 128 + (((o >> 4) ^ rx) << 4) + (o & 15)); }
                const int prow = 16 * vt + m16; const int pc = 4 * tj + g;
                f32x4 z = *(const LAS f32x4*)(sl + 8192 + prow * 256 + ((pc ^ (prow & 15)) << 4));
                u32x4 a0; a0.x = f[0][0].x; a0.y = f[0][0].y; a0.z = f[0][1].x; a0.w = f[0][1].y;
                u32x4 a1; a1.x = f[1][0].x; a1.y = f[1][0].y; a1.z = f[1][1].x; a1.w = f[1][1].y;
                z = __builtin_amdgcn_mfma_f32_16x16x32_bf16(__builtin_bit_cast(bf16x8, a0), bk[0], z, 0, 0, 0); z = __builtin_amdgcn_mfma_f32_16x16x32_bf16(__builtin_bit_cast(bf16x8, a1), bk[1], z, 0, 0, 0); D[tj] = z; }
            asm volatile("s_waitcnt lgkmcnt(0)" ::: "memory");
            __builtin_amdgcn_s_barrier(); asm volatile("" ::: "memory");
        }
    }
}
__device__ __forceinline__ void ph_x2b_post(const P& p, int l, LAS unsigned char* lds, int lane, int wave, int blk, int G) {
    (void)lds;
    const int m16 = lane & 15, g = lane >> 4;
    const bf16_t* V = WSP(O_V, bf16_t); const bf16_t* GATE = WSP(O_GATE, bf16_t); const float* RKB = WSP(O_RKB, float); bf16_t* MIX = WSP(O_MIX, bf16_t);
#pragma unroll 1
    for (int task = blk * 8 + wave; task < 6144; task += G * 8) {
        const int tt = task & 3, c = (task >> 2) & 63, bh = task >> 8, b = bh / 6, h = bh % 6; const int tok = b * 4096 + 64 * c + 16 * tt + m16;
        u32x2 gm[2][4]; u32x4 sb[2][8]; u32x2 yl[2][4];
#pragma unroll
        for (int dir = 0; dir < 2; ++dir) {
            const int unit = ((b * 6 + h) * 2 + dir) * 64 + (dir ? 63 - c : c);
            const bf16_t* GMi = WSP(O_GM, bf16_t) + (size_t)unit * 4096 + (16 * tt + m16) * 64 + 4 * g; const bf16_t* YL = WSP(O_YLT, bf16_t) + (size_t)unit * 4096 + (16 * tt + m16) * 64 + 4 * g;
            const u32x4* SB = (const u32x4*)(p.ws + O_SB) + (size_t)unit * 512 + lane;
#pragma unroll
            for (int k = 0; k < 4; ++k) gm[dir][k] = *(const u32x2*)(GMi + 16 * k);
#pragma unroll
            for (int k = 0; k < 8; ++k) sb[dir][k] = SB[k * 64];
#pragma unroll
            for (int vt = 0; vt < 4; ++vt) yl[dir][vt] = *(const u32x2*)(YL + 16 * vt);
        }
        u32x2 vin[4], gin[4]; f32x4 lw[4], lb[4];
#pragma unroll
        for (int vt = 0; vt < 4; ++vt) { const size_t o = (size_t)tok * 384 + h * 64 + 16 * vt + 4 * g; vin[vt] = *(const u32x2*)(V + o); gin[vt] = *(const u32x2*)(GATE + o);
            lw[vt] = *(const f32x4*)(p.in[29] + l * 384 + h * 64 + 16 * vt + 4 * g); lb[vt] = *(const f32x4*)(p.in[30] + l * 384 + h * 64 + 16 * vt + 4 * g); }
        const float rkv = RKB[tok * 8 + h];
        f32x4 yy[4]; float s = 0.f;
#pragma unroll
        for (int vt = 0; vt < 4; ++vt) { f32x4 z = bf4_to_f32(yl[0][vt]) + bf4_to_f32(yl[1][vt]);
#pragma unroll
            for (int dir = 0; dir < 2; ++dir) {
                u32x4 g0; g0.x = gm[dir][0].x; g0.y = gm[dir][0].y; g0.z = gm[dir][1].x; g0.w = gm[dir][1].y; u32x4 g1; g1.x = gm[dir][2].x; g1.y = gm[dir][2].y; g1.z = gm[dir][3].x; g1.w = gm[dir][3].y;
                z = __builtin_amdgcn_mfma_f32_16x16x32_bf16(__builtin_bit_cast(bf16x8, sb[dir][2 * vt]), __builtin_bit_cast(bf16x8, g0), z, 0, 0, 0);
                z = __builtin_amdgcn_mfma_f32_16x16x32_bf16(__builtin_bit_cast(bf16x8, sb[dir][2 * vt + 1]), __builtin_bit_cast(bf16x8, g1), z, 0, 0, 0); }
            yy[vt] = z; s += hsum4(z); }
        s += xchg16(s, lane); s += xchg32(s, lane);
        const float mean = s * (1.0f / 64.0f); float q = 0.f;
#pragma unroll
        for (int vt = 0; vt < 4; ++vt) { yy[vt] = yy[vt] - mean; q += hsum4(yy[vt] * yy[vt]); }
        q += xchg16(q, lane); q += xchg32(q, lane);
        const float rstd = rsqrtf(q * (1.0f / 64.0f) + 64e-5f);
#pragma unroll
        for (int vt = 0; vt < 4; ++vt) { const f32x4 vv = bf4_to_f32(vin[vt]), gg = bf4_to_f32(gin[vt]);
            const f32x4 out = (yy[vt] * rstd * lw[vt] + lb[vt] + rkv * vv) * gg;
            *(u32x2*)(MIX + (size_t)tok * 1024 + 256 + h * 64 + 16 * vt + 4 * g) = f32_to_bf4(out); }
    }
}

__device__ __forceinline__ void ph_router(const P& p, int l, unsigned char* lds, int tid, int lane, int wave, int blk, int G, int cnt_off) {
    constexpr int WTS = 1028;
    float* WT = (float*)lds;
    constexpr int RM = LDS_X + 512;
    int* sel = (int*)(lds + RM);
    float* gat = (float*)(lds + RM + 1024);
    int* lpos = (int*)(lds + RM + 2048);
    float* rstd_s = (float*)(lds + RM + 3072);
    int* lcnt = (int*)(lds + RM + 3328);
    int* gbase = (int*)(lds + RM + 3456);
    float* bpart = (float*)(lds + RM + 12288);
    const float* rw = p.in[34] + (size_t)l * 1024 * 32;
    const float* MOD = WSP(O_MOD, float);
    unsigned* CNT = WSP(O_CTL, unsigned) + CW_CNT + l * 64 + cnt_off;
    bf16_t* XS = WSP(O_XS, bf16_t); int* SLOT = WSP(O_SLOT, int); float* GV = WSP(O_GV, float); int* TOKT = WSP(O_YS, int);
    float* lgt = (float*)(lds + RM + 4096);
    const int m16 = lane & 15, kq = lane >> 4, ttile = wave >> 1, etile = wave & 1;
    int fb = -1;
    for (int item = blk; item < T / 64; item += G) {
        const int b = item >> 6;
        const float* m = MOD + (size_t)(l * 4 + b) * 6144;
        if (b != fb) {
            if (fb >= 0) __syncthreads();
            fb = b;
            float bs[4] = {0.f, 0.f, 0.f, 0.f};
#pragma unroll 1
            for (int i0 = 0; i0 < 16; i0 += 8) {
                f32x4 v[8]; float g2v[8], scv[8], shv[8];
#pragma unroll
                for (int i = 0; i < 8; ++i) { const int idx4 = (i0 + i) * NTHREADS + tid, d = idx4 >> 3, e4 = (idx4 & 7) * 4; v[i] = *(const f32x4*)(rw + d * 32 + e4);
                    g2v[i] = p.in[5][l * 1024 + d]; scv[i] = m[4096 + d]; shv[i] = m[3072 + d]; }
#pragma unroll
                for (int i = 0; i < 8; ++i) { const int idx4 = (i0 + i) * NTHREADS + tid, d = idx4 >> 3, e4 = (idx4 & 7) * 4; const float gm = g2v[i] * (scv[i] + 1.0f), sh = shv[i];
                    WT[(e4 + 0) * WTS + d] = v[i][0] * gm; WT[(e4 + 1) * WTS + d] = v[i][1] * gm; WT[(e4 + 2) * WTS + d] = v[i][2] * gm; WT[(e4 + 3) * WTS + d] = v[i][3] * gm;
                    bs[0] += sh * v[i][0]; bs[1] += sh * v[i][1]; bs[2] += sh * v[i][2]; bs[3] += sh * v[i][3]; } }
#pragma unroll
            for (int j = 0; j < 4; ++j) { float s = dpp_add<0x128>(bs[j]); s += xchg16(s, lane); s += xchg32(s, lane); bs[j] = s; }
            if (lane < 8) { bpart[wave * 32 + lane * 4 + 0] = bs[0]; bpart[wave * 32 + lane * 4 + 1] = bs[1]; bpart[wave * 32 + lane * 4 + 2] = bs[2]; bpart[wave * 32 + lane * 4 + 3] = bs[3]; }
        }
        if (tid < 32) lcnt[tid] = 0;
        __syncthreads();
        { const int tl = ttile * 16 + m16, row = item * 64 + tl;
          const bf16_t* xr = WSP(O_XR, bf16_t) + (size_t)row * 1024 + kq * 256; const float* wt = WT + (etile * 16 + m16) * WTS + kq * 256;
          f32x4 acc = {0.f, 0.f, 0.f, 0.f}, acc1 = {0.f, 0.f, 0.f, 0.f}; float ss = 0.f;
          u32x2 xa[8], xb[8];
#define RT_LOAD(buf, j0) do { _Pragma("unroll") for (int u_ = 0; u_ < 8; ++u_) buf[u_] = *(const u32x2*)(xr + 4 * ((j0) + u_)); } while (0)
#define RT_MMA(buf, j0) do { _Pragma("unroll") for (int u_ = 0; u_ < 8; ++u_) { const f32x4 xv = bf4_to_f32(buf[u_]); const f32x4 wv = *(const f32x4*)(wt + 4 * ((j0) + u_)); \
              ss += xv[0] * xv[0] + xv[1] * xv[1] + xv[2] * xv[2] + xv[3] * xv[3]; \
              acc = __builtin_amdgcn_mfma_f32_16x16x4f32(xv[0], wv[0], acc, 0, 0, 0); acc1 = __builtin_amdgcn_mfma_f32_16x16x4f32(xv[1], wv[1], acc1, 0, 0, 0); \
              acc = __builtin_amdgcn_mfma_f32_16x16x4f32(xv[2], wv[2], acc, 0, 0, 0); acc1 = __builtin_amdgcn_mfma_f32_16x16x4f32(xv[3], wv[3], acc1, 0, 0, 0); } } while (0)
          RT_LOAD(xa, 0); RT_LOAD(xb, 8);
#pragma unroll
          for (int jb = 0; jb < 64; jb += 16) {
              RT_MMA(xa, jb); __builtin_amdgcn_sched_barrier(0); if (jb + 16 < 64) RT_LOAD(xa, jb + 16); __builtin_amdgcn_sched_barrier(0);
              RT_MMA(xb, jb + 8); __builtin_amdgcn_sched_barrier(0); if (jb + 24 < 64) RT_LOAD(xb, jb + 24); __builtin_amdgcn_sched_barrier(0); }
#undef RT_LOAD
#undef RT_MMA
          acc = acc + acc1;
          ss += xchg16(ss, lane); ss += xchg32(ss, lane);
          if (etile == 0 && kq == 0) rstd_s[tl] = rsqrtf(ss * (1.0f / 1024.0f) + 1e-6f);
#pragma unroll
          for (int i = 0; i < 4; ++i) lgt[(ttile * 16 + 4 * kq + i) * 32 + etile * 16 + m16] = acc[i]; }
        __syncthreads();
        { const int me = lane >> 1; float rbias = p.in[35][l * 32 + me];
#pragma unroll
          for (int w = 0; w < 8; ++w) rbias += bpart[w * 32 + me];
#pragma unroll 1
          for (int it = 0; it < 8; ++it) {
            const int tl = wave * 8 + it;
            float val = lgt[tl * 32 + me] * rstd_s[tl] + rbias;
            float tv[4]; int te[4];
#pragma unroll
            for (int k = 0; k < 4; ++k) { const float mxv = wave_max_all(val); const int idx = wave_min_all(val == mxv ? me : 64); tv[k] = mxv; te[k] = idx; if (me == idx) val = -3.0e38f; }
            const float e1 = __expf(tv[1] - tv[0]), e2 = __expf(tv[2] - tv[0]), e3 = __expf(tv[3] - tv[0]); const float inv = 1.0f / (1.0f + e1 + e2 + e3);
            if (lane == 0) {
                const float gg[4] = {inv, e1 * inv, e2 * inv, e3 * inv};
#pragma unroll
                for (int k = 0; k < 4; ++k) { sel[tl * 4 + k] = te[k]; gat[tl * 4 + k] = gg[k]; lpos[tl * 4 + k] = atomicAdd(&lcnt[te[k]], 1); } }
          } }
        __syncthreads();
        if (tid < 32) gbase[tid] = (int)__hip_atomic_fetch_add(CNT + tid, (unsigned)lcnt[tid], __ATOMIC_RELAXED, __HIP_MEMORY_SCOPE_AGENT);
        __syncthreads();
        { f32x4 gmv[4], shv[4], scv_[4];
#pragma unroll
          for (int i = 0; i < 4; ++i) { const int c = i * 256 + lane * 4; gmv[i] = *(const f32x4*)(p.in[5] + l * 1024 + c); scv_[i] = *(const f32x4*)(m + 4096 + c); shv[i] = *(const f32x4*)(m + 3072 + c); }
#pragma unroll
          for (int i = 0; i < 4; ++i) gmv[i] = gmv[i] * (scv_[i] + 1.0f);
#pragma unroll 1
          for (int it0 = 0; it0 < 8; it0 += 4) {
            u32x2 xrow[4][4];
#pragma unroll
            for (int u = 0; u < 4; ++u)
#pragma unroll
                for (int i = 0; i < 4; ++i) xrow[u][i] = *(const u32x2*)(WSP(O_XR, bf16_t) + (size_t)(item * 64 + wave * 8 + it0 + u) * 1024 + i * 256 + lane * 4);
#pragma unroll
          for (int u = 0; u < 4; ++u) { const int it = it0 + u;
            const int tl = wave * 8 + it, row = item * 64 + tl; const float rstd = rstd_s[tl];
            u32x2 w[4];
#pragma unroll
            for (int i = 0; i < 4; ++i) { const f32x4 x = bf4_to_f32(xrow[u][i]);
                const f32x4 hh = x * rstd * gmv[i] + shv[i];
                w[i].x = cvt_pk_bf16(hh[0], hh[1]); w[i].y = cvt_pk_bf16(hh[2], hh[3]); }
#pragma unroll
            for (int i = 0; i < 4; ++i) *(u32x2*)(XS + (size_t)row * 1024 + i * 256 + lane * 4) = w[i];
            if (lane < 4) { const int k = lane; const int e = sel[tl * 4 + k]; const int slot = e * CAP + gbase[e] + lpos[tl * 4 + k];
                SLOT[row * 4 + k] = slot; GV[row * 4 + k] = gat[tl * 4 + k]; TOKT[slot] = row; }
          } } }
        __syncthreads();
    }
}


#if defined(__HIP_DEVICE_COMPILE__)
typedef const __attribute__((address_space(4))) P* KargPtr;
__device__ __forceinline__ P load_params() { KargPtr kp = (KargPtr)__builtin_amdgcn_kernarg_segment_ptr(); asm volatile("" : "+s"(kp)); P r;
    for (int i = 0; i < 40; ++i) r.in[i] = kp->in[i];
    r.out = kp->out; r.ws = kp->ws; r.lo = kp->lo; r.hi = kp->hi; return r; }
#else
__device__ __forceinline__ P load_params() { return P{}; }
#endif
__device__ __forceinline__ int fresh_tid(int wave_s) { asm volatile("" : "+s"(wave_s)); int ln = __builtin_amdgcn_mbcnt_hi(~0u, __builtin_amdgcn_mbcnt_lo(~0u, 0u)); asm volatile("" : "+v"(ln)); return wave_s * 64 + ln; }
#define PHASE_ENV() const P q = load_params(); int blk = blk0, G = G0; asm volatile("" : "+s"(blk), "+s"(G)); const int tid = fresh_tid(wave_s0), lane = tid & 63, wave = __builtin_amdgcn_readfirstlane(tid >> 6); (void)lane; (void)wave

constexpr int PH_PER_LAYER = 12, N_PHASES = 2 + NL * PH_PER_LAYER + 1;
__global__ void __launch_bounds__(NTHREADS, 2) enc_fwd(P p) {
    extern __shared__ __attribute__((aligned(16))) unsigned char lds[];
    const int blk0 = blockIdx.x, G0 = gridDim.x, wave_s0 = __builtin_amdgcn_readfirstlane(threadIdx.x >> 6);
    LAS unsigned char* ldsl = (LAS unsigned char*)lds;
    volatile LAS unsigned* MISC = (volatile LAS unsigned*)(ldsl + LDS_MISC);
    LAS int* moe_pre = (LAS int*)(ldsl + LDS_MISC - 256); LAS int* moe_cnt = (LAS int*)(ldsl + LDS_MISC - 512);
    if (threadIdx.x < 64) MISC[threadIdx.x] = 0u;
    __syncthreads();
#if MK_LAUNCH_PER_PHASE
#define GRID_BAR() do { } while (0)
#else
    XcdBarrier bar = xcd_barrier_post((unsigned*)(p.ws + O_CTL) + CW_BAR, MISC + 8);
#define GRID_BAR() xcd_barrier(bar)
#endif
    const int lo = p.lo, hi = p.hi;
#ifndef EN_MASK
#define EN_MASK 0xFFFFFFFFu
#endif
#define EN(j) ((EN_MASK >> (j)) & 1u)
#ifndef REP_MASK
#define REP_MASK 0u
#endif
#define PROBE_DUMMY(j) (((REP_MASK >> (j)) & 1u) && rep_ == 0)
#define REPS(j) for (int rep_ = 0; rep_ <= (int)((REP_MASK >> (j)) & 1u); ++rep_)
#define IN(k) (lo <= (k) && (k) < hi)
#define SEAM(k) do { if (IN((k) + 1)) { GRID_BAR(); if ((REP_MASK >> 14) & 1u) GRID_BAR(); } } while (0)
#define QWS(off, type) ((type*)(q.ws + (off)))

    if (EN(20) && IN(0)) REPS(20) { { PHASE_ENV(); ph_mod(q, lds, tid, blk, G); } { PHASE_ENV(); ph_convert<false>(q, 0, lds, tid, blk, G, 0, 1 << 30); } { PHASE_ENV(); ph_smallw(q, tid, blk, G); } { PHASE_ENV(); ph_s5ops(q, lds, tid, blk, G); } SEAM(0); }
    if (EN(22) && IN(1)) REPS(22) { { PHASE_ENV(); ph_s5fill(q, tid, blk, G, 0, G == 256 ? 1 : NL); } { PHASE_ENV(); ph_combine_norm(q, -1, 0, lane, wave, blk, G, QWS(O_XR, bf16_t)); } SEAM(1); }

#pragma unroll 1
    for (int l = 0; l < NL; ++l) {
        const int pb = 2 + l * PH_PER_LAYER;
        if (l > 0 && EN(0) && IN(pb + 0)) REPS(0) { PHASE_ENV(); ph_combine_norm(q, l - 1, l, lane, wave, blk, G, PROBE_DUMMY(0) ? QWS(O_HH, bf16_t) : QWS(O_XR, bf16_t)); SEAM(pb + 0); }
        if (EN(1) && IN(pb + 1)) REPS(1) { PHASE_ENV();
            pg8::GridOrder S; S.init(QWS(O_H1, bf16_t), 1024, QWS(O_WIN, bf16_t) + (size_t)l * 3072 * 1024, 1024, T, NPROJ, G, blk, 0);
            EpiBf16T<false> E{QWS(O_PROJ, bf16_t), NPROJ, nullptr, NPROJ, 0};
            pg8::gemm_phase(ldsl, 1024, 1024, 1024, S, E, tid);
            SEAM(pb + 1);
        }
        if (EN(2) && IN(pb + 2)) REPS(2) { PHASE_ENV(); ph_prepass(q, l, lane, wave, blk, G); SEAM(pb + 2); }
        if (EN(3) && IN(pb + 3)) REPS(3) {
            { PHASE_ENV(); pg8::GridOrder S; S.init(QWS(O_ZS, bf16_t), 384, QWS(O_W1C, bf16_t) + (size_t)l * 512 * 384, 384, T, 512, G, blk, 0);
              EpiLvl1 E{QWS(O_HID, bf16_t)};
              pg8::gemm_phase(ldsl, 384, 384, 384, S, E, tid); }
            { PHASE_ENV(); S5SOrder S{(const char*)QWS(O_AS5, bf16_t), (const char*)(QWS(O_WS5S, bf16_t) + (size_t)l * 16 * 256 * 1024), G, (blk - 128 + G) % G};
              EpiF32 E{QWS(O_SLOC, float), 256};
              pg8::gemm_phase(ldsl, 1024, 1280, 1024, S, E, tid); }
            { PHASE_ENV(); if (G == 256) { if (blk >= 144) ph_convert<true>(q, l, lds, tid, blk - 144, 112, 0, CONV_EARLY);
                                             else if (blk < 128) ph_convert<true>(q, l, lds, tid, blk, 128, CONV_EARLY, CONV_EARLY + CONV_EARLY2); } }
            SEAM(pb + 3);
        }
        if (EN(4) && IN(pb + 4)) REPS(4) {
            { PHASE_ENV(); pg8::GridOrder S; S.init(QWS(O_HID, bf16_t), 384, QWS(O_W2B, bf16_t) + (size_t)l * 2048 * 384, 384, T, 2048, G, blk, 0);
              EpiLvl2 E{q.in[18] + l * 768, q.in[21] + l * 768, q.in[27] + l * 384, q.ws};
              pg8::gemm_phase(ldsl, 384, 384, 384, S, E, tid); }
            { PHASE_ENV(); ph_s5carry(q, l, tid, blk); }
            SEAM(pb + 4);
        }
        if (EN(5) && IN(pb + 5)) REPS(5) {
            { PHASE_ENV(); S5YOrder S{(const char*)QWS(O_AS5, bf16_t), (const char*)(QWS(O_WS5Y, bf16_t) + (size_t)l * 16 * 1024 * 1280), G, blk};
              EpiS5Y E{QWS(O_YG, bf16_t)};
              pg8::gemm_phase(ldsl, 1280, 1280, 1280, S, E, tid); }
            { PHASE_ENV(); if (G > 64) { if (blk >= 64) ph_na(q, l, lds, tid, lane, wave, blk - 64, G - 64); } else ph_na(q, l, lds, tid, lane, wave, blk, G); }
            { PHASE_ENV(); if (G == 256) { if (blk < 64) ph_x1(q, lds, tid, lane, wave, blk, 64, 0, 896); else ph_x1(q, lds, tid, lane, wave, blk - 64, 192, 896, 3072); } else ph_x1(q, lds, tid, lane, wave, blk, G, 0, 3072); }
            SEAM(pb + 5);
        }
        if (EN(6) && IN(pb + 6)) REPS(6) {
            { PHASE_ENV(); ph_x2a(q, ldsl, tid, lane, wave, blk); }
            { PHASE_ENV(); pg8::GridOrder S; S.init(QWS(O_YG, bf16_t), 256, QWS(O_WGLU, bf16_t) + (size_t)l * 65536, 256, T, 256, G, blk, 192 % G);
              EpiGlu E{QWS(O_YG, bf16_t), QWS(O_MIX, bf16_t)};
              pg8::gemm_phase(ldsl, 256, 256, 256, S, E, tid); }
            { PHASE_ENV();
              if (G == 256) { constexpr int t0 = CONV_EARLY + CONV_EARLY2, rr = 6144 - t0, ta = t0 + (336 * rr) / 6144, tb = t0 + (1936 * rr) / 6144;
                  if (blk < 48) ph_convert<true>(q, l, lds, tid, blk, 48, t0, ta); else if (blk >= 192) ph_convert<true>(q, l, lds, tid, blk - 192, 64, ta, tb); else ph_convert<true>(q, l, lds, tid, blk - 48, 144, tb, 6144); }
              else if (G > 48) { if (blk >= 48) ph_convert<true>(q, l, lds, tid, blk - 48, G - 48, 480, 6144); else ph_convert<true>(q, l, lds, tid, blk, 48, 0, 480); } else ph_convert<true>(q, l, lds, tid, blk, G, 0, 6144); }
            SEAM(pb + 6);
        }
        if (EN(7) && IN(pb + 7)) REPS(7) { PHASE_ENV(); ph_x2b_post(q, l, ldsl, lane, wave, blk, G); SEAM(pb + 7); }
        if (EN(8) && IN(pb + 8)) REPS(8) { PHASE_ENV();
            pg8::GridOrder S; S.init(QWS(O_MIX, bf16_t), 1024, QWS(O_WOUT, bf16_t) + (size_t)l * 1024 * 1024, 1024, T, 1024, G, blk, 0);
            EpiWout E{PROBE_DUMMY(8) ? QWS(O_HH, bf16_t) : QWS(O_XR, bf16_t), QWS(O_MOD, float) + (size_t)(l * 4) * 6144 + 2048};
            pg8::gemm_phase(ldsl, 1024, 1024, 1024, S, E, tid);
            SEAM(pb + 8);
        }
        if (EN(9) && IN(pb + 9)) REPS(9) { PHASE_ENV(); ph_router(q, l, lds, tid, lane, wave, blk, G, PROBE_DUMMY(9) ? 32 : 0); SEAM(pb + 9); }
        if ((EN(10) && IN(pb + 10)) || (EN(11) && IN(pb + 11))) {
            PHASE_ENV();
            if (tid < 32) moe_cnt[tid] = (int)__hip_atomic_load(QWS(O_CTL, unsigned) + CW_CNT + l * 64 + tid, __ATOMIC_RELAXED, __HIP_MEMORY_SCOPE_AGENT);
            __syncthreads();
            if (tid == 0) { int run = 0; for (int e = 0; e < 32; ++e) { moe_pre[e] = run; run += (moe_cnt[e] + 255) >> 8; } moe_pre[32] = run; }
            __syncthreads();
        }
        if (EN(10) && IN(pb + 10)) REPS(10) { PHASE_ENV();
            LAS unsigned* tokl = (LAS unsigned*)(ldsl + LDS_X);
            MoeOrderT<true> S{moe_pre, (const char*)QWS(O_XS, bf16_t), (const char*)(QWS(O_EW1, bf16_t) + (size_t)l * NE * 2048 * 1024), G, blk, 8, (size_t)256 * 1024 * 2, tokl};
            { const int* TOKT = QWS(O_YS, int);
              int tv_[MOE_NTAB / 2]; bool ok_[MOE_NTAB / 2];
#pragma unroll
              for (int k_ = 0; k_ < MOE_NTAB / 2; ++k_) { const int idx = k_ * NTHREADS + tid, ui_ = idx >> 8, r_ = idx & 255; Unit u_; const bool has_ = S.next(ui_, u_);
                  const int orow_ = has_ ? u_.orow : 0, e_ = has_ ? u_.aux : 0; ok_[k_] = has_ && ((orow_ & (CAP - 1)) + r_ < moe_cnt[e_]); tv_[k_] = TOKT[ok_[k_] ? orow_ + r_ : 0]; }
#pragma unroll
              for (int k_ = 0; k_ < MOE_NTAB / 2; ++k_) tokl[k_ * NTHREADS + tid] = ok_[k_] ? (unsigned)tv_[k_] * 2048u : 0u;
              __syncthreads(); }
            EpiSwiglu E{QWS(O_HH, bf16_t), q.in[37] + (size_t)l * NE * 2048};
            pg8::gemm_phase(ldsl, 1024, 1024, 1024, S, E, tid);
            if (G == 256 && l + 1 < NL && rep_ == 0) { PHASE_ENV(); const int nrb = moe_pre[32], rem_rb = nrb & 31, nshort = (32 - rem_rb) * 8; const int q_ = (blk & 7) * 4 + ((blk >> 3) & 3);
                if (rem_rb == 0 || nshort < 64) ph_s5fill(q, tid, blk, G, l + 1, l + 2);
                else if (q_ >= rem_rb) ph_s5fill(q, tid, (q_ - rem_rb) * 8 + (blk >> 5), nshort, l + 1, l + 2); }
            SEAM(pb + 10);
        }
        if (EN(11) && IN(pb + 11)) REPS(11) { PHASE_ENV();
            MoeOrderT<false> S{moe_pre, (const char*)QWS(O_HH, bf16_t), (const char*)(QWS(O_EW2, bf16_t) + (size_t)l * NE * 1024 * 1024), G, blk, 4, (size_t)256 * 1024 * 2, nullptr};
            EpiBf16T<true> E{QWS(O_XS, bf16_t), 1024, q.in[39] + (size_t)l * NE * 1024, 1024, 1024};
            pg8::gemm_phase(ldsl, 1024, 1024, 1024, S, E, tid);
            SEAM(pb + 11);
        }
    }
    if (EN(21) && IN(N_PHASES - 1)) { PHASE_ENV(); ph_combine_norm(q, NL - 1, NL, lane, wave, blk, G, nullptr); }
}

extern "C" void kernel_launch(void* const* d_in, const int* in_sizes, int n_in, void* d_out, int out_size, void* d_ws, size_t ws_size, hipStream_t stream) {
    static int grid = 0;
    if (grid == 0) {
        if (n_in != 40 || out_size != T * D || ws_size < WS_END) { fprintf(stderr, "kernel_launch: unexpected shapes (n_in %d out %d ws %zu)\n", n_in, out_size, ws_size); grid = -1; return; }
        int dev = 0, cus = 0, per_cu = 0;
        if (hipGetDevice(&dev) != hipSuccess || hipDeviceGetAttribute(&cus, hipDeviceAttributeMultiprocessorCount, dev) != hipSuccess) { grid = -1; return; }
        if (hipFuncSetAttribute((const void*)enc_fwd, hipFuncAttributeMaxDynamicSharedMemorySize, LDS_BYTES) != hipSuccess) { fprintf(stderr, "kernel_launch: hipFuncSetAttribute failed\n"); grid = -1; return; }
        if (hipOccupancyMaxActiveBlocksPerMultiprocessor(&per_cu, (const void*)enc_fwd, NTHREADS, LDS_BYTES) != hipSuccess || per_cu < 1) fprintf(stderr, "kernel_launch: occupancy query reports %d\n", per_cu);
        (void)hipGetLastError();
        if (cus * MOE_NTAB < 2304) { fprintf(stderr, "kernel_launch: %d CUs: too few for the expert GEMM's row-offset table\n", cus); grid = -1; return; }
        grid = cus;
    }
    if (grid < 0) return;
    (void)hipMemsetAsync((char*)d_ws + O_CTL, 0, CTL_BYTES, stream);
    P a{};
    for (int i = 0; i < 40; ++i) a.in[i] = (const float*)d_in[i];
    a.out = (float*)d_out; a.ws = (unsigned char*)d_ws;
#if MK_LAUNCH_PER_PHASE
    for (int ph = 0; ph < N_PHASES; ++ph) { a.lo = ph; a.hi = ph + 1; hipLaunchKernelGGL(enc_fwd, dim3(grid), dim3(NTHREADS), LDS_BYTES, stream, a); }
#else
    a.lo = 0; a.hi = N_PHASES;
    hipLaunchKernelGGL(enc_fwd, dim3(grid), dim3(NTHREADS), LDS_BYTES, stream, a);
#endif
}
```

```cpp
#include <hip/hip_runtime.h>
#include <cstdio>
#include <cstdint>

#define LAS __attribute__((address_space(3)))
typedef unsigned short bf16_t;
typedef short bf16x8 __attribute__((ext_vector_type(8)));
typedef short s16x4 __attribute__((ext_vector_type(4)));
typedef float f32x4 __attribute__((ext_vector_type(4)));
typedef float f32x2 __attribute__((ext_vector_type(2)));
typedef unsigned u32x4 __attribute__((ext_vector_type(4)));
typedef unsigned u32x2 __attribute__((ext_vector_type(2)));

#ifndef MK_LAUNCH_PER_PHASE
#define MK_LAUNCH_PER_PHASE 0
#endif

constexpr int T = 16384, D = 1024, NL = 4, SEQ = 4096, NE = 32, CAP = 16384;
constexpr int NPROJ = 3072;
constexpr int NTHREADS = 512;
constexpr size_t MiB = 1u << 20;
constexpr size_t O_CTL = 0, CTL_BYTES = 1 * MiB;
constexpr size_t O_MOD = 1 * MiB;
constexpr size_t O_S5M = 1 * MiB + 512 * 1024;
constexpr size_t O_WIN = 2 * MiB;
constexpr size_t O_WOUT = 26 * MiB;
constexpr size_t O_W1C = 34 * MiB;
constexpr size_t O_W2B = 36 * MiB;
constexpr size_t O_WGLU = 42 * MiB;
constexpr size_t O_WS5S = 43 * MiB;
constexpr size_t O_WS5Y = 75 * MiB;
constexpr size_t O_EW1 = 235 * MiB;
constexpr size_t O_EW2 = 747 * MiB;
constexpr size_t O_H1 = 1003 * MiB;
constexpr size_t O_PROJ = 1035 * MiB;
constexpr size_t O_ZS = 1131 * MiB;
constexpr size_t O_HID = 1143 * MiB;
constexpr size_t O_QN = 1155 * MiB;
constexpr size_t O_KN = 1167 * MiB;
constexpr size_t O_R = 1179 * MiB;
constexpr size_t O_K = 1203 * MiB;
constexpr size_t O_V = 1227 * MiB;
constexpr size_t O_A = 1251 * MiB;
constexpr size_t O_GATE = 1275 * MiB;
constexpr size_t O_DEC = 1299 * MiB;
constexpr size_t O_KD = 1347 * MiB;
constexpr size_t O_BV = 1395 * MiB;
constexpr size_t O_YS = 1443 * MiB;
constexpr size_t O_KT = O_YS + 40 * MiB;
constexpr size_t O_XR = O_YS + 8 * MiB;
constexpr size_t O_RKB = 1491 * MiB;
constexpr size_t O_AS5 = 1492 * MiB;
constexpr size_t O_SLOC = 1502 * MiB;
constexpr size_t O_YG = 1506 * MiB;
constexpr size_t O_MIX = 1514 * MiB;
constexpr size_t O_SLOT = 1546 * MiB;
constexpr size_t O_GV = 1547 * MiB;
constexpr size_t O_XS = 1548 * MiB;
constexpr size_t O_HH = 2572 * MiB;
constexpr size_t O_PHI = O_HH, O_GM = O_HH + 32 * MiB, O_PSIT = O_HH + 64 * MiB, O_YLT = O_HH + 128 * MiB, O_SB = O_HH + 192 * MiB;
constexpr size_t WS_END = 3596 * MiB;
constexpr int CW_BAR = 4096;
constexpr int CW_CNT = 8192;
constexpr int LDS_BYTES = 147456;
constexpr int LDS_MISC = 147456 - 256;
constexpr int LDS_X = 131072;

struct P { const float* in[40]; float* out; unsigned char* ws; int lo, hi; };

typedef __bf16 bf16x2_t __attribute__((ext_vector_type(2)));
__device__ __forceinline__ unsigned cvt_pk_bf16(float lo, float hi) { const f32x2 v = {lo, hi}; return __builtin_bit_cast(unsigned, __builtin_convertvector(v, bf16x2_t)); }
__device__ __forceinline__ float bf2f(bf16_t v) { return __uint_as_float(((unsigned)v) << 16); }
__device__ __forceinline__ bf16_t f2bf(float f) { unsigned u = __float_as_uint(f); u += 0x7FFFu + ((u >> 16) & 1u); return (bf16_t)(u >> 16); }
__device__ __forceinline__ float wsum(float v) {
#pragma unroll
    for (int o = 32; o > 0; o >>= 1) v += __shfl_xor(v, o);
    return v; }
__device__ __forceinline__ float wmaxf(float v) {
#pragma unroll
    for (int o = 32; o > 0; o >>= 1) v = fmaxf(v, __shfl_xor(v, o));
    return v; }
__device__ __forceinline__ int wmini(int v) {
#pragma unroll
    for (int o = 32; o > 0; o >>= 1) v = min(v, __shfl_xor(v, o));
    return v; }
__device__ __forceinline__ float frcp(float x) { return __builtin_amdgcn_rcpf(x); }
__device__ __forceinline__ float sigmoidf_(float x) { return frcp(1.0f + __expf(-x)); }
__device__ __forceinline__ float gelu_tanh(float x) { const float u = 0.7978845608f * (x + 0.044715f * x * x * x); return x * frcp(1.0f + __expf(-2.0f * u)); }

__device__ __forceinline__ f32x4 bf4_to_f32(u32x2 v) { f32x4 r; r[0] = __uint_as_float(v.x << 16); r[1] = __uint_as_float(v.x & 0xFFFF0000u); r[2] = __uint_as_float(v.y << 16); r[3] = __uint_as_float(v.y & 0xFFFF0000u); return r; }
__device__ __forceinline__ u32x2 f32_to_bf4(f32x4 v) { u32x2 w; w.x = cvt_pk_bf16(v[0], v[1]); w.y = cvt_pk_bf16(v[2], v[3]); return w; }
__device__ __forceinline__ unsigned f2h_bits(float f) { return (unsigned)__builtin_bit_cast(unsigned short, (_Float16)f); }
__device__ __forceinline__ float h2f_bits(unsigned h) { return (float)__builtin_bit_cast(_Float16, (unsigned short)h); }
__device__ __forceinline__ u32x2 f32_to_h4(f32x4 v) { u32x2 w; w.x = f2h_bits(v[0]) | (f2h_bits(v[1]) << 16); w.y = f2h_bits(v[2]) | (f2h_bits(v[3]) << 16); return w; }
__device__ __forceinline__ f32x4 h4_to_f32(u32x2 w) { f32x4 r; r[0] = h2f_bits(w.x & 0xFFFFu); r[1] = h2f_bits(w.x >> 16); r[2] = h2f_bits(w.y & 0xFFFFu); r[3] = h2f_bits(w.y >> 16); return r; }
__device__ __forceinline__ float hsum4(f32x4 v) { return (v[0] + v[1]) + (v[2] + v[3]); }
template <int CTRL> __device__ __forceinline__ float dpp_add(float v) { return v + __builtin_bit_cast(float, __builtin_amdgcn_update_dpp(0, __builtin_bit_cast(int, v), CTRL, 0xF, 0xF, true)); }
__device__ __forceinline__ float row16_sum(float v) { v = dpp_add<0xB1>(v); v = dpp_add<0x4E>(v); v = dpp_add<0x124>(v); v = dpp_add<0x128>(v); return v; }

template <int CTRL> __device__ __forceinline__ float dpp_mov(float v) { return __builtin_bit_cast(float, __builtin_amdgcn_update_dpp(0, __builtin_bit_cast(int, v), CTRL, 0xF, 0xF, true)); }
template <int CTRL> __device__ __forceinline__ int dpp_movi(int v) { return __builtin_amdgcn_update_dpp(0, v, CTRL, 0xF, 0xF, true); }
__device__ __forceinline__ void swap16(float& a, float& b) { asm volatile("s_nop 1\n\tv_permlane16_swap_b32 %0, %1\n\ts_nop 0" : "+v"(a), "+v"(b)); }
__device__ __forceinline__ void swap32(float& a, float& b) { asm volatile("s_nop 1\n\tv_permlane32_swap_b32 %0, %1\n\ts_nop 0" : "+v"(a), "+v"(b)); }
__device__ __forceinline__ float xchg16(float send, int lane) { float a = send, b = send; swap16(a, b); return (lane & 16) ? a : b; }
__device__ __forceinline__ float xchg32(float send, int lane) { float a = send, b = send; swap32(a, b); return (lane & 32) ? a : b; }
__device__ __forceinline__ float wave_sum_all(float v) { v = row16_sum(v); { float a = v, b = v; swap16(a, b); v = a + b; } { float a = v, b = v; swap32(a, b); v = a + b; } return v; }
__device__ __forceinline__ float wave_max_all(float v) { v = fmaxf(v, dpp_mov<0xB1>(v)); v = fmaxf(v, dpp_mov<0x4E>(v)); v = fmaxf(v, dpp_mov<0x124>(v)); v = fmaxf(v, dpp_mov<0x128>(v));
    { float a = v, b = v; swap16(a, b); v = fmaxf(a, b); } { float a = v, b = v; swap32(a, b); v = fmaxf(a, b); } return v; }
__device__ __forceinline__ int wave_min_all(int v) { v = min(v, dpp_movi<0xB1>(v)); v = min(v, dpp_movi<0x4E>(v)); v = min(v, dpp_movi<0x124>(v)); v = min(v, dpp_movi<0x128>(v));
    { float a = __builtin_bit_cast(float, v), b = a; swap16(a, b); v = min(__builtin_bit_cast(int, a), __builtin_bit_cast(int, b)); } { float a = __builtin_bit_cast(float, v), b = a; swap32(a, b); v = min(__builtin_bit_cast(int, a), __builtin_bit_cast(int, b)); } return v; }


#define LDS_BARRIER() do { asm volatile("s_waitcnt lgkmcnt(0)" ::: "memory"); __builtin_amdgcn_s_barrier(); asm volatile("" ::: "memory"); } while (0)

#define XB_TMO      128
#define XB_XCNT(j)  (256  + 64 * (j))
#define XB_XSUB(j)  (1280 + 64 * (j))
#define XB_XGEN(j)  (2304 + 64 * (j))
#define XB_TOP      3328
#define XB_TOPGEN   3392
#define XCD_BAR_WORDS 3456
#define XB_SPIN_CAP (1u << 22)
__device__ __forceinline__ unsigned xb_ld(unsigned* p)              { return __hip_atomic_load(p, __ATOMIC_RELAXED, __HIP_MEMORY_SCOPE_AGENT); }
__device__ __forceinline__ unsigned xb_add(unsigned* p, unsigned v) { return __hip_atomic_fetch_add(p, v, __ATOMIC_RELAXED, __HIP_MEMORY_SCOPE_AGENT); }
__device__ __forceinline__ unsigned xb_xcc_id() { return (unsigned)__builtin_amdgcn_s_getreg((3 << 11) | 20) & 0xFu; }
#define XB_SPIN(cond, bar) do { unsigned _sp = 0; while (cond) { __builtin_amdgcn_s_sleep(1); \
    if ((++_sp & 255u) == 0u) { if (xb_ld(&(bar)[XB_TMO])) break; if (_sp > XB_SPIN_CAP) { atomicAdd(&(bar)[XB_TMO], 1u); break; } } } } while (0)
struct XcdBarrier { unsigned* bar; unsigned x; volatile LAS unsigned* st; };
__device__ __forceinline__ XcdBarrier xcd_barrier_post(unsigned* bar, volatile LAS unsigned* st) {
    XcdBarrier b; b.bar = bar; b.x = xb_xcc_id(); b.st = st;
    if (threadIdx.x == 0) (void)xb_add(&bar[XB_XCNT(b.x)], 1u);
    return b;
}
__device__ __forceinline__ void xcd_barrier_complete(unsigned* bar, unsigned x, unsigned& nloc, unsigned& nx) {
    const unsigned G = gridDim.x * gridDim.y * gridDim.z;
    unsigned sum, cnt, mine, sp = 0u;
    for (;;) {
        sum = 0u; cnt = 0u; mine = 0u;
#pragma unroll
        for (unsigned j = 0; j < 16; ++j) { const unsigned c = xb_ld(&bar[XB_XCNT(j)]); sum += c; cnt += (c > 0u) ? 1u : 0u; mine = (j == x) ? c : mine; }
        if (sum == G) break;
        __builtin_amdgcn_s_sleep(1);
        if ((++sp & 255u) == 0u) { if (xb_ld(&bar[XB_TMO])) break; if (sp > XB_SPIN_CAP) { atomicAdd(&bar[XB_TMO], 1u); break; } }
    }
    nloc = mine > 0u ? mine : 1u; nx = cnt > 0u ? cnt : 1u;
}
__device__ __forceinline__ void xcd_barrier(const XcdBarrier& b) {
    asm volatile("s_waitcnt vmcnt(0)" ::: "memory");
    __syncthreads();
    if (threadIdx.x == 0) {
        unsigned* bar = b.bar;
        __builtin_amdgcn_s_waitcnt(0);
        unsigned nloc = b.st[0], nx = b.st[1];
        if (nloc == 0u) { xcd_barrier_complete(bar, b.x, nloc, nx); b.st[0] = nloc; b.st[1] = nx; }
        const unsigned old = xb_add(&bar[XB_XSUB(b.x)], 1u);
        const unsigned gen = old / nloc;
        if (old + 1u == (gen + 1u) * nloc) {
            __builtin_amdgcn_fence(__ATOMIC_RELEASE, "agent");
            asm volatile("s_waitcnt vmcnt(0)" ::: "memory");
            const unsigned og = xb_add(&bar[XB_TOP], 1u);
            const unsigned tg = og / nx;
            if (og + 1u == (tg + 1u) * nx) xb_add(&bar[XB_TOPGEN], 1u);
            else XB_SPIN(xb_ld(&bar[XB_TOPGEN]) == tg, bar);
            __builtin_amdgcn_fence(__ATOMIC_ACQUIRE, "agent");
            xb_add(&bar[XB_XGEN(b.x)], 1u);
            asm volatile("s_waitcnt vmcnt(0)" ::: "memory");
        } else {
            XB_SPIN(xb_ld(&bar[XB_XGEN(b.x)]) == gen, bar);
            __builtin_amdgcn_fence(__ATOMIC_ACQUIRE, "agent");
            asm volatile("s_waitcnt vmcnt(0)" ::: "memory");
        }
    }
    __syncthreads();
}

namespace pg8 {
constexpr int BM = 256, BK = 64, HALF = 128, HTB = HALF * BK * 2, STAGE_BYTES = 8 * HTB, NXCD = 8, WGM = 8;
__host__ __device__ __forceinline__ int lds_byte(int r, int c) { const int st = (r >> 4) * 2 + (c >> 5), rr = r & 15, cc = c & 31, ob = rr * 64 + cc * 2; return st * 1024 + (ob ^ (((ob >> 9) & 1) << 5)); }
__host__ __device__ __forceinline__ void stage_rc(int b, int& R, int& C) { const int st = b / 1024, sb = b % 1024, swz = sb ^ (((sb >> 9) & 1) << 5); R = (st >> 1) * 16 + swz / 64; C = (st & 1) * 32 + (swz % 64) / 2; }
__host__ __device__ __forceinline__ int perm32(int rho) { const int n = rho >> 4, i = rho & 15; return 8 * (i >> 2) + 4 * n + (i & 3); }

struct Unit { const char* a; const char* b; int orow, ocol, aux; };

template <class Epi, class Sched>
__device__ __forceinline__ void gemm_phase(LAS unsigned char* lds, const int K, const int lda, const int ldb, const Sched& S, const Epi& E, const int tid_in) {
    const int tid = tid_in, wid = __builtin_amdgcn_readfirstlane(tid >> 6), lane = tid & 63, wr = wid >> 2, wc = wid & 3, fr = lane & 15, fq = lane >> 4;
    const int nt = K / BK;
    constexpr bool GA = Sched::GATHER;
    unsigned voffA[2], voffB[2]; int rowA[2]; unsigned gc[2][2], gn[2][2];
#pragma unroll
    for (int i = 0; i < 2; ++i) { int R, C; stage_rc(tid * 16 + i * 8192, R, C); const int Rb = Epi::PERM ? ((R & ~31) + perm32(R & 31)) : R;
        voffA[i] = GA ? (unsigned)C * 2u : (unsigned)(R * lda + C) * 2u; voffB[i] = (unsigned)(Rb * ldb + C) * 2u; rowA[i] = R; }
#define PG8_GLOAD(g, ui_) do { if constexpr (GA) { _Pragma("unroll") for (int h_ = 0; h_ < 2; ++h_) _Pragma("unroll") for (int i_ = 0; i_ < 2; ++i_) g[h_][i_] = S.tok_off((ui_), h_ * 128 + rowA[i_]) + voffA[i_]; } } while (0)
#define PG8_STAGE_A(bufoff, base, kb, h, g) do { if constexpr (GA) { _Pragma("unroll") for (int _i = 0; _i < 2; ++_i) \
        __builtin_amdgcn_global_load_lds((const unsigned*)((const char*)(base) + (kb) + g[h][_i]), (LAS unsigned*)(lds + (bufoff) + ldsw + _i * 8192), 16, 0, 0); } \
        else PG8_STAGE(bufoff, (base) + (kb) + (h) * hstepA, voffA); } while (0)
    const size_t kstep = (size_t)(BK * 2);
    const size_t hstepA = (size_t)HALF * lda * 2, hstepB = (size_t)HALF * ldb * 2;
    const unsigned ldsw = (unsigned)wid * 1024u;
    const int aoff = lds_byte(wr * 64 + fr, fq * 8), boff = lds_byte(wc * 32 + fr, fq * 8);
#define PG8_SA(b, h) (((b) * 2 + (h)) * HTB)
#define PG8_SB(b, h) ((4 + (b) * 2 + (h)) * HTB)
#define PG8_STAGE(bufoff, gbase, voff) do { _Pragma("unroll") for (int _i = 0; _i < 2; ++_i) \
        __builtin_amdgcn_global_load_lds((const unsigned*)((const char*)(gbase) + (voff)[_i]), (LAS unsigned*)(lds + (bufoff) + ldsw + _i * 8192), 16, 0, 0); } while (0)
#define PG8_LDA(dst, b, h) do { _Pragma("unroll") for (int m = 0; m < 4; ++m) _Pragma("unroll") for (int k = 0; k < 2; ++k) dst[m][k] = *(const LAS bf16x8*)(lds + PG8_SA(b, h) + aoff + m * 2048 + k * 1024); } while (0)
#define PG8_LDB(dst, b, h) do { _Pragma("unroll") for (int n = 0; n < 2; ++n) _Pragma("unroll") for (int k = 0; k < 2; ++k) dst[n][k] = *(const LAS bf16x8*)(lds + PG8_SB(b, h) + boff + n * 2048 + k * 1024); } while (0)
#define PG8_MMA(ai, bj, At, Bt) do { __builtin_amdgcn_s_setprio(1); _Pragma("unroll") for (int m = 0; m < 4; ++m) _Pragma("unroll") for (int n = 0; n < 2; ++n) _Pragma("unroll") for (int k = 0; k < 2; ++k) \
        acc[ai][bj][m][n] = __builtin_amdgcn_mfma_f32_16x16x32_bf16(Bt[n][k], At[m][k], acc[ai][bj][m][n], 0, 0, 0); __builtin_amdgcn_s_setprio(0); } while (0)
#define PG8_WAIT_V(n) asm volatile("s_waitcnt vmcnt(" #n ")" ::: "memory")
#define PG8_WAIT_L(n) asm volatile("s_waitcnt lgkmcnt(" #n ")" ::: "memory")
#define PG8_BAR __builtin_amdgcn_s_barrier()
#define PG8_SCHED __builtin_amdgcn_sched_barrier(0)
    Unit cur, nxt; int ui = 0;
    if (!S.next(0, cur)) return;
    f32x4 acc[2][2][4][2];
#pragma unroll
    for (int a = 0; a < 2; ++a)
#pragma unroll
        for (int b = 0; b < 2; ++b)
#pragma unroll
            for (int m = 0; m < 4; ++m)
#pragma unroll
                for (int n = 0; n < 2; ++n) acc[a][b][m][n] = (f32x4){0.f, 0.f, 0.f, 0.f};
    bf16x8 At[4][2], B0[2][2], B1[2][2];
    const char* cA = cur.a; const char* cB = cur.b;
    PG8_GLOAD(gc, 0);
    PG8_STAGE(PG8_SB(0, 0), cB, voffB); PG8_STAGE(PG8_SB(0, 1), cB + hstepB, voffB); PG8_STAGE_A(PG8_SA(0, 0), cA, 0, 0, gc); PG8_STAGE_A(PG8_SA(0, 1), cA, 0, 1, gc);
    if (wr == 1) PG8_BAR;
    PG8_WAIT_V(2); PG8_BAR;
    PG8_STAGE(PG8_SB(1, 0), cB + kstep, voffB); PG8_STAGE_A(PG8_SA(1, 0), cA, kstep, 0, gc); PG8_STAGE(PG8_SB(1, 1), cB + hstepB + kstep, voffB);
    PG8_WAIT_V(6); PG8_BAR;
    for (;;) {
        const bool has_next = S.next(ui + 1, nxt);
        const char* nA = has_next ? nxt.a : cA; const char* nB = has_next ? nxt.b : cB;
        if constexpr (GA) { if (has_next) PG8_GLOAD(gn, ui + 1); else {
#pragma unroll
            for (int h_ = 0; h_ < 2; ++h_)
#pragma unroll
                for (int i_ = 0; i_ < 2; ++i_) gn[h_][i_] = gc[h_][i_]; } }
#pragma unroll 1
        for (int t = 0; t < nt; t += 2) {
            const bool last = (t == nt - 2);
            const size_t k1 = (size_t)(t + 1) * kstep, k2 = last ? (size_t)0 : (size_t)(t + 2) * kstep, k3 = k2 + kstep;
            const char* a2 = last ? nA : cA; const char* b2 = last ? nB : cB;
            unsigned g2[2][2];
#pragma unroll
            for (int h_ = 0; h_ < 2; ++h_)
#pragma unroll
                for (int i_ = 0; i_ < 2; ++i_) g2[h_][i_] = GA ? (last ? gn[h_][i_] : gc[h_][i_]) : 0u;
            PG8_LDB(B0, 0, 0); PG8_LDB(B1, 0, 1); PG8_SCHED; PG8_LDA(At, 0, 0); PG8_STAGE_A(PG8_SA(1, 1), cA, k1, 1, gc);
            PG8_WAIT_V(8); PG8_WAIT_L(0); PG8_BAR; PG8_MMA(0, 0, At, B0); PG8_MMA(0, 1, At, B1); PG8_BAR; PG8_SCHED;
            PG8_LDA(At, 0, 1); PG8_STAGE(PG8_SB(0, 0), b2 + k2, voffB); PG8_STAGE(PG8_SB(0, 1), b2 + k2 + hstepB, voffB); PG8_STAGE_A(PG8_SA(0, 0), a2, k2, 0, g2);
            PG8_WAIT_V(8); PG8_WAIT_L(0); PG8_BAR; PG8_MMA(1, 0, At, B0); PG8_MMA(1, 1, At, B1); PG8_BAR; PG8_SCHED;
            PG8_LDB(B0, 1, 0); PG8_LDB(B1, 1, 1); PG8_SCHED; PG8_LDA(At, 1, 0); PG8_STAGE_A(PG8_SA(0, 1), a2, k2, 1, g2);
            PG8_WAIT_V(8); PG8_WAIT_L(0); PG8_BAR; PG8_MMA(0, 0, At, B0); PG8_MMA(0, 1, At, B1); PG8_BAR; PG8_SCHED;
            PG8_LDA(At, 1, 1); PG8_STAGE(PG8_SB(1, 0), b2 + k3, voffB); PG8_STAGE(PG8_SB(1, 1), b2 + k3 + hstepB, voffB); PG8_STAGE_A(PG8_SA(1, 0), a2, k3, 0, g2);
            PG8_WAIT_V(8); PG8_WAIT_L(0); PG8_BAR; PG8_MMA(1, 0, At, B0); PG8_MMA(1, 1, At, B1); PG8_BAR; PG8_SCHED;
        }
        if (wr == 0) PG8_BAR;
        E(acc, cur, wr, wc, fr, fq);
        if constexpr (Epi::DRAIN) __builtin_amdgcn_s_waitcnt(0x0F70);
        if (!has_next) break;
#pragma unroll
        for (int a = 0; a < 2; ++a)
#pragma unroll
            for (int b = 0; b < 2; ++b)
#pragma unroll
                for (int m = 0; m < 4; ++m)
#pragma unroll
                    for (int n = 0; n < 2; ++n) acc[a][b][m][n] = (f32x4){0.f, 0.f, 0.f, 0.f};
        cur = nxt; cA = nA; cB = nB; ++ui;
        if constexpr (GA) {
#pragma unroll
            for (int h_ = 0; h_ < 2; ++h_)
#pragma unroll
                for (int i_ = 0; i_ < 2; ++i_) gc[h_][i_] = gn[h_][i_]; }
        if (wr == 1) PG8_BAR;
    }
    PG8_WAIT_V(0);
    PG8_BAR;
#undef PG8_SA
#undef PG8_SB
#undef PG8_STAGE
#undef PG8_STAGE_A
#undef PG8_GLOAD
#undef PG8_LDA
#undef PG8_LDB
#undef PG8_MMA
#undef PG8_WAIT_V
#undef PG8_WAIT_L
#undef PG8_BAR
#undef PG8_SCHED
}

struct GridOrder {
    static constexpr bool GATHER = false; __device__ __forceinline__ unsigned tok_off(int, int) const { return 0u; }
    const char* A; const char* B; size_t tA, tB; int nM, nN, nwg, G, c;
    __device__ __forceinline__ void init(const void* A_, int lda, const void* B_, int ldb, int M, int N, int G_, int blk, int off) {
        A = (const char*)A_; B = (const char*)B_; tA = (size_t)256 * lda * 2; tB = (size_t)256 * ldb * 2; nM = M / BM; nN = N / BM; nwg = nM * nN; G = G_; c = (blk - off + G_) % G_; }
    __device__ __forceinline__ bool next(int i, Unit& u) const {
        const long L = (long)i * G + c; if (L >= nwg) return false;
        int wgid = (int)L; { const int q = nwg / NXCD, r = nwg % NXCD, xcd = wgid % NXCD, off = wgid / NXCD; wgid = (xcd < r ? xcd * (q + 1) : r * (q + 1) + (xcd - r) * q) + off; }
        const int nig = WGM * nN, gid = wgid / nig, fm = gid * WGM, gsz = (nM - fm) < WGM ? (nM - fm) : WGM;
        const int pm = fm + ((wgid % nig) % gsz), pn = (wgid % nig) / gsz;
        u.a = A + (size_t)pm * tA; u.b = B + (size_t)pn * tB; u.orow = pm * BM; u.ocol = pn * BM; u.aux = 0; return true;
    }
};
}
using pg8::Unit;

#define EPI_LOOP_ROWS for (int ai = 0; ai < 2; ++ai) _Pragma("unroll") for (int m = 0; m < 4; ++m)
template <bool DRAIN_> struct EpiBf16T {
    static constexpr bool PERM = true, DRAIN = DRAIN_;
    bf16_t* O; int ldc; const float* bias; int ncols;
    int biasld;
    __device__ __forceinline__ void operator()(const f32x4 (&acc)[2][2][4][2], const Unit& u, int wr, int wc, int fr, int fq) const {
        const int row0 = u.orow + wr * 64 + fr, col0 = u.ocol + wc * 32 + 8 * fq;
        f32x4 bv[2][2];
#pragma unroll
        for (int bj = 0; bj < 2; ++bj)
#pragma unroll
            for (int n = 0; n < 2; ++n) bv[bj][n] = bias ? *(const f32x4*)(bias + (size_t)u.aux * biasld + col0 + bj * 128 + 4 * n) : (f32x4){0.f, 0.f, 0.f, 0.f};
#pragma unroll
        EPI_LOOP_ROWS { bf16_t* rowp = O + (size_t)(row0 + ai * 128 + m * 16) * ldc + col0;
#pragma unroll
            for (int bj = 0; bj < 2; ++bj) { if (col0 + bj * 128 < ncols) { const f32x4 v0 = acc[ai][bj][m][0] + bv[bj][0], v1 = acc[ai][bj][m][1] + bv[bj][1];
                u32x4 w; w.x = cvt_pk_bf16(v0[0], v0[1]); w.y = cvt_pk_bf16(v0[2], v0[3]); w.z = cvt_pk_bf16(v1[0], v1[1]); w.w = cvt_pk_bf16(v1[2], v1[3]);
                *(u32x4*)(rowp + bj * 128) = w; } } }
    }
};
struct EpiLvl1 {
    static constexpr bool PERM = true, DRAIN = false;
    bf16_t* O;
    __device__ __forceinline__ void operator()(const f32x4 (&acc)[2][2][4][2], const Unit& u, int wr, int wc, int fr, int fq) const {
        const int row0 = u.orow + wr * 64 + fr, col0 = u.ocol + wc * 32 + 8 * fq;
#pragma unroll
        EPI_LOOP_ROWS { bf16_t* rowp = O + (size_t)(row0 + ai * 128 + m * 16) * 384 + col0;
#pragma unroll
            for (int bj = 0; bj < 2; ++bj) { const int c = col0 + bj * 128; if (c < 384) { f32x4 v0 = acc[ai][bj][m][0], v1 = acc[ai][bj][m][1];
#pragma unroll
                for (int j = 0; j < 4; ++j) {
                    if (c < 128) { v0[j] = 1.0f - 2.0f * frcp(__expf(2.0f * fminf(fmaxf(v0[j], -15.f), 15.f)) + 1.0f); v1[j] = 1.0f - 2.0f * frcp(__expf(2.0f * fminf(fmaxf(v1[j], -15.f), 15.f)) + 1.0f); }
                    else if (c >= 256) { v0[j] = sigmoidf_(v0[j]); v1[j] = sigmoidf_(v1[j]); } }
                u32x4 w; w.x = cvt_pk_bf16(v0[0], v0[1]); w.y = cvt_pk_bf16(v0[2], v0[3]); w.z = cvt_pk_bf16(v1[0], v1[1]); w.w = cvt_pk_bf16(v1[2], v1[3]);
                *(u32x4*)(rowp + bj * 128) = w; } } }
    }
};
struct EpiLvl2 {
    static constexpr bool PERM = false, DRAIN = false;
    const float* w0; const float* a0; const float* k_a;
    unsigned char* ws;
    template <int BJ, int N_>
    __device__ __forceinline__ void part(const f32x4 (&acc)[2][2][4][2], int row0, int col0) const {
        const int c = col0 + BJ * 128 + N_ * 16;
        const int seg = c / 384, cc = c - seg * 384;
        if (seg < 2) {
            bf16_t* DEC = (bf16_t*)(ws + O_DEC) + (size_t)seg * T * 384;
            const f32x4 w0v = *(const f32x4*)(w0 + seg * 384 + cc);
#pragma unroll
            for (int ai = 0; ai < 2; ++ai)
#pragma unroll
                for (int m = 0; m < 4; ++m) { const size_t ro = (size_t)(row0 + ai * 128 + m * 16) * 384 + cc; f32x4 o;
#pragma unroll
                    for (int j = 0; j < 4; ++j) { const float pre = w0v[j] + acc[ai][BJ][m][N_][j]; o[j] = __expf(-0.60653065971f * sigmoidf_(pre)); }
                    *(u32x2*)(DEC + ro) = f32_to_h4(o); }
        } else if (seg < 4) {
            const int d = seg - 2; const f32x4 a0v = *(const f32x4*)(a0 + d * 384 + cc), kav = *(const f32x4*)(k_a + cc);
            const bf16_t* Kb = (const bf16_t*)(ws + O_K); const bf16_t* Ab = (const bf16_t*)(ws + O_A);
            bf16_t* KD = (bf16_t*)(ws + O_KD) + (size_t)d * T * 384; bf16_t* BV = (bf16_t*)(ws + O_BV) + (size_t)d * T * 384;
            u32x2 kraw[2][4], araw[2][4];
#pragma unroll
            for (int ai = 0; ai < 2; ++ai)
#pragma unroll
                for (int m = 0; m < 4; ++m) { const size_t ro = (size_t)(row0 + ai * 128 + m * 16) * 384 + cc; kraw[ai][m] = *(const u32x2*)(Kb + ro); araw[ai][m] = *(const u32x2*)(Ab + ro); }
#pragma unroll
            for (int ai = 0; ai < 2; ++ai)
#pragma unroll
                for (int m = 0; m < 4; ++m) { const size_t ro = (size_t)(row0 + ai * 128 + m * 16) * 384 + cc; const f32x4 kv = bf4_to_f32(kraw[ai][m]), av = bf4_to_f32(araw[ai][m]); f32x4 okd, obv;
#pragma unroll
                    for (int j = 0; j < 4; ++j) { const float as = sigmoidf_(a0v[j] + acc[ai][BJ][m][N_][j]); okd[j] = kv[j] * (1.0f + (as - 1.0f) * kav[j]); obv[j] = -av[j] * as; }
                    *(u32x2*)(KD + ro) = f32_to_bf4(okd); *(u32x2*)(BV + ro) = f32_to_bf4(obv); }
        } else if (seg == 4) {
            bf16_t* GATE = (bf16_t*)(ws + O_GATE);
#pragma unroll
            for (int ai = 0; ai < 2; ++ai)
#pragma unroll
                for (int m = 0; m < 4; ++m) { const size_t ro = (size_t)(row0 + ai * 128 + m * 16) * 384 + cc; *(u32x2*)(GATE + ro) = f32_to_bf4(acc[ai][BJ][m][N_]); }
        }
    }
    __device__ __forceinline__ void operator()(const f32x4 (&acc)[2][2][4][2], const Unit& u, int wr, int wc, int fr, int fq) const {
        const int row0 = u.orow + wr * 64 + fr, col0 = u.ocol + wc * 32 + 4 * fq;
        part<0, 0>(acc, row0, col0); part<0, 1>(acc, row0, col0); part<1, 0>(acc, row0, col0); part<1, 1>(acc, row0, col0);
    }
};
struct EpiF32 {
    static constexpr bool PERM = false, DRAIN = false;
    float* C; int ldc;
    __device__ __forceinline__ void operator()(const f32x4 (&acc)[2][2][4][2], const Unit& u, int wr, int wc, int fr, int fq) const {
        const int row0 = u.orow + wr * 64 + fr, col0 = u.ocol + wc * 32 + 4 * fq;
#pragma unroll
        EPI_LOOP_ROWS { float* rowp = C + (size_t)(row0 + ai * 128 + m * 16) * ldc + col0;
#pragma unroll
            for (int bj = 0; bj < 2; ++bj)
#pragma unroll
                for (int n = 0; n < 2; ++n) *(f32x4*)(rowp + bj * 128 + n * 16) = acc[ai][bj][m][n]; }
    }
};
struct EpiS5Y {
    static constexpr bool PERM = true, DRAIN = false;
    bf16_t* YG;
    __device__ __forceinline__ void operator()(const f32x4 (&acc)[2][2][4][2], const Unit& u, int wr, int wc, int fr, int fq) const {
        const int row0 = u.orow + wr * 64 + fr, col0 = u.ocol + wc * 32 + 8 * fq;
#pragma unroll
        EPI_LOOP_ROWS { const int chunk = row0 + ai * 128 + m * 16;
#pragma unroll
            for (int bj = 0; bj < 2; ++bj) { const int nn = col0 + bj * 128, t = nn >> 4, ho = nn & 15; const f32x4 v0 = acc[ai][bj][m][0], v1 = acc[ai][bj][m][1];
                u32x4 w; w.x = cvt_pk_bf16(gelu_tanh(v0[0]), gelu_tanh(v0[1])); w.y = cvt_pk_bf16(gelu_tanh(v0[2]), gelu_tanh(v0[3])); w.z = cvt_pk_bf16(gelu_tanh(v1[0]), gelu_tanh(v1[1])); w.w = cvt_pk_bf16(gelu_tanh(v1[2]), gelu_tanh(v1[3]));
                *(u32x4*)(YG + (size_t)(chunk * 64 + t) * 256 + u.aux * 16 + ho) = w; } }
    }
};
struct EpiGlu {
    static constexpr bool PERM = true, DRAIN = false;
    const bf16_t* YG; bf16_t* MIX;
    __device__ __forceinline__ void operator()(const f32x4 (&acc)[2][2][4][2], const Unit& u, int wr, int wc, int fr, int fq) const {
        const int row0 = u.orow + wr * 64 + fr, col0 = u.ocol + wc * 32 + 8 * fq;
        u32x4 yraw[2][4][2];
#pragma unroll
        EPI_LOOP_ROWS {
#pragma unroll
            for (int bj = 0; bj < 2; ++bj) yraw[ai][m][bj] = *(const u32x4*)(YG + (size_t)(row0 + ai * 128 + m * 16) * 256 + col0 + bj * 128); }
#pragma unroll
        EPI_LOOP_ROWS { const size_t row = (size_t)(row0 + ai * 128 + m * 16);
#pragma unroll
            for (int bj = 0; bj < 2; ++bj) { const int c = col0 + bj * 128; const u32x4 yv = yraw[ai][m][bj]; const f32x4 v0 = acc[ai][bj][m][0], v1 = acc[ai][bj][m][1];
                float y[8]; y[0] = __uint_as_float(yv.x << 16); y[1] = __uint_as_float(yv.x & 0xFFFF0000u); y[2] = __uint_as_float(yv.y << 16); y[3] = __uint_as_float(yv.y & 0xFFFF0000u);
                y[4] = __uint_as_float(yv.z << 16); y[5] = __uint_as_float(yv.z & 0xFFFF0000u); y[6] = __uint_as_float(yv.w << 16); y[7] = __uint_as_float(yv.w & 0xFFFF0000u);
                u32x4 w; w.x = cvt_pk_bf16(y[0] * sigmoidf_(v0[0]), y[1] * sigmoidf_(v0[1])); w.y = cvt_pk_bf16(y[2] * sigmoidf_(v0[2]), y[3] * sigmoidf_(v0[3]));
                w.z = cvt_pk_bf16(y[4] * sigmoidf_(v1[0]), y[5] * sigmoidf_(v1[1])); w.w = cvt_pk_bf16(y[6] * sigmoidf_(v1[2]), y[7] * sigmoidf_(v1[3]));
                *(u32x4*)(MIX + row * 1024 + c) = w; } }
    }
};
struct EpiWout {
    static constexpr bool PERM = false, DRAIN = false;
    bf16_t* X; const float* gate;
    __device__ __forceinline__ void operator()(const f32x4 (&acc)[2][2][4][2], const Unit& u, int wr, int wc, int fr, int fq) const {
        const int row0 = u.orow + wr * 64 + fr, col0 = u.ocol + wc * 32 + 4 * fq; const int b = u.orow >> 12;
        f32x4 gv[2][2];
#pragma unroll
        for (int bj = 0; bj < 2; ++bj)
#pragma unroll
            for (int n = 0; n < 2; ++n) gv[bj][n] = *(const f32x4*)(gate + (size_t)b * 6144 + col0 + bj * 128 + n * 16);
        u32x2 old[2][4][2][2];
#pragma unroll
        for (int ai = 0; ai < 2; ++ai)
#pragma unroll
            for (int m = 0; m < 4; ++m)
#pragma unroll
                for (int bj = 0; bj < 2; ++bj)
#pragma unroll
                    for (int n = 0; n < 2; ++n) old[ai][m][bj][n] = *(const u32x2*)(X + (size_t)(row0 + ai * 128 + m * 16) * 1024 + col0 + bj * 128 + n * 16);
#pragma unroll
        for (int ai = 0; ai < 2; ++ai)
#pragma unroll
            for (int m = 0; m < 4; ++m)
#pragma unroll
                for (int bj = 0; bj < 2; ++bj)
#pragma unroll
                    for (int n = 0; n < 2; ++n) *(u32x2*)(X + (size_t)(row0 + ai * 128 + m * 16) * 1024 + col0 + bj * 128 + n * 16) = f32_to_bf4(bf4_to_f32(old[ai][m][bj][n]) + gv[bj][n] * acc[ai][bj][m][n]);
    }
};
struct EpiSwiglu {
    static constexpr bool PERM = true, DRAIN = false;
    bf16_t* HH; const float* b1;
    __device__ __forceinline__ void operator()(const f32x4 (&acc)[2][2][4][2], const Unit& u, int wr, int wc, int fr, int fq) const {
        const int row0 = u.orow + wr * 64 + fr, col0 = u.ocol + wc * 32 + 8 * fq;
        f32x4 bv[2][2];
#pragma unroll
        for (int bj = 0; bj < 2; ++bj)
#pragma unroll
            for (int n = 0; n < 2; ++n) bv[bj][n] = *(const f32x4*)(b1 + (size_t)u.aux * 2048 + col0 + bj * 128 + 4 * n);
#pragma unroll
        EPI_LOOP_ROWS { bf16_t* rowp = HH + (size_t)(row0 + ai * 128 + m * 16) * 1024 + (col0 >> 1);
#pragma unroll
            for (int bj = 0; bj < 2; ++bj) { const f32x4 v0 = acc[ai][bj][m][0] + bv[bj][0], v1 = acc[ai][bj][m][1] + bv[bj][1];
                float o[4];
#pragma unroll
                for (int j = 0; j < 4; ++j) { const float g = fminf(j < 2 ? v0[2 * j] : v1[2 * j - 4], 7.0f); const float li = fminf(fmaxf(j < 2 ? v0[2 * j + 1] : v1[2 * j - 3], -7.0f), 7.0f);
                    o[j] = g * sigmoidf_(1.702f * g) * (li + 1.0f); }
                u32x2 w; w.x = cvt_pk_bf16(o[0], o[1]); w.y = cvt_pk_bf16(o[2], o[3]);
                *(u32x2*)(rowp + bj * 64) = w; } }
    }
};

struct S5SOrder {
    static constexpr bool GATHER = false; __device__ __forceinline__ unsigned tok_off(int, int) const { return 0u; }
    const char* A; const char* B; int G, c;
    __device__ __forceinline__ bool next(int i, Unit& u) const { const int L = i * G + c; if (L >= 16) return false;
        u.a = A + (size_t)L * 256 * 1280 * 2; u.b = B + (size_t)L * 256 * 1024 * 2; u.orow = L * 256; u.ocol = 0; u.aux = L; return true; }
};
struct S5YOrder {
    static constexpr bool GATHER = false; __device__ __forceinline__ unsigned tok_off(int, int) const { return 0u; }
    const char* A; const char* B; int G, c;
    __device__ __forceinline__ bool next(int i, Unit& u) const { const int L = i * G + c; if (L >= 64) return false; const int g = L >> 2, pn = L & 3;
        u.a = A + (size_t)g * 256 * 1280 * 2; u.b = B + (size_t)(g * 1024 + pn * 256) * 1280 * 2; u.orow = 0; u.ocol = pn * 256; u.aux = g; return true; }
};
template <bool GATHER_> struct MoeOrderT {
    static constexpr bool GATHER = GATHER_;
    const LAS int* pre; const char* A; const char* B; int G, c, npn; size_t tB; const LAS unsigned* tokl;
    __device__ __forceinline__ unsigned tok_off(int ui, int r) const { return tokl[ui * 256 + r]; }
    __device__ __forceinline__ bool next(int i, Unit& u) const {
        int rbg, pn;
        if (G == 256) { const int xcd = c & 7, j = c >> 3; if (npn == 8) { rbg = i * 32 + xcd * 4 + (j & 3); pn = j >> 2; } else { rbg = i * 64 + xcd * 8 + (j & 7); pn = j >> 3; } }
        else { const int L = i * G + c; rbg = L / npn; pn = L - rbg * npn; }
        if (rbg >= pre[32]) return false;
        int e = 0;
#pragma unroll 1
        for (int s = 16; s > 0; s >>= 1) if (pre[e + s] <= rbg) e += s;
        const int rb = rbg - pre[e];
        u.a = GATHER_ ? A : A + (size_t)(e * 64 + rb) * (256 * 1024 * 2); u.b = B + (size_t)(e * npn + pn) * tB; u.orow = (e * 64 + rb) * 256; u.ocol = pn * 256; u.aux = e; return true;
    }
};
constexpr int CONV_EARLY = 336;
constexpr int MOE_NTAB = 14;

#define WSP(off, type) ((type*)(p.ws + (off)))

__device__ __forceinline__ void ph_mod(const P& p, unsigned char* lds, int tid, int blk, int G) {
    float* cond = (float*)lds;
    float* red = cond + 4096;
    for (int i = tid; i < 4096; i += NTHREADS) { const float c = p.in[1][i]; cond[i] = c / (1.0f + __expf(-c)); }
    __syncthreads();
    float* MOD = WSP(O_MOD, float);
    for (int item = blk; item < 256; item += G) {
        const int l = item >> 6, cb = item & 63;
        const int col = tid % 96, part = tid / 96;
        if (part < 5) {
            float a0 = 0.f, a1 = 0.f, a2 = 0.f, a3 = 0.f;
            const int d0 = part * 205, d1 = min(1024, d0 + 205);
            const float* w = p.in[2] + (size_t)l * 1024 * 6144 + cb * 96 + col;
            for (int db = d0; db < d1; db += 32) {
                float wv[32];
#pragma unroll
                for (int u = 0; u < 32; ++u) { const int d = min(db + u, d1 - 1); wv[u] = w[(size_t)d * 6144]; }
#pragma unroll
                for (int u = 0; u < 32; ++u) { const int d = db + u; const float x = d < d1 ? wv[u] : 0.f; const int dc = min(d, 1023); a0 += cond[dc] * x; a1 += cond[1024 + dc] * x; a2 += cond[2048 + dc] * x; a3 += cond[3072 + dc] * x; } }
            red[(part * 4 + 0) * 96 + col] = a0; red[(part * 4 + 1) * 96 + col] = a1; red[(part * 4 + 2) * 96 + col] = a2; red[(part * 4 + 3) * 96 + col] = a3;
        }
        __syncthreads();
        if (tid < 384) { const int b = tid / 96, c2 = tid % 96; float s = 0.f;
            for (int q = 0; q < 5; ++q) s += red[(q * 4 + b) * 96 + c2];
            MOD[(size_t)(l * 4 + b) * 6144 + cb * 96 + c2] = s + p.in[3][l * 6144 + cb * 96 + c2]; }
        __syncthreads();
    }
}

struct ConvTile { const float* src; bf16_t* dst; int N, kt, nt; };
__device__ __forceinline__ void conv_load(const ConvTile& t, int tid, f32x4 (&r)[8]) {
#pragma unroll
    for (int i = 0; i < 8; ++i) { const int idx = i * NTHREADS + tid, kk = idx >> 6, n = t.nt * 256 + (idx & 63) * 4;
        r[i] = (f32x4){0.f, 0.f, 0.f, 0.f};
        if (n < t.N) r[i] = __builtin_nontemporal_load((const f32x4*)(t.src + (size_t)(t.kt * 64 + kk) * t.N + n)); }
}
__device__ __forceinline__ void conv_to_lds(int tid, const f32x4 (&r)[8], float* tile) {
#pragma unroll
    for (int i = 0; i < 8; ++i) { const int idx = i * NTHREADS + tid, kk = idx >> 6, n4 = (idx & 63) * 4; float* d = tile + kk * 257 + n4; d[0] = r[i][0]; d[1] = r[i][1]; d[2] = r[i][2]; d[3] = r[i][3]; }
}
__device__ __forceinline__ void conv_from_lds(const ConvTile& t, int tid, const float* tile) {
    const int n = tid >> 1, kh = tid & 1; bf16_t* d = t.dst + (size_t)(t.nt * 256 + n) * 1024 + t.kt * 64 + kh * 32;
#pragma unroll
    for (int q = 0; q < 4; ++q) { float f[8];
#pragma unroll
        for (int j = 0; j < 8; ++j) f[j] = tile[(kh * 32 + q * 8 + j) * 257 + n];
        u32x4 w; w.x = cvt_pk_bf16(f[0], f[1]); w.y = cvt_pk_bf16(f[2], f[3]); w.z = cvt_pk_bf16(f[4], f[5]); w.w = cvt_pk_bf16(f[6], f[7]);
        *(u32x4*)(d + q * 8) = w; }
}
__device__ __forceinline__ bool conv_tile_a(const P& p, int g, ConvTile& t) {
    if (g < NL * 192) { const int l = g / 192, r = g % 192; t.src = p.in[6] + (size_t)l * 1024 * 2944; t.dst = WSP(O_WIN, bf16_t) + (size_t)l * 3072 * 1024; t.N = 2944; t.kt = r / 12; t.nt = r % 12; return true; }
    g -= NL * 192;
    if (g < NL * 64) { const int l = g >> 6, r = g & 63; t.src = p.in[7] + (size_t)l * 1024 * 1024; t.dst = WSP(O_WOUT, bf16_t) + (size_t)l * 1024 * 1024; t.N = 1024; t.kt = r >> 2; t.nt = r & 3; return true; }
    return false;
}
__device__ __forceinline__ bool conv_tile_b(const P& p, int l, int g, ConvTile& t) {
    if (g < 4096) { const int e = g >> 7, r = g & 127; t.src = p.in[36] + (size_t)(l * NE + e) * 1024 * 2048; t.dst = WSP(O_EW1, bf16_t) + (size_t)(l * NE + e) * 2048 * 1024; t.N = 2048; t.kt = r >> 3; t.nt = r & 7; return true; }
    g -= 4096;
    if (g < 2048) { const int e = g >> 6, r = g & 63; t.src = p.in[38] + (size_t)(l * NE + e) * 1024 * 1024; t.dst = WSP(O_EW2, bf16_t) + (size_t)(l * NE + e) * 1024 * 1024; t.N = 1024; t.kt = r >> 2; t.nt = r & 3; return true; }
    return false;
}
template <bool LIST_B> __device__ __forceinline__ void ph_convert(const P& p, int l, unsigned char* lds, int tid, int cblk, int CG, int g0, int g1) {
    float* tile = (float*)lds;
    ConvTile ta, tb, tc, tn; f32x4 ra[8], rb[8], rc[8];
    int g = g0 + cblk;
#define CONV_NEXT(t, has) do { has = g < g1 && (LIST_B ? conv_tile_b(p, l, g, t) : conv_tile_a(p, g, t)); g += CG; } while (0)
    bool ha, hb, hc, hn;
    CONV_NEXT(ta, ha); CONV_NEXT(tb, hb); CONV_NEXT(tc, hc);
    if (ha) conv_load(ta, tid, ra);
    if (hb) conv_load(tb, tid, rb);
    if (hc) conv_load(tc, tid, rc);
#define CONV_STEP(t, r, h) do { conv_to_lds(tid, r, tile); CONV_NEXT(tn, hn); if (hn) conv_load(tn, tid, r); LDS_BARRIER(); conv_from_lds(t, tid, tile); LDS_BARRIER(); t = tn; h = hn; } while (0)
#pragma unroll 1
    while (ha) {
        CONV_STEP(ta, ra, ha);
        if (!hb) break;
        CONV_STEP(tb, rb, hb);
        if (!hc) break;
        CONV_STEP(tc, rc, hc);
    }
#undef CONV_NEXT
#undef CONV_STEP
}
__device__ __forceinline__ void ph_smallw(const P& p, int tid, int blk, int G) {
    bf16_t* W1C = WSP(O_W1C, bf16_t); bf16_t* W2B = WSP(O_W2B, bf16_t); bf16_t* WGLU = WSP(O_WGLU, bf16_t);
    const int gt = blk * NTHREADS + tid, gs = G * NTHREADS;
    for (int idx = gt; idx < NL * 512 * 384; idx += gs) { const int l = idx / (512 * 384), r = idx % (512 * 384), n = r / 384, k = r % 384; float v = 0.f;
        if (n < 64) v = p.in[19][((size_t)(l * 2 + 0) * 384 + k) * 64 + n];
        else if (n < 128) v = p.in[19][((size_t)(l * 2 + 1) * 384 + k) * 64 + n - 64];
        else if (n < 192) v = p.in[22][((size_t)(l * 2 + 0) * 384 + k) * 64 + n - 128];
        else if (n < 256) v = p.in[22][((size_t)(l * 2 + 1) * 384 + k) * 64 + n - 192];
        else if (n < 384) v = p.in[24][((size_t)l * 384 + k) * 128 + n - 256];
        W1C[idx] = f2bf(v); }
    for (int idx = gt; idx < NL * 2048 * 384; idx += gs) { const int l = idx / (2048 * 384), r = idx % (2048 * 384), n = r / 384, k = r % 384; float v = 0.f;
        if (n < 1920) { const int seg = n / 384, cc = n % 384;
            if (seg == 0) { if (k < 64) v = p.in[20][((size_t)(l * 2 + 0) * 64 + k) * 384 + cc]; }
            else if (seg == 1) { if (k >= 64 && k < 128) v = p.in[20][((size_t)(l * 2 + 1) * 64 + k - 64) * 384 + cc]; }
            else if (seg == 2) { if (k >= 128 && k < 192) v = p.in[23][((size_t)(l * 2 + 0) * 64 + k - 128) * 384 + cc]; }
            else if (seg == 3) { if (k >= 192 && k < 256) v = p.in[23][((size_t)(l * 2 + 1) * 64 + k - 192) * 384 + cc]; }
            else { if (k >= 256) v = p.in[25][((size_t)l * 128 + k - 256) * 384 + cc]; } }
        W2B[idx] = f2bf(v); }
    for (int idx = gt; idx < NL * 256 * 256; idx += gs) { const int l = idx >> 16, n = (idx >> 8) & 255, k = idx & 255; WGLU[idx] = f2bf(p.in[16][((size_t)l * 256 + k) * 256 + n]); }
}
__device__ __forceinline__ void cpowz(double zre, double zim, int n, float& ore, float& oim) {
    const float mag = __expf((float)(zre * (double)n));
    double rev = zim * (double)n * 0.15915494309189535; rev -= rint(rev);
    const float r = (float)rev;
    ore = mag * __builtin_amdgcn_cosf(r); oim = mag * __builtin_amdgcn_sinf(r);
}
__device__ __forceinline__ void ph_s5ops(const P& p, unsigned char* lds, int tid, int blk, int G) {
    double* zr = (double*)lds;
    double* zi = zr + 128;
    float* qre = (float*)(zi + 128);
    float* qim = qre + 128;
    float* bbr = qim + 128;
    float* bbi = bbr + 2048;
    float* ccr = bbi + 2048;
    float* cci = ccr + 2048;
    float* pwr = cci + 2048;
    float* pwi = pwr + 320;
    float* kt = pwi + 320;
    for (int item = blk; item < NL * 16 * 64; item += G) {
        const int l = item >> 10, g = (item >> 6) & 15, j = item & 63;
        if (tid < 128) { const int dir = tid >> 6, pp = tid & 63; const int li = ((l * 2 + dir) * 16 + g) * 64 + pp;
            const double lre = (double)p.in[8][li], lim = (double)p.in[9][li]; const double dt = exp((double)p.in[10][(l * 2 + dir) * 16 + g]);
            const double zre = lre * dt, zim = lim * dt; zr[tid] = zre; zi[tid] = zim;
            float er, ei; cpowz(zre, zim, 1, er, ei);
            const double nr = (double)er - 1.0, ni = (double)ei, den = lre * lre + lim * lim;
            qre[tid] = (float)((nr * lre + ni * lim) / den); qim[tid] = (float)((ni * lre - nr * lim) / den);
            if (j == 0) { float m64r, m64i; cpowz(zre, zim, 64, m64r, m64i); float* S5M = WSP(O_S5M, float); S5M[(size_t)li * 2] = m64r; S5M[(size_t)li * 2 + 1] = m64i; } }
        __syncthreads();
        { float brv[4], biv[4], crv[4], civ[4];
#pragma unroll
          for (int k = 0; k < 4; ++k) { const int i = k * NTHREADS + tid; const int dir = i >> 10, pp = (i >> 4) & 63;
            const size_t gi = ((size_t)((l * 2 + dir) * 16 + g) * 64 + pp) * 16 + (i & 15);
            const int ho = (i >> 6) & 15, p2 = i & 63;
            const size_t ci = ((size_t)((l * 2 + dir) * 16 + g) * 16 + ho) * 64 + p2;
            brv[k] = p.in[11][gi]; biv[k] = p.in[12][gi]; crv[k] = p.in[13][ci]; civ[k] = p.in[14][ci]; }
#pragma unroll
          for (int k = 0; k < 4; ++k) { const int i = k * NTHREADS + tid; const int dir = i >> 10, pp = (i >> 4) & 63;
            const float qr = qre[dir * 64 + pp], qi = qim[dir * 64 + pp];
            bbr[i] = qr * brv[k] - qi * biv[k]; bbi[i] = qr * biv[k] + qi * brv[k]; ccr[i] = crv[k]; cci[i] = civ[k]; } }
        if (tid < 320) { const int tb = tid >> 6, pp = tid & 63; float a, b;
            if (tb < 2) cpowz(zr[tb * 64 + pp], zi[tb * 64 + pp], j, a, b);
            else if (tb == 2) cpowz(zr[pp], zi[pp], j + 1, a, b);
            else if (tb == 3) cpowz(zr[64 + pp], zi[64 + pp], 64 - j, a, b);
            else cpowz(zr[pp], zi[pp], 63 - j, a, b);
            pwr[tid] = a; pwi[tid] = b; }
        __syncthreads();
        bf16_t* Wy = WSP(O_WS5Y, bf16_t) + (size_t)(l * 16 + g) * 1024 * 1280;
        bf16_t* Ws = WSP(O_WS5S, bf16_t) + (size_t)(l * 16 + g) * 256 * 1024;
        if (tid < 128) { const int dir = tid >> 6, ln = tid & 63, i16 = ln & 15, kq = ln >> 4;
            f32x4 acc = {0.f, 0.f, 0.f, 0.f};
#pragma unroll 4
            for (int st = 0; st < 16; ++st) { const int pp = 4 * st + kq;
                const float cr = ccr[(dir * 16 + i16) * 64 + pp], ci = cci[(dir * 16 + i16) * 64 + pp], wr_ = pwr[dir * 64 + pp], wi_ = pwi[dir * 64 + pp];
                const float tr = cr * wr_ - ci * wi_, ti = cr * wi_ + ci * wr_;
                acc = __builtin_amdgcn_mfma_f32_16x16x4f32(tr, bbr[(dir * 64 + pp) * 16 + i16], acc, 0, 0, 0);
                acc = __builtin_amdgcn_mfma_f32_16x16x4f32(-ti, bbi[(dir * 64 + pp) * 16 + i16], acc, 0, 0, 0); }
            float* KT = WSP(O_KT, float) + ((size_t)((l * 16 + g) * 2 + dir) * 64 + j) * 256;
#pragma unroll
            for (int r = 0; r < 4; ++r) KT[(4 * kq + r) * 16 + i16] = acc[r]; }
        { const int kp = tid & 255, dir = kp >> 7, comp = (kp >> 6) & 1, pp = kp & 63; const float wr_ = pwr[(2 + dir) * 64 + pp], wi_ = pwi[(2 + dir) * 64 + pp];
#pragma unroll
          for (int q = 0; q < 8; ++q) { const int ho = (tid >> 8) * 8 + q; const float cr = ccr[(dir * 16 + ho) * 64 + pp], ci = cci[(dir * 16 + ho) * 64 + pp];
              const float gr = cr * wr_ - ci * wi_, gi = cr * wi_ + ci * wr_;
              Wy[(size_t)(j * 16 + ho) * 1280 + 1024 + kp] = f2bf(comp == 0 ? gr : -gi); } }
        { const int kp = tid & 255, dir = kp >> 7, comp = (kp >> 6) & 1, pp = kp & 63; const int tb = dir == 0 ? 4 : 1; const float wr_ = pwr[tb * 64 + pp], wi_ = pwi[tb * 64 + pp];
          float f[8];
#pragma unroll
          for (int q = 0; q < 8; ++q) { const int hi = (tid >> 8) * 8 + q; const float br = bbr[(dir * 64 + pp) * 16 + hi], bi = bbi[(dir * 64 + pp) * 16 + hi];
              f[q] = comp == 0 ? (wr_ * br - wi_ * bi) : (wr_ * bi + wi_ * br); }
          u32x4 w; w.x = cvt_pk_bf16(f[0], f[1]); w.y = cvt_pk_bf16(f[2], f[3]); w.z = cvt_pk_bf16(f[4], f[5]); w.w = cvt_pk_bf16(f[6], f[7]);
          *(u32x4*)(Ws + (size_t)kp * 1024 + j * 16 + (tid >> 8) * 8) = w; }
        __syncthreads();
    }
}

__device__ __forceinline__ void ph_s5fill(const P& p, int tid, int blk, int G, int l0, int l1) {
    const float* KT = WSP(O_KT, float);
    for (int item = blk; item < (l1 - l0) * 16 * 64; item += G) {
        const int l = l0 + (item >> 10), g = (item >> 6) & 15, t = item & 63;
        bf16_t* Wy = WSP(O_WS5Y, bf16_t) + (size_t)(l * 16 + g) * 1024 * 1280;
        const float* kf = KT + (size_t)((l * 16 + g) * 2 + 0) * 64 * 256; const float* kr = KT + (size_t)((l * 16 + g) * 2 + 1) * 64 * 256;
        f32x4 va[4][2], vb[4][2];
#pragma unroll
        for (int r = 0; r < 4; ++r) { const int idx = r * NTHREADS + tid, ho = idx >> 7, k8 = idx & 127, sI = k8 >> 1, hi0 = (k8 & 1) * 8;
            const float* qa = kf + (size_t)max(t - sI, 0) * 256 + ho * 16 + hi0; const float* qb = kr + (size_t)max(sI - t, 0) * 256 + ho * 16 + hi0;
            va[r][0] = *(const f32x4*)qa; va[r][1] = *(const f32x4*)(qa + 4); vb[r][0] = *(const f32x4*)qb; vb[r][1] = *(const f32x4*)(qb + 4); }
#pragma unroll
        for (int r = 0; r < 4; ++r) { const int idx = r * NTHREADS + tid, ho = idx >> 7, k8 = idx & 127, sI = k8 >> 1, hi0 = (k8 & 1) * 8;
            const float fa = sI <= t ? 1.0f : 0.f, fb = sI >= t ? 1.0f : 0.f;
            f32x4 v0 = va[r][0] * fa + vb[r][0] * fb, v1 = va[r][1] * fa + vb[r][1] * fb;
            const float dd = sI == t ? p.in[15][(l * 16 + g) * 16 + ho] : 0.f; const int dpos = ho - hi0;
#pragma unroll
            for (int e = 0; e < 4; ++e) { v0[e] += (dpos == e) ? dd : 0.f; v1[e] += (dpos == e + 4) ? dd : 0.f; }
            u32x4 w; w.x = cvt_pk_bf16(v0[0], v0[1]); w.y = cvt_pk_bf16(v0[2], v0[3]); w.z = cvt_pk_bf16(v1[0], v1[1]); w.w = cvt_pk_bf16(v1[2], v1[3]);
            *(u32x4*)(Wy + (size_t)(t * 16 + ho) * 1280 + sI * 16 + hi0) = w; }
    }
}

__device__ __forceinline__ void ph_combine_norm(const P& p, int lsrc, int ldst, int lane, int wave, int blk, int G, bf16_t* xrdst) {
    const float* MOD = WSP(O_MOD, float);
    const bf16_t* Y = WSP(O_XS, bf16_t); const int* SLOT = WSP(O_SLOT, int); const float* GV = WSP(O_GV, float);
    bf16_t* H1 = WSP(O_H1, bf16_t);
    f32x4 gw[4], gfv[4], shv[4], scv[4]; int bcur = -1;
    if (ldst < NL) {
#pragma unroll
        for (int i = 0; i < 4; ++i) gw[i] = *(const f32x4*)(p.in[4] + ldst * 1024 + i * 256 + lane * 4); }
    for (int row = blk * 8 + wave; row < T; row += G * 8) {
        const int b = row >> 12;
        if (b != bcur) { bcur = b;
#pragma unroll
            for (int i = 0; i < 4; ++i) { const int c = i * 256 + lane * 4;
                if (lsrc >= 0) gfv[i] = *(const f32x4*)(MOD + (size_t)(lsrc * 4 + b) * 6144 + 5120 + c);
                if (ldst < NL) { shv[i] = *(const f32x4*)(MOD + (size_t)(ldst * 4 + b) * 6144 + c); scv[i] = *(const f32x4*)(MOD + (size_t)(ldst * 4 + b) * 6144 + 1024 + c) + 1.0f; } } }
        f32x4 x[4];
        if (lsrc < 0) {
#pragma unroll
            for (int i = 0; i < 4; ++i) x[i] = *(const f32x4*)(p.in[0] + (size_t)row * 1024 + i * 256 + lane * 4);
        } else { u32x2 xb[4];
#pragma unroll
            for (int i = 0; i < 4; ++i) xb[i] = *(const u32x2*)(WSP(O_XR, bf16_t) + (size_t)row * 1024 + i * 256 + lane * 4);
#pragma unroll
            for (int i = 0; i < 4; ++i) x[i] = bf4_to_f32(xb[i]); }
        if (lsrc >= 0) {
            f32x4 acc[4] = {{0.f, 0.f, 0.f, 0.f}, {0.f, 0.f, 0.f, 0.f}, {0.f, 0.f, 0.f, 0.f}, {0.f, 0.f, 0.f, 0.f}};
#pragma unroll
            for (int k = 0; k < 4; ++k) { const int slot = SLOT[row * 4 + k]; const float gk = GV[row * 4 + k]; const bf16_t* yr = Y + (size_t)slot * 1024;
#pragma unroll
                for (int i = 0; i < 4; ++i) { const u32x2 v = *(const u32x2*)(yr + i * 256 + lane * 4);
                    acc[i][0] += gk * __uint_as_float(v.x << 16); acc[i][1] += gk * __uint_as_float(v.x & 0xFFFF0000u); acc[i][2] += gk * __uint_as_float(v.y << 16); acc[i][3] += gk * __uint_as_float(v.y & 0xFFFF0000u); } }
#pragma unroll
            for (int i = 0; i < 4; ++i) x[i] = x[i] + gfv[i] * acc[i];
        }
        if (ldst < NL) {
#pragma unroll
            for (int i = 0; i < 4; ++i) { const u32x2 w = f32_to_bf4(x[i]); *(u32x2*)(xrdst + (size_t)row * 1024 + i * 256 + lane * 4) = w; x[i] = bf4_to_f32(w); }
        } else {
#pragma unroll
            for (int i = 0; i < 4; ++i) *(f32x4*)(p.out + (size_t)row * 1024 + i * 256 + lane * 4) = x[i];
        }
        if (ldst < NL) {
            float ss = 0.f;
#pragma unroll
            for (int i = 0; i < 4; ++i) ss += x[i][0] * x[i][0] + x[i][1] * x[i][1] + x[i][2] * x[i][2] + x[i][3] * x[i][3];
            ss = wave_sum_all(ss); const float rstd = rsqrtf(ss * (1.0f / 1024.0f) + 1e-6f);
#pragma unroll
            for (int i = 0; i < 4; ++i) { const int c = i * 256 + lane * 4;
                const f32x4 h = x[i] * rstd * gw[i] * scv[i] + shv[i];
                u32x2 w; w.x = cvt_pk_bf16(h[0], h[1]); w.y = cvt_pk_bf16(h[2], h[3]); *(u32x2*)(H1 + (size_t)row * 1024 + c) = w; }
        }
    }
}

__device__ __forceinline__ void ph_prepass(const P& p, int l, int lane, int wave, int blk, int G) {
    const bf16_t* PROJ = WSP(O_PROJ, bf16_t);
    bf16_t* ZS = WSP(O_ZS, bf16_t); bf16_t* QN = WSP(O_QN, bf16_t); bf16_t* KN = WSP(O_KN, bf16_t); bf16_t* AS5 = WSP(O_AS5, bf16_t);
    bf16_t* R = WSP(O_R, bf16_t); bf16_t* K = WSP(O_K, bf16_t); bf16_t* V = WSP(O_V, bf16_t); bf16_t* A = WSP(O_A, bf16_t); float* RKB = WSP(O_RKB, float);
    const float* mu = p.in[17] + l * 1536; const float* k_k = p.in[26] + l * 384; const float* r_k = p.in[28] + l * 384;
    const int r4 = lane >> 4, j4 = (lane & 15) * 4;
    const f32x4 qg = *(const f32x4*)(p.in[31] + l * 64 + j4), kg = *(const f32x4*)(p.in[32] + l * 64 + j4);
    const int c0 = r4 * 64 + j4, c1 = min(4 + r4, 5) * 64 + j4;
    f32x4 muv[2][4], kkv[2], rkv2[2];
#pragma unroll
    for (int pass = 0; pass < 2; ++pass) { const int c = pass ? c1 : c0;
#pragma unroll
        for (int part = 0; part < 4; ++part) muv[pass][part] = *(const f32x4*)(mu + part * 384 + c);
        kkv[pass] = *(const f32x4*)(k_k + c); rkv2[pass] = *(const f32x4*)(r_k + c); }
#pragma unroll 1
    for (int run = blk * 8 + wave; run < T / 8; run += G * 8) {
        const int base = run * 8, t0 = base & 4095;
        u32x2 rows[4][2][4], aux[2][5];
#define PP_ROW(slot, tk, valid) do { _Pragma("unroll") for (int part_ = 0; part_ < 4; ++part_) { const bf16_t* s0_ = PROJ + (size_t)(tk) * NPROJ + 256 + part_ * 384; \
            rows[slot][0][part_] = (valid) ? *(const u32x2*)(s0_ + c0) : (u32x2){0u, 0u}; rows[slot][1][part_] = (valid) ? *(const u32x2*)(s0_ + c1) : (u32x2){0u, 0u}; } } while (0)
#define PP_AUX(slot, tk) do { const bf16_t* s0_ = PROJ + (size_t)(tk) * NPROJ; aux[slot][0] = *(const u32x2*)(s0_ + lane * 4); aux[slot][1] = *(const u32x2*)(s0_ + 1792 + c0); aux[slot][2] = *(const u32x2*)(s0_ + 2176 + c0); \
            aux[slot][3] = *(const u32x2*)(s0_ + 1792 + c1); aux[slot][4] = *(const u32x2*)(s0_ + 2176 + c1); } while (0)
        PP_ROW(0, base - 1, t0 > 0); PP_ROW(1, base, true); PP_ROW(2, base + 1, true); PP_AUX(0, base);
#pragma unroll
        for (int it = 0; it < 8; ++it) {
            const int tok = base + it; const int sp = it & 3, sc = (it + 1) & 3, sn = (it + 2) & 3, snn = (it + 3) & 3;
            if (it < 7) { PP_ROW(snn, tok + 2, t0 + it + 2 <= 4095); PP_AUX((it + 1) & 1, tok + 1); }
            { const int g = lane >> 2, hi0 = (lane & 3) * 4; *(u32x2*)(AS5 + ((size_t)g * 256 + (tok >> 6)) * 1280 + (tok & 63) * 16 + hi0) = aux[it & 1][0]; }
#pragma unroll
            for (int pass = 0; pass < 2; ++pass) {
                const int hd_ = pass * 4 + r4; const bool act = hd_ < 6; const int hd = act ? hd_ : 5; const int c = hd * 64 + j4;
                f32x4 xs[4];
#pragma unroll
                for (int part = 0; part < 4; ++part) { const f32x4 cur = bf4_to_f32(rows[sc][pass][part]), pv = bf4_to_f32(rows[sp][pass][part]), nx = bf4_to_f32(rows[sn][pass][part]);
                    xs[part] = cur + ((pv + nx) * 0.5f - cur) * muv[pass][part]; }
                const f32x4 kr = xs[1] * kkv[pass];
                const float n2 = row16_sum(hsum4(kr * kr)); const float rk = row16_sum(hsum4(xs[0] * xs[1] * rkv2[pass]));
                const f32x4 qv = bf4_to_f32(aux[it & 1][1 + 2 * pass]), kv = bf4_to_f32(aux[it & 1][2 + 2 * pass]);
                const float mq = row16_sum(hsum4(qv * qv)) * (1.0f / 64.0f), mk = row16_sum(hsum4(kv * kv)) * (1.0f / 64.0f);
                if (act) { const size_t o = (size_t)tok * 384 + c;
                    *(u32x2*)(R + o) = f32_to_bf4(xs[0]); *(u32x2*)(K + o) = f32_to_bf4(xs[1]); *(u32x2*)(V + o) = f32_to_bf4(xs[2]); *(u32x2*)(ZS + o) = f32_to_bf4(xs[3]);
                    *(u32x2*)(A + o) = f32_to_bf4(kr * (-1.0f / fmaxf(sqrtf(n2), 1e-12f)));
                    if ((lane & 15) == 0) RKB[tok * 8 + hd] = rk;
                    *(u32x2*)(QN + o) = f32_to_bf4(qv * (rsqrtf(mq + 1e-6f) * 0.125f) * qg); *(u32x2*)(KN + o) = f32_to_bf4(kv * rsqrtf(mk + 1e-6f) * kg); }
            }
        }
#undef PP_ROW
#undef PP_AUX
    }
}

__device__ __forceinline__ void ph_na(const P& p, int l, unsigned char* lds, int tid, int lane, int wave, int blk, int G) {
    float* rpb = (float*)lds;
    unsigned char* vb = lds + 11264 + wave * 4608;
    { float rv[6];
#pragma unroll
      for (int k = 0; k < 6; ++k) { const int i = k * NTHREADS + tid; rv[k] = p.in[33][l * 2790 + (i < 2790 ? i : 0)]; }
#pragma unroll
      for (int k = 0; k < 6; ++k) { const int i = k * NTHREADS + tid; if (i < 2790) rpb[i] = rv[k]; } }
    __syncthreads();
    const bf16_t* QN = WSP(O_QN, bf16_t); const bf16_t* KN = WSP(O_KN, bf16_t); const bf16_t* PROJ = WSP(O_PROJ, bf16_t); bf16_t* MIX = WSP(O_MIX, bf16_t);
    const int q16 = lane & 15, g = lane >> 4;
    const unsigned vaddr = (unsigned)(size_t)(LAS unsigned char*)vb + (unsigned)((4 * g + (q16 >> 2)) * 144 + (q16 & 3) * 8);
    for (int unit = blk * 8 + wave; unit < 6144; unit += G * 8) {
        const int nb = unit & 3, r = (unit >> 2) & 63, bh = unit >> 8, h = bh % 6, b = bh / 6;
        const int rs = min(max(r - 4, 0), 56), kb0 = min(max(16 * nb - 8, 0), 32);
        const int tq = b * 4096 + r * 64 + 16 * nb + q16;
        const bf16x8 qf0 = *(const bf16x8*)(QN + (size_t)tq * 384 + h * 64 + 8 * g), qf1 = *(const bf16x8*)(QN + (size_t)tq * 384 + h * 64 + 32 + 8 * g);
        f32x4 s[16];
        bf16x8 kf[2][4][2];
#define NA_KLOAD(set, gi) do { _Pragma("unroll") for (int jj = 0; jj < 4; ++jj) { const int j_ = (gi) * 4 + jj; const int tk = b * 4096 + (rs + (j_ >> 1)) * 64 + kb0 + (j_ & 1) * 16 + q16; \
            const bf16_t* kp = KN + (size_t)tk * 384 + h * 64 + 8 * g; kf[set][jj][0] = *(const bf16x8*)kp; kf[set][jj][1] = *(const bf16x8*)(kp + 32); } } while (0)
        NA_KLOAD(0, 0);
        u32x4 vr[2][4];
#define NA_VLOAD(set, s2_) do { const int tv = b * 4096 + (rs + (s2_)) * 64 + kb0 + (lane >> 1); const bf16_t* vp = PROJ + (size_t)tv * NPROJ + 2560 + h * 64 + (lane & 1) * 32; \
            vr[set][0] = *(const u32x4*)vp; vr[set][1] = *(const u32x4*)(vp + 8); vr[set][2] = *(const u32x4*)(vp + 16); vr[set][3] = *(const u32x4*)(vp + 24); } while (0)
#pragma unroll
        for (int gi = 0; gi < 4; ++gi) {
            if (gi < 3) NA_KLOAD((gi + 1) & 1, gi + 1); else NA_VLOAD(0, 0);
#pragma unroll
            for (int jj = 0; jj < 4; ++jj) { f32x4 z = {0.f, 0.f, 0.f, 0.f};
                z = __builtin_amdgcn_mfma_f32_16x16x32_bf16(kf[gi & 1][jj][0], qf0, z, 0, 0, 0); z = __builtin_amdgcn_mfma_f32_16x16x32_bf16(kf[gi & 1][jj][1], qf1, z, 0, 0, 0); s[gi * 4 + jj] = z; }
            __builtin_amdgcn_sched_barrier(0); }
        const int qc = 16 * nb + q16, cst = min(max(qc - 8, 0), 48);
        float mx = -3.0e38f;
#pragma unroll
        for (int j = 0; j < 16; ++j)
#pragma unroll
            for (int i = 0; i < 4; ++i) { const int kc = kb0 + (j & 1) * 16 + 4 * g + i; const bool valid = (kc >= cst) && (kc < cst + 16);
                const int dy = rs + (j >> 1) - r + 7, dx = min(max(kc - qc + 15, 0), 30);
                const float v = valid ? s[j][i] + rpb[(h * 15 + dy) * 31 + dx] : -3.0e38f; s[j][i] = v; mx = fmaxf(mx, v); }
        { float a = mx, b = mx; swap16(a, b); mx = fmaxf(a, b); } { float a = mx, b = mx; swap32(a, b); mx = fmaxf(a, b); }
        float sum = 0.f;
#pragma unroll
        for (int j = 0; j < 16; ++j)
#pragma unroll
            for (int i = 0; i < 4; ++i) { const float e = __expf(s[j][i] - mx); s[j][i] = e; sum += e; }
        { float a = sum, b = sum; swap16(a, b); sum = a + b; } { float a = sum, b = sum; swap32(a, b); sum = a + b; }
        const float inv = 1.0f / sum;
        f32x4 o[4] = {{0.f, 0.f, 0.f, 0.f}, {0.f, 0.f, 0.f, 0.f}, {0.f, 0.f, 0.f, 0.f}, {0.f, 0.f, 0.f, 0.f}};
#pragma unroll
        for (int s2 = 0; s2 < 8; ++s2) {
            if (s2 < 7) NA_VLOAD((s2 + 1) & 1, s2 + 1);
            unsigned char* vw = vb + (lane >> 1) * 144 + (lane & 1) * 64;
            *(u32x4*)vw = vr[s2 & 1][0]; *(u32x4*)(vw + 16) = vr[s2 & 1][1]; *(u32x4*)(vw + 32) = vr[s2 & 1][2]; *(u32x4*)(vw + 48) = vr[s2 & 1][3];
            s16x4 lo[4], hi[4];
            asm volatile("s_waitcnt lgkmcnt(0)\n\t"
                         "ds_read_b64_tr_b16 %0, %8\n\tds_read_b64_tr_b16 %1, %8 offset:32\n\tds_read_b64_tr_b16 %2, %8 offset:64\n\tds_read_b64_tr_b16 %3, %8 offset:96\n\t"
                         "ds_read_b64_tr_b16 %4, %8 offset:2304\n\tds_read_b64_tr_b16 %5, %8 offset:2336\n\tds_read_b64_tr_b16 %6, %8 offset:2368\n\tds_read_b64_tr_b16 %7, %8 offset:2400\n\t"
                         "s_waitcnt lgkmcnt(0)"
                         : "=&v"(lo[0]), "=&v"(lo[1]), "=&v"(lo[2]), "=&v"(lo[3]), "=&v"(hi[0]), "=&v"(hi[1]), "=&v"(hi[2]), "=&v"(hi[3]) : "v"(vaddr) : "memory");
            bf16x8 pa;
            { const f32x4 a = s[2 * s2] * inv, c = s[2 * s2 + 1] * inv; u32x4 w; w.x = cvt_pk_bf16(a[0], a[1]); w.y = cvt_pk_bf16(a[2], a[3]); w.z = cvt_pk_bf16(c[0], c[1]); w.w = cvt_pk_bf16(c[2], c[3]); pa = __builtin_bit_cast(bf16x8, w); }
#pragma unroll
            for (int nt = 0; nt < 4; ++nt) { bf16x8 bfr; bfr[0] = lo[nt][0]; bfr[1] = lo[nt][1]; bfr[2] = lo[nt][2]; bfr[3] = lo[nt][3]; bfr[4] = hi[nt][0]; bfr[5] = hi[nt][1]; bfr[6] = hi[nt][2]; bfr[7] = hi[nt][3];
                o[nt] = __builtin_amdgcn_mfma_f32_16x16x32_bf16(pa, bfr, o[nt], 0, 0, 0); }
        }
#undef NA_KLOAD
#undef NA_VLOAD
#pragma unroll
        for (int nt = 0; nt < 4; ++nt)
#pragma unroll
            for (int i = 0; i < 4; ++i) MIX[(size_t)(b * 4096 + r * 64 + 16 * nb + 4 * g + i) * 1024 + 640 + h * 64 + 16 * nt + q16] = f2bf(o[nt][i]);
    }
    __syncthreads();
}

__device__ __forceinline__ void ph_s5carry(const P& p, int l, int tid, int blk) {
    if (blk >= 16) return;
    const int g = blk, b = tid >> 7, dir = (tid >> 6) & 1, pp = tid & 63;
    const int li = ((l * 2 + dir) * 16 + g) * 64 + pp;
    const float mr = WSP(O_S5M, float)[(size_t)li * 2], mi = WSP(O_S5M, float)[(size_t)li * 2 + 1];
    const float* SL = WSP(O_SLOC, float) + (size_t)g * 256 * 256; bf16_t* AS = WSP(O_AS5, bf16_t) + (size_t)g * 256 * 1280;
    float hr = 0.f, hi = 0.f;
#pragma unroll 1
    for (int c0 = 0; c0 < 64; c0 += 16) {
        float sr[16], si[16];
#pragma unroll
        for (int u = 0; u < 16; ++u) { const int cc = c0 + u, c = dir == 0 ? cc : 63 - cc, chunk = b * 64 + c;
            sr[u] = SL[(size_t)chunk * 256 + dir * 128 + pp]; si[u] = SL[(size_t)chunk * 256 + dir * 128 + 64 + pp]; }
#pragma unroll
        for (int u = 0; u < 16; ++u) { const int cc = c0 + u, c = dir == 0 ? cc : 63 - cc, chunk = b * 64 + c;
            AS[(size_t)chunk * 1280 + 1024 + dir * 128 + pp] = f2bf(hr); AS[(size_t)chunk * 1280 + 1024 + dir * 128 + 64 + pp] = f2bf(hi);
            const float nr = mr * hr - mi * hi + sr[u], ni = mr * hi + mi * hr + si[u]; hr = nr; hi = ni; }
    }
}

constexpr int XB = 8192;
#define XOFF(row, col) ((row) * 128 + (((((col) >> 3) ^ (((row) >> 1) & 7))) << 4) + ((col) & 7) * 2)
__device__ __forceinline__ void nt2(const LAS unsigned char* X, const LAS unsigned char* Y, int tm, int tn0, int m16, int g, f32x4 (&acc)[2]) {
    const int ra_ = 16 * tm + m16;
    const bf16x8 a0 = *(const LAS bf16x8*)(X + XOFF(ra_, 8 * g)), a1 = *(const LAS bf16x8*)(X + XOFF(ra_, 32 + 8 * g));
#pragma unroll
    for (int q = 0; q < 2; ++q) { const int rb_ = 16 * (tn0 + q) + m16;
        const bf16x8 b0 = *(const LAS bf16x8*)(Y + XOFF(rb_, 8 * g)), b1 = *(const LAS bf16x8*)(Y + XOFF(rb_, 32 + 8 * g));
        acc[q] = __builtin_amdgcn_mfma_f32_16x16x32_bf16(a0, b0, acc[q], 0, 0, 0); acc[q] = __builtin_amdgcn_mfma_f32_16x16x32_bf16(a1, b1, acc[q], 0, 0, 0); }
}
struct XF { bf16x8 a0, a1, b00, b01, b10, b11; };
__device__ __forceinline__ void xload(XF& f, const LAS unsigned char* X, const LAS unsigned char* Y, int tm, int tn0, int m16, int g) {
    const int ra_ = 16 * tm + m16, rb0_ = 16 * tn0 + m16, rb1_ = rb0_ + 16;
    f.a0 = *(const LAS bf16x8*)(X + XOFF(ra_, 8 * g)); f.a1 = *(const LAS bf16x8*)(X + XOFF(ra_, 32 + 8 * g));
    f.b00 = *(const LAS bf16x8*)(Y + XOFF(rb0_, 8 * g)); f.b01 = *(const LAS bf16x8*)(Y + XOFF(rb0_, 32 + 8 * g));
    f.b10 = *(const LAS bf16x8*)(Y + XOFF(rb1_, 8 * g)); f.b11 = *(const LAS bf16x8*)(Y + XOFF(rb1_, 32 + 8 * g)); }
__device__ __forceinline__ void xmma(const XF& f, f32x4 (&acc)[2]) {
    acc[0] = __builtin_amdgcn_mfma_f32_16x16x32_bf16(f.a0, f.b00, (f32x4){0.f, 0.f, 0.f, 0.f}, 0, 0, 0); acc[1] = __builtin_amdgcn_mfma_f32_16x16x32_bf16(f.a0, f.b10, (f32x4){0.f, 0.f, 0.f, 0.f}, 0, 0, 0);
    acc[0] = __builtin_amdgcn_mfma_f32_16x16x32_bf16(f.a1, f.b01, acc[0], 0, 0, 0); acc[1] = __builtin_amdgcn_mfma_f32_16x16x32_bf16(f.a1, f.b11, acc[1], 0, 0, 0); }
#define X1_L(f, Xb, Yb) xload(f, BUF(Yb), BUF(Xb), tm, tn0, m16, g)
#define X1_M(f, acc) xmma(f, acc)
#define X1_PROD(Xb, Yb) do { acc[0] = (f32x4){0.f, 0.f, 0.f, 0.f}; acc[1] = (f32x4){0.f, 0.f, 0.f, 0.f}; nt2(BUF(Yb), BUF(Xb), tm, tn0, m16, g, acc); } while (0)
#define X1_Q(q, mrow) _Pragma("unroll") for (int q = 0; q < 2; ++q) { const int mrow = 16 * (tn0 + q) + m16; (void)mrow;
#define X1_END }
#define X1_ST4(buf, mrow, v4) (*(LAS u32x2*)(BUF(buf) + XOFF(mrow, nc0)) = f32_to_bf4(v4))
#define X1_LD4(buf, mrow) bf4_to_f32(*(const LAS u32x2*)(BUF(buf) + XOFF(mrow, nc0)))
__device__ __forceinline__ void ph_x1(const P& p, unsigned char* lds_, int tid, int lane, int wave, int ublk, int ustride, int u0, int u1) {
    LAS unsigned char* LB = (LAS unsigned char*)lds_;
#define BUF(i) (LB + (i) * XB)
    LAS float* Gm = (LAS float*)BUF(8);
    LAS float* gC = (LAS float*)(LB + LDS_X);
    const int m16 = lane & 15, g = lane >> 4, tm = wave >> 1, tn0 = (wave & 1) * 2, nc0 = 16 * tm + 4 * g;
    const int half = tid >> 8, s0 = ((tid & 255) >> 4) * 4, j4 = (tid & 15) * 4;
    u32x2 inr[3][4];
#define X1_LOAD(unit) do { const int ch_ = (unit) >> 6, c_ = (unit) & 63, b_ = ch_ / 12, h_ = (ch_ % 12) >> 1, dir_ = ch_ & 1; \
        const bf16_t* f0_ = half ? WSP(O_KD, bf16_t) + (size_t)dir_ * T * 384 : WSP(O_A, bf16_t); const bf16_t* f2_ = half ? WSP(O_V, bf16_t) : WSP(O_BV, bf16_t) + (size_t)dir_ * T * 384; const bf16_t* f1_ = half ? WSP(O_R, bf16_t) : WSP(O_DEC, bf16_t) + (size_t)dir_ * T * 384; \
        _Pragma("unroll") for (int r_ = 0; r_ < 4; ++r_) { const int t_ = dir_ ? (4095 - (64 * c_ + s0 + r_)) : (64 * c_ + s0 + r_); const size_t o_ = (size_t)(b_ * 4096 + t_) * 384 + h_ * 64 + j4; \
            inr[0][r_] = *(const u32x2*)(f0_ + o_); inr[2][r_] = *(const u32x2*)(f2_ + o_); inr[1][r_] = *(const u32x2*)(f1_ + o_); } } while (0)
    int unit = u0 + ublk;
    if (unit < u1) X1_LOAD(unit);
#pragma unroll 1
    for (; unit < u1; unit += ustride) {
        if (half == 0) {
#pragma unroll
            for (int r = 0; r < 4; ++r) *(LAS f32x4*)(Gm + (s0 + r) * 68 + j4) = h4_to_f32(inr[1][r]); }
        LDS_BARRIER();
        { const int jch = tid & 63, seg = tid >> 6; LAS float* segT = (LAS float*)BUF(11);
          float gv[8];
#pragma unroll
          for (int u = 0; u < 8; ++u) gv[u] = Gm[(seg * 8 + u) * 68 + jch];
#pragma unroll
          for (int u = 1; u < 8; ++u) gv[u] = gv[u] * gv[u - 1];
          segT[seg * 64 + jch] = gv[7];
          LDS_BARRIER();
          float pre = 1.0f;
#pragma unroll
          for (int u = 0; u < 7; ++u) { const float tv = segT[u * 64 + jch]; if (u < seg) pre *= tv; }
#pragma unroll
          for (int u = 0; u < 8; ++u) Gm[(seg * 8 + u) * 68 + jch] = gv[u] * pre;
          if (seg == 7) gC[jch] = gv[7] * pre; }
        LDS_BARRIER();
        { f32x4 gg[4], gp;
#pragma unroll
          for (int r = 0; r < 4; ++r) gg[r] = *(const LAS f32x4*)(Gm + (s0 + r) * 68 + j4);
          gp = s0 > 0 ? *(const LAS f32x4*)(Gm + (s0 - 1) * 68 + j4) : (f32x4){1.f, 1.f, 1.f, 1.f};
          f32x4 m0[4], m2[4], m1[4];
#pragma unroll
          for (int r = 0; r < 4; ++r) { f32x4 gi; gi[0] = frcp(gg[r][0]); gi[1] = frcp(gg[r][1]); gi[2] = frcp(gg[r][2]); gi[3] = frcp(gg[r][3]);
              const f32x4 i0 = bf4_to_f32(inr[0][r]), i2 = bf4_to_f32(inr[2][r]);
              if (half == 0) { m0[r] = i0 * (r == 0 ? gp : gg[r - 1]); m2[r] = i2 * gi; m1[r] = m0[r]; }
              else { m0[r] = i0 * gi; m1[r] = bf4_to_f32(inr[1][r]) * gg[r]; m2[r] = i2; } }
          const int bA = half ? 2 : 0, bAT = half ? 6 : 4;
#pragma unroll
          for (int r = 0; r < 4; ++r) *(LAS u32x2*)(BUF(bA) + XOFF(s0 + r, j4)) = f32_to_bf4(m0[r]);
#pragma unroll
          for (int q = 0; q < 4; ++q) *(LAS u32x2*)(BUF(bAT) + XOFF(j4 + q, s0)) = f32_to_bf4((f32x4){m0[0][q], m0[1][q], m0[2][q], m0[3][q]});
          if (half == 0) {
#pragma unroll
              for (int r = 0; r < 4; ++r) *(LAS u32x2*)(BUF(1) + XOFF(s0 + r, j4)) = f32_to_bf4(m2[r]);
#pragma unroll
              for (int q = 0; q < 4; ++q) *(LAS u32x2*)(BUF(5) + XOFF(j4 + q, s0)) = f32_to_bf4((f32x4){m2[0][q], m2[1][q], m2[2][q], m2[3][q]});
          } else {
#pragma unroll
              for (int r = 0; r < 4; ++r) *(LAS u32x2*)(BUF(3) + XOFF(s0 + r, j4)) = f32_to_bf4(m1[r]);
#pragma unroll
              for (int q = 0; q < 4; ++q) *(LAS u32x2*)(BUF(7) + XOFF(j4 + q, s0)) = f32_to_bf4((f32x4){m2[0][q], m2[1][q], m2[2][q], m2[3][q]});
          } }
        LDS_BARRIER();
        { const int un = unit + ustride; if (un < u1) X1_LOAD(un); }
        XF fa, fb, fc, fd; f32x4 acc[2], acb[2], acd[2], ace[2];
        X1_L(fa, 0, 1); X1_L(fb, 1, 0); X1_L(fc, 2, 0);
        X1_M(fa, acc); X1_M(fb, acb); X1_M(fc, acd);
        X1_L(fa, 3, 1); X1_L(fb, 3, 2);
        X1_Q(q, mrow) f32x4 v, w, vt, vk;
#pragma unroll
            for (int i = 0; i < 4; ++i) { v[i] = (nc0 + i) < mrow ? acc[q][i] : 0.f; w[i] = v[i] + ((nc0 + i) == mrow ? 1.0f : 0.f); vt[i] = mrow < (nc0 + i) ? acb[q][i] : 0.f; vk[i] = mrow < (nc0 + i) ? acd[q][i] : 0.f; }
            X1_ST4(8, mrow, v); X1_ST4(13, mrow, w); X1_ST4(9, mrow, vt); X1_ST4(10, mrow, vk); X1_END
        X1_M(fa, acc); X1_M(fb, acb);
        X1_Q(q, mrow) f32x4 v, w;
#pragma unroll
            for (int i = 0; i < 4; ++i) { v[i] = (nc0 + i) <= mrow ? acc[q][i] : 0.f; w[i] = (nc0 + i) <= mrow ? acb[q][i] : 0.f; }
            X1_ST4(11, mrow, v); X1_ST4(12, mrow, w); X1_END
        LDS_BARRIER();
#define X1_DSTAGE(pi, pti, po, pto, wantP, li, lpt, lo, hasL) do { \
            if (wantP) X1_L(fa, pi, pti); X1_L(fb, pti, pi); if (hasL) X1_L(fc, li, lpt); \
            f32x4 lold[2]; if (hasL) { X1_Q(q, mrow) lold[q] = X1_LD4(li, mrow); X1_END } \
            if (wantP) X1_M(fa, acc); X1_M(fb, acb); if (hasL) X1_M(fc, acd); \
            X1_Q(q, mrow) if (wantP) X1_ST4(po, mrow, acc[q]); X1_ST4(pto, mrow, acb[q]); if (hasL) X1_ST4(lo, mrow, acd[q] + lold[q]); X1_END } while (0)
        X1_DSTAGE(8, 9, 0, 1, true, 0, 0, 0, false); LDS_BARRIER();
        X1_DSTAGE(0, 1, 8, 9, true, 13, 1, 2, true); LDS_BARRIER();
        X1_DSTAGE(8, 9, 0, 1, true, 2, 9, 13, true); LDS_BARRIER();
        X1_DSTAGE(0, 1, 8, 9, true, 13, 1, 2, true); LDS_BARRIER();
        X1_DSTAGE(8, 9, 0, 1, false, 2, 9, 13, true); LDS_BARRIER();
        { X1_L(fc, 13, 1); f32x4 lold[2]; X1_Q(q, mrow) lold[q] = X1_LD4(13, mrow); X1_END X1_M(fc, acd); X1_Q(q, mrow) X1_ST4(2, mrow, acd[q] + lold[q]); X1_END }
        LDS_BARRIER();
        X1_L(fa, 4, 2); X1_L(fb, 10, 2); X1_M(fa, acc); X1_M(fb, acb);
        X1_Q(q, mrow) X1_ST4(8, mrow, acc[q]); X1_ST4(9, mrow, acb[q]); X1_END
        LDS_BARRIER();
        const int udir = (unit >> 6) & 1;
        { bf16_t* PHI = WSP(O_PHI, bf16_t) + (size_t)unit * 4096; bf16_t* GMo = WSP(O_GM, bf16_t) + (size_t)unit * 4096;
          X1_L(fa, 5, 8); X1_L(fb, 5, 9); X1_L(fc, 11, 8); X1_L(fd, 11, 9);
          f32x4 ek[2], gr[2], hk[2];
          X1_Q(q, mrow) ek[q] = X1_LD4(6, mrow); gr[q] = X1_LD4(3, mrow); hk[q] = X1_LD4(12, mrow); X1_END
          X1_M(fa, acc); X1_M(fb, acb); X1_M(fc, acd); X1_M(fd, ace);
          X1_Q(q, mrow) f32x4 v; const float gc = gC[mrow];
#pragma unroll
              for (int i = 0; i < 4; ++i) v[i] = gc * (acc[q][i] + ((nc0 + i) == mrow ? 1.0f : 0.f));
              *(u32x2*)(PHI + mrow * 64 + nc0) = f32_to_bf4(v);
              X1_ST4(0, mrow, acb[q] + ek[q]);
              *(u32x2*)(GMo + (udir ? 63 - mrow : mrow) * 64 + nc0) = f32_to_bf4(acd[q] + gr[q]);
              X1_ST4(1, mrow, ace[q] + hk[q]); X1_END }
        LDS_BARRIER();
        { float* PSIT = WSP(O_PSIT, float) + (size_t)unit * 4096; bf16_t* YLT = WSP(O_YLT, bf16_t) + (size_t)unit * 4096;
          const f32x4 gc4 = *(const LAS f32x4*)(gC + nc0);
          X1_L(fa, 7, 0); X1_L(fb, 1, 7); X1_M(fa, acc); X1_M(fb, acb);
          X1_Q(q, mrow) *(f32x4*)(PSIT + mrow * 64 + nc0) = acc[q] * gc4;
              *(u32x2*)(YLT + (udir ? 63 - mrow : mrow) * 64 + nc0) = f32_to_bf4(acb[q]); X1_END }
    }
#undef BUF
#undef X1_LOAD
#undef X1_DSTAGE
}
__device__ __forceinline__ void ph_x2a(const P& p, LAS unsigned char* lds, int tid, int lane, int wave, int blk) {
    if (blk >= 48) return;
    constexpr int SLOT = 24576, NSLOT = 5;
    const int ch = blk;
    const char* PHI = (const char*)(WSP(O_PHI, bf16_t) + (size_t)ch * 64 * 4096); const char* PSIT = (const char*)(WSP(O_PSIT, float) + (size_t)ch * 64 * 4096);
    if (wave >= 4) {
        const int lw = wave - 4;
        unsigned so[6];
#pragma unroll
        for (int q = 0; q < 6; ++q) { const int piece = lw + 4 * q;
            if (piece < 8) { const int row = piece * 8 + (lane >> 3), cp = lane & 7; so[q] = (unsigned)(row * 128 + ((cp ^ (row & 7)) << 4)); }
            else { const int row = (piece - 8) * 4 + (lane >> 4), cp = lane & 15; so[q] = (unsigned)(row * 256 + ((cp ^ (row & 15)) << 4)); } }
#define X2A_ISSUE(c) do { const int cc_ = (c) < 64 ? (c) : 63; const int sl_ = (c) % NSLOT; \
        _Pragma("unroll") for (int q = 0; q < 6; ++q) { const int piece = lw + 4 * q; \
            const char* src_ = piece < 8 ? PHI + (size_t)cc_ * 8192 + so[q] : PSIT + (size_t)cc_ * 16384 + so[q]; \
            __builtin_amdgcn_global_load_lds((const unsigned*)src_, (LAS unsigned*)(lds + sl_ * SLOT + piece * 1024), 16, 0, 0); } } while (0)
        X2A_ISSUE(0); X2A_ISSUE(1); X2A_ISSUE(2); X2A_ISSUE(3);
        asm volatile("s_waitcnt vmcnt(18)" ::: "memory");
        __builtin_amdgcn_s_barrier(); asm volatile("" ::: "memory");
#pragma unroll 1
        for (int c = 0; c < 64; ++c) {
            X2A_ISSUE(c + 4);
            asm volatile("s_waitcnt vmcnt(18)" ::: "memory");
            __builtin_amdgcn_s_barrier(); asm volatile("" ::: "memory");
        }
        asm volatile("s_waitcnt vmcnt(0)" ::: "memory");
#undef X2A_ISSUE
    } else {
        const int vt = wave, m16 = lane & 15, g = lane >> 4;
        u32x4* SB = (u32x4*)(p.ws + O_SB) + (size_t)ch * 64 * 512 + vt * 128 + lane;
        f32x4 D[4] = {{0.f, 0.f, 0.f, 0.f}, {0.f, 0.f, 0.f, 0.f}, {0.f, 0.f, 0.f, 0.f}, {0.f, 0.f, 0.f, 0.f}};
        __builtin_amdgcn_s_barrier(); asm volatile("" ::: "memory");
#pragma unroll 1
        for (int c = 0; c < 64; ++c) {
            const LAS unsigned char* sl = lds + (c % NSLOT) * SLOT;
            bf16x8 bk[2];
#pragma unroll
            for (int ks = 0; ks < 2; ++ks) { u32x4 w; w.x = cvt_pk_bf16(D[2 * ks][0], D[2 * ks][1]); w.y = cvt_pk_bf16(D[2 * ks][2], D[2 * ks][3]); w.z = cvt_pk_bf16(D[2 * ks + 1][0], D[2 * ks + 1][1]); w.w = cvt_pk_bf16(D[2 * ks + 1][2], D[2 * ks + 1][3]);
                bk[ks] = __builtin_bit_cast(bf16x8, w); SB[(size_t)c * 512 + ks * 64] = w; }
#pragma unroll
            for (int tj = 0; tj < 4; ++tj) { const int row = 16 * tj + m16, rx = row & 7;
                u32x2 f[2][2];
#pragma unroll
                for (int ks = 0; ks < 2; ++ks)
#pragma unroll
                    for (int hh = 0; hh < 2; ++hh) { const int o = 64 * ks + 8 * g + 32 * hh; f[ks][hh] = *(const LAS u32x2*)(sl + row * 128 + (((o >> 4) ^ rx) << 4) + (o & 15)); }
                const int prow = 16 * vt + m16; const int pc = 4 * tj + g;
                f32x4 z = *(const LAS f32x4*)(sl + 8192 + prow * 256 + ((pc ^ (prow & 15)) << 4));
                u32x4 a0; a0.x = f[0][0].x; a0.y = f[0][0].y; a0.z = f[0][1].x; a0.w = f[0][1].y;
                u32x4 a1; a1.x = f[1][0].x; a1.y = f[1][0].y; a1.z = f[1][1].x; a1.w = f[1][1].y;
                z = __builtin_amdgcn_mfma_f32_16x16x32_bf16(__builtin_bit_cast(bf16x8, a0), bk[0], z, 0, 0, 0); z = __builtin_amdgcn_mfma_f32_16x16x32_bf16(__builtin_bit_cast(bf16x8, a1), bk[1], z, 0, 0, 0); D[tj] = z; }
            asm volatile("s_waitcnt lgkmcnt(0)" ::: "memory");
            __builtin_amdgcn_s_barrier(); asm volatile("" ::: "memory");
        }
    }
}
__device__ __forceinline__ void ph_x2b_post(const P& p, int l, LAS unsigned char* lds, int lane, int wave, int blk, int G) {
    (void)lds;
    const int m16 = lane & 15, g = lane >> 4;
    const bf16_t* V = WSP(O_V, bf16_t); const bf16_t* GATE = WSP(O_GATE, bf16_t); const float* RKB = WSP(O_RKB, float); bf16_t* MIX = WSP(O_MIX, bf16_t);
#pragma unroll 1
    for (int task = blk * 8 + wave; task < 6144; task += G * 8) {
        const int tt = task & 3, c = (task >> 2) & 63, bh = task >> 8, b = bh / 6, h = bh % 6; const int tok = b * 4096 + 64 * c + 16 * tt + m16;
        u32x2 gm[2][4]; u32x4 sb[2][8]; u32x2 yl[2][4];
#pragma unroll
        for (int dir = 0; dir < 2; ++dir) {
            const int unit = ((b * 6 + h) * 2 + dir) * 64 + (dir ? 63 - c : c);
            const bf16_t* GMi = WSP(O_GM, bf16_t) + (size_t)unit * 4096 + (16 * tt + m16) * 64 + 4 * g; const bf16_t* YL = WSP(O_YLT, bf16_t) + (size_t)unit * 4096 + (16 * tt + m16) * 64 + 4 * g;
            const u32x4* SB = (const u32x4*)(p.ws + O_SB) + (size_t)unit * 512 + lane;
#pragma unroll
            for (int k = 0; k < 4; ++k) gm[dir][k] = *(const u32x2*)(GMi + 16 * k);
#pragma unroll
            for (int k = 0; k < 8; ++k) sb[dir][k] = SB[k * 64];
#pragma unroll
            for (int vt = 0; vt < 4; ++vt) yl[dir][vt] = *(const u32x2*)(YL + 16 * vt);
        }
        u32x2 vin[4], gin[4]; f32x4 lw[4], lb[4];
#pragma unroll
        for (int vt = 0; vt < 4; ++vt) { const size_t o = (size_t)tok * 384 + h * 64 + 16 * vt + 4 * g; vin[vt] = *(const u32x2*)(V + o); gin[vt] = *(const u32x2*)(GATE + o);
            lw[vt] = *(const f32x4*)(p.in[29] + l * 384 + h * 64 + 16 * vt + 4 * g); lb[vt] = *(const f32x4*)(p.in[30] + l * 384 + h * 64 + 16 * vt + 4 * g); }
        const float rkv = RKB[tok * 8 + h];
        f32x4 yy[4]; float s = 0.f;
#pragma unroll
        for (int vt = 0; vt < 4; ++vt) { f32x4 z = bf4_to_f32(yl[0][vt]) + bf4_to_f32(yl[1][vt]);
#pragma unroll
            for (int dir = 0; dir < 2; ++dir) {
                u32x4 g0; g0.x = gm[dir][0].x; g0.y = gm[dir][0].y; g0.z = gm[dir][1].x; g0.w = gm[dir][1].y; u32x4 g1; g1.x = gm[dir][2].x; g1.y = gm[dir][2].y; g1.z = gm[dir][3].x; g1.w = gm[dir][3].y;
                z = __builtin_amdgcn_mfma_f32_16x16x32_bf16(__builtin_bit_cast(bf16x8, sb[dir][2 * vt]), __builtin_bit_cast(bf16x8, g0), z, 0, 0, 0);
                z = __builtin_amdgcn_mfma_f32_16x16x32_bf16(__builtin_bit_cast(bf16x8, sb[dir][2 * vt + 1]), __builtin_bit_cast(bf16x8, g1), z, 0, 0, 0); }
            yy[vt] = z; s += hsum4(z); }
        s += xchg16(s, lane); s += xchg32(s, lane);
        const float mean = s * (1.0f / 64.0f); float q = 0.f;
#pragma unroll
        for (int vt = 0; vt < 4; ++vt) { yy[vt] = yy[vt] - mean; q += hsum4(yy[vt] * yy[vt]); }
        q += xchg16(q, lane); q += xchg32(q, lane);
        const float rstd = rsqrtf(q * (1.0f / 64.0f) + 64e-5f);
#pragma unroll
        for (int vt = 0; vt < 4; ++vt) { const f32x4 vv = bf4_to_f32(vin[vt]), gg = bf4_to_f32(gin[vt]);
            const f32x4 out = (yy[vt] * rstd * lw[vt] + lb[vt] + rkv * vv) * gg;
            *(u32x2*)(MIX + (size_t)tok * 1024 + 256 + h * 64 + 16 * vt + 4 * g) = f32_to_bf4(out); }
    }
}

__device__ __forceinline__ void ph_router(const P& p, int l, unsigned char* lds, int tid, int lane, int wave, int blk, int G, int cnt_off) {
    constexpr int WTS = 1028;
    float* WT = (float*)lds;
    constexpr int RM = LDS_X + 512;
    int* sel = (int*)(lds + RM);
    float* gat = (float*)(lds + RM + 1024);
    int* lpos = (int*)(lds + RM + 2048);
    float* rstd_s = (float*)(lds + RM + 3072);
    int* lcnt = (int*)(lds + RM + 3328);
    int* gbase = (int*)(lds + RM + 3456);
    float* bpart = (float*)(lds + RM + 12288);
    const float* rw = p.in[34] + (size_t)l * 1024 * 32;
    const float* MOD = WSP(O_MOD, float);
    unsigned* CNT = WSP(O_CTL, unsigned) + CW_CNT + l * 64 + cnt_off;
    bf16_t* XS = WSP(O_XS, bf16_t); int* SLOT = WSP(O_SLOT, int); float* GV = WSP(O_GV, float); int* TOKT = WSP(O_YS, int);
    float* lgt = (float*)(lds + RM + 4096);
    const int m16 = lane & 15, kq = lane >> 4, ttile = wave >> 1, etile = wave & 1;
    int fb = -1;
    for (int item = blk; item < T / 64; item += G) {
        const int b = item >> 6;
        const float* m = MOD + (size_t)(l * 4 + b) * 6144;
        if (b != fb) {
            if (fb >= 0) __syncthreads();
            fb = b;
            float bs[4] = {0.f, 0.f, 0.f, 0.f};
#pragma unroll 1
            for (int i0 = 0; i0 < 16; i0 += 8) {
                f32x4 v[8]; float g2v[8], scv[8], shv[8];
#pragma unroll
                for (int i = 0; i < 8; ++i) { const int idx4 = (i0 + i) * NTHREADS + tid, d = idx4 >> 3, e4 = (idx4 & 7) * 4; v[i] = *(const f32x4*)(rw + d * 32 + e4);
                    g2v[i] = p.in[5][l * 1024 + d]; scv[i] = m[4096 + d]; shv[i] = m[3072 + d]; }
#pragma unroll
                for (int i = 0; i < 8; ++i) { const int idx4 = (i0 + i) * NTHREADS + tid, d = idx4 >> 3, e4 = (idx4 & 7) * 4; const float gm = g2v[i] * (scv[i] + 1.0f), sh = shv[i];
                    WT[(e4 + 0) * WTS + d] = v[i][0] * gm; WT[(e4 + 1) * WTS + d] = v[i][1] * gm; WT[(e4 + 2) * WTS + d] = v[i][2] * gm; WT[(e4 + 3) * WTS + d] = v[i][3] * gm;
                    bs[0] += sh * v[i][0]; bs[1] += sh * v[i][1]; bs[2] += sh * v[i][2]; bs[3] += sh * v[i][3]; } }
#pragma unroll
            for (int j = 0; j < 4; ++j) { float s = dpp_add<0x128>(bs[j]); s += xchg16(s, lane); s += xchg32(s, lane); bs[j] = s; }
            if (lane < 8) { bpart[wave * 32 + lane * 4 + 0] = bs[0]; bpart[wave * 32 + lane * 4 + 1] = bs[1]; bpart[wave * 32 + lane * 4 + 2] = bs[2]; bpart[wave * 32 + lane * 4 + 3] = bs[3]; }
        }
        if (tid < 32) lcnt[tid] = 0;
        __syncthreads();
        { const int tl = ttile * 16 + m16, row = item * 64 + tl;
          const bf16_t* xr = WSP(O_XR, bf16_t) + (size_t)row * 1024 + kq * 256; const float* wt = WT + (etile * 16 + m16) * WTS + kq * 256;
          f32x4 acc = {0.f, 0.f, 0.f, 0.f}, acc1 = {0.f, 0.f, 0.f, 0.f}; float ss = 0.f;
          u32x2 xa[8], xb[8];
#define RT_LOAD(buf, j0) do { _Pragma("unroll") for (int u_ = 0; u_ < 8; ++u_) buf[u_] = *(const u32x2*)(xr + 4 * ((j0) + u_)); } while (0)
#define RT_MMA(buf, j0) do { _Pragma("unroll") for (int u_ = 0; u_ < 8; ++u_) { const f32x4 xv = bf4_to_f32(buf[u_]); const f32x4 wv = *(const f32x4*)(wt + 4 * ((j0) + u_)); \
              ss += xv[0] * xv[0] + xv[1] * xv[1] + xv[2] * xv[2] + xv[3] * xv[3]; \
              acc = __builtin_amdgcn_mfma_f32_16x16x4f32(xv[0], wv[0], acc, 0, 0, 0); acc1 = __builtin_amdgcn_mfma_f32_16x16x4f32(xv[1], wv[1], acc1, 0, 0, 0); \
              acc = __builtin_amdgcn_mfma_f32_16x16x4f32(xv[2], wv[2], acc, 0, 0, 0); acc1 = __builtin_amdgcn_mfma_f32_16x16x4f32(xv[3], wv[3], acc1, 0, 0, 0); } } while (0)
          RT_LOAD(xa, 0); RT_LOAD(xb, 8);
#pragma unroll
          for (int jb = 0; jb < 64; jb += 16) {
              RT_MMA(xa, jb); __builtin_amdgcn_sched_barrier(0); if (jb + 16 < 64) RT_LOAD(xa, jb + 16); __builtin_amdgcn_sched_barrier(0);
              RT_MMA(xb, jb + 8); __builtin_amdgcn_sched_barrier(0); if (jb + 24 < 64) RT_LOAD(xb, jb + 24); __builtin_amdgcn_sched_barrier(0); }
#undef RT_LOAD
#undef RT_MMA
          acc = acc + acc1;
          ss += xchg16(ss, lane); ss += xchg32(ss, lane);
          if (etile == 0 && kq == 0) rstd_s[tl] = rsqrtf(ss * (1.0f / 1024.0f) + 1e-6f);
#pragma unroll
          for (int i = 0; i < 4; ++i) lgt[(ttile * 16 + 4 * kq + i) * 32 + etile * 16 + m16] = acc[i]; }
        __syncthreads();
        { const int me = lane >> 1; float rbias = p.in[35][l * 32 + me];
#pragma unroll
          for (int w = 0; w < 8; ++w) rbias += bpart[w * 32 + me];
#pragma unroll 1
          for (int it = 0; it < 8; ++it) {
            const int tl = wave * 8 + it;
            float val = lgt[tl * 32 + me] * rstd_s[tl] + rbias;
            float tv[4]; int te[4];
#pragma unroll
            for (int k = 0; k < 4; ++k) { const float mxv = wave_max_all(val); const int idx = wave_min_all(val == mxv ? me : 64); tv[k] = mxv; te[k] = idx; if (me == idx) val = -3.0e38f; }
            const float e1 = __expf(tv[1] - tv[0]), e2 = __expf(tv[2] - tv[0]), e3 = __expf(tv[3] - tv[0]); const float inv = 1.0f / (1.0f + e1 + e2 + e3);
            if (lane == 0) {
                const float gg[4] = {inv, e1 * inv, e2 * inv, e3 * inv};
#pragma unroll
                for (int k = 0; k < 4; ++k) { sel[tl * 4 + k] = te[k]; gat[tl * 4 + k] = gg[k]; lpos[tl * 4 + k] = atomicAdd(&lcnt[te[k]], 1); } }
          } }
        __syncthreads();
        if (tid < 32) gbase[tid] = (int)__hip_atomic_fetch_add(CNT + tid, (unsigned)lcnt[tid], __ATOMIC_RELAXED, __HIP_MEMORY_SCOPE_AGENT);
        __syncthreads();
        { f32x4 gmv[4], shv[4], scv_[4];
#pragma unroll
          for (int i = 0; i < 4; ++i) { const int c = i * 256 + lane * 4; gmv[i] = *(const f32x4*)(p.in[5] + l * 1024 + c); scv_[i] = *(const f32x4*)(m + 4096 + c); shv[i] = *(const f32x4*)(m + 3072 + c); }
#pragma unroll
          for (int i = 0; i < 4; ++i) gmv[i] = gmv[i] * (scv_[i] + 1.0f);
#pragma unroll 1
          for (int it0 = 0; it0 < 8; it0 += 4) {
            u32x2 xrow[4][4];
#pragma unroll
            for (int u = 0; u < 4; ++u)
#pragma unroll
                for (int i = 0; i < 4; ++i) xrow[u][i] = *(const u32x2*)(WSP(O_XR, bf16_t) + (size_t)(item * 64 + wave * 8 + it0 + u) * 1024 + i * 256 + lane * 4);
#pragma unroll
          for (int u = 0; u < 4; ++u) { const int it = it0 + u;
            const int tl = wave * 8 + it, row = item * 64 + tl; const float rstd = rstd_s[tl];
            u32x2 w[4];
#pragma unroll
            for (int i = 0; i < 4; ++i) { const f32x4 x = bf4_to_f32(xrow[u][i]);
                const f32x4 hh = x * rstd * gmv[i] + shv[i];
                w[i].x = cvt_pk_bf16(hh[0], hh[1]); w[i].y = cvt_pk_bf16(hh[2], hh[3]); }
#pragma unroll
            for (int i = 0; i < 4; ++i) *(u32x2*)(XS + (size_t)row * 1024 + i * 256 + lane * 4) = w[i];
            if (lane < 4) { const int k = lane; const int e = sel[tl * 4 + k]; const int slot = e * CAP + gbase[e] + lpos[tl * 4 + k];
                SLOT[row * 4 + k] = slot; GV[row * 4 + k] = gat[tl * 4 + k]; TOKT[slot] = row; }
          } } }
        __syncthreads();
    }
}


#if defined(__HIP_DEVICE_COMPILE__)
typedef const __attribute__((address_space(4))) P* KargPtr;
__device__ __forceinline__ P load_params() { KargPtr kp = (KargPtr)__builtin_amdgcn_kernarg_segment_ptr(); asm volatile("" : "+s"(kp)); P r;
    for (int i = 0; i < 40; ++i) r.in[i] = kp->in[i];
    r.out = kp->out; r.ws = kp->ws; r.lo = kp->lo; r.hi = kp->hi; return r; }
#else
__device__ __forceinline__ P load_params() { return P{}; }
#endif
__device__ __forceinline__ int fresh_tid(int wave_s) { asm volatile("" : "+s"(wave_s)); int ln = __builtin_amdgcn_mbcnt_hi(~0u, __builtin_amdgcn_mbcnt_lo(~0u, 0u)); asm volatile("" : "+v"(ln)); return wave_s * 64 + ln; }
#define PHASE_ENV() const P q = load_params(); int blk = blk0, G = G0; asm volatile("" : "+s"(blk), "+s"(G)); const int tid = fresh_tid(wave_s0), lane = tid & 63, wave = __builtin_amdgcn_readfirstlane(tid >> 6); (void)lane; (void)wave

constexpr int PH_PER_LAYER = 12, N_PHASES = 2 + NL * PH_PER_LAYER + 1;
__global__ void __launch_bounds__(NTHREADS, 2) enc_fwd(P p) {
    extern __shared__ __attribute__((aligned(16))) unsigned char lds[];
    const int blk0 = blockIdx.x, G0 = gridDim.x, wave_s0 = __builtin_amdgcn_readfirstlane(threadIdx.x >> 6);
    LAS unsigned char* ldsl = (LAS unsigned char*)lds;
    volatile LAS unsigned* MISC = (volatile LAS unsigned*)(ldsl + LDS_MISC);
    LAS int* moe_pre = (LAS int*)(ldsl + LDS_MISC - 256); LAS int* moe_cnt = (LAS int*)(ldsl + LDS_MISC - 512);
    if (threadIdx.x < 64) MISC[threadIdx.x] = 0u;
    __syncthreads();
#if MK_LAUNCH_PER_PHASE
#define GRID_BAR() do { } while (0)
#else
    XcdBarrier bar = xcd_barrier_post((unsigned*)(p.ws + O_CTL) + CW_BAR, MISC + 8);
#define GRID_BAR() xcd_barrier(bar)
#endif
    const int lo = p.lo, hi = p.hi;
#ifndef EN_MASK
#define EN_MASK 0xFFFFFFFFu
#endif
#define EN(j) ((EN_MASK >> (j)) & 1u)
#ifndef REP_MASK
#define REP_MASK 0u
#endif
#define PROBE_DUMMY(j) (((REP_MASK >> (j)) & 1u) && rep_ == 0)
#define REPS(j) for (int rep_ = 0; rep_ <= (int)((REP_MASK >> (j)) & 1u); ++rep_)
#define IN(k) (lo <= (k) && (k) < hi)
#define SEAM(k) do { if (IN((k) + 1)) { GRID_BAR(); if ((REP_MASK >> 14) & 1u) GRID_BAR(); } } while (0)
#define QWS(off, type) ((type*)(q.ws + (off)))

    if (EN(20) && IN(0)) REPS(20) { { PHASE_ENV(); ph_mod(q, lds, tid, blk, G); } { PHASE_ENV(); ph_convert<false>(q, 0, lds, tid, blk, G, 0, 1 << 30); } { PHASE_ENV(); ph_smallw(q, tid, blk, G); } { PHASE_ENV(); ph_s5ops(q, lds, tid, blk, G); } SEAM(0); }
    if (EN(22) && IN(1)) REPS(22) { { PHASE_ENV(); ph_s5fill(q, tid, blk, G, 0, G == 256 ? 1 : NL); } { PHASE_ENV(); ph_combine_norm(q, -1, 0, lane, wave, blk, G, QWS(O_XR, bf16_t)); } SEAM(1); }

#pragma unroll 1
    for (int l = 0; l < NL; ++l) {
        const int pb = 2 + l * PH_PER_LAYER;
        if (l > 0 && EN(0) && IN(pb + 0)) REPS(0) { PHASE_ENV(); ph_combine_norm(q, l - 1, l, lane, wave, blk, G, PROBE_DUMMY(0) ? QWS(O_HH, bf16_t) : QWS(O_XR, bf16_t)); SEAM(pb + 0); }
        if (EN(1) && IN(pb + 1)) REPS(1) { PHASE_ENV();
            pg8::GridOrder S; S.init(QWS(O_H1, bf16_t), 1024, QWS(O_WIN, bf16_t) + (size_t)l * 3072 * 1024, 1024, T, NPROJ, G, blk, 0);
            EpiBf16T<false> E{QWS(O_PROJ, bf16_t), NPROJ, nullptr, NPROJ, 0};
            pg8::gemm_phase(ldsl, 1024, 1024, 1024, S, E, tid);
            SEAM(pb + 1);
        }
        if (EN(2) && IN(pb + 2)) REPS(2) { PHASE_ENV(); ph_prepass(q, l, lane, wave, blk, G); SEAM(pb + 2); }
        if (EN(3) && IN(pb + 3)) REPS(3) {
            { PHASE_ENV(); pg8::GridOrder S; S.init(QWS(O_ZS, bf16_t), 384, QWS(O_W1C, bf16_t) + (size_t)l * 512 * 384, 384, T, 512, G, blk, 0);
              EpiLvl1 E{QWS(O_HID, bf16_t)};
              pg8::gemm_phase(ldsl, 384, 384, 384, S, E, tid); }
            { PHASE_ENV(); S5SOrder S{(const char*)QWS(O_AS5, bf16_t), (const char*)(QWS(O_WS5S, bf16_t) + (size_t)l * 16 * 256 * 1024), G, (blk - 128 + G) % G};
              EpiF32 E{QWS(O_SLOC, float), 256};
              pg8::gemm_phase(ldsl, 1024, 1280, 1024, S, E, tid); }
            { PHASE_ENV(); if (G == 256 && blk >= 144) ph_convert<true>(q, l, lds, tid, blk - 144, 112, 0, CONV_EARLY); }
            SEAM(pb + 3);
        }
        if (EN(4) && IN(pb + 4)) REPS(4) {
            { PHASE_ENV(); pg8::GridOrder S; S.init(QWS(O_HID, bf16_t), 384, QWS(O_W2B, bf16_t) + (size_t)l * 2048 * 384, 384, T, 2048, G, blk, 0);
              EpiLvl2 E{q.in[18] + l * 768, q.in[21] + l * 768, q.in[27] + l * 384, q.ws};
              pg8::gemm_phase(ldsl, 384, 384, 384, S, E, tid); }
            { PHASE_ENV(); ph_s5carry(q, l, tid, blk); }
            SEAM(pb + 4);
        }
        if (EN(5) && IN(pb + 5)) REPS(5) {
            { PHASE_ENV(); S5YOrder S{(const char*)QWS(O_AS5, bf16_t), (const char*)(QWS(O_WS5Y, bf16_t) + (size_t)l * 16 * 1024 * 1280), G, blk};
              EpiS5Y E{QWS(O_YG, bf16_t)};
              pg8::gemm_phase(ldsl, 1280, 1280, 1280, S, E, tid); }
            { PHASE_ENV(); if (G > 64) { if (blk >= 64) ph_na(q, l, lds, tid, lane, wave, blk - 64, G - 64); } else ph_na(q, l, lds, tid, lane, wave, blk, G); }
            { PHASE_ENV(); if (G == 256) { if (blk < 64) ph_x1(q, lds, tid, lane, wave, blk, 64, 0, 896); else ph_x1(q, lds, tid, lane, wave, blk - 64, 192, 896, 3072); } else ph_x1(q, lds, tid, lane, wave, blk, G, 0, 3072); }
            SEAM(pb + 5);
        }
        if (EN(6) && IN(pb + 6)) REPS(6) {
            { PHASE_ENV(); ph_x2a(q, ldsl, tid, lane, wave, blk); }
            { PHASE_ENV(); pg8::GridOrder S; S.init(QWS(O_YG, bf16_t), 256, QWS(O_WGLU, bf16_t) + (size_t)l * 65536, 256, T, 256, G, blk, 192 % G);
              EpiGlu E{QWS(O_YG, bf16_t), QWS(O_MIX, bf16_t)};
              pg8::gemm_phase(ldsl, 256, 256, 256, S, E, tid); }
            { PHASE_ENV();
              if (G == 256) { constexpr int t0 = CONV_EARLY, rr = 6144 - t0, ta = t0 + (336 * rr) / 6144, tb = t0 + (1936 * rr) / 6144;
                  if (blk < 48) ph_convert<true>(q, l, lds, tid, blk, 48, t0, ta); else if (blk >= 192) ph_convert<true>(q, l, lds, tid, blk - 192, 64, ta, tb); else ph_convert<true>(q, l, lds, tid, blk - 48, 144, tb, 6144); }
              else if (G > 48) { if (blk >= 48) ph_convert<true>(q, l, lds, tid, blk - 48, G - 48, 480, 6144); else ph_convert<true>(q, l, lds, tid, blk, 48, 0, 480); } else ph_convert<true>(q, l, lds, tid, blk, G, 0, 6144); }
            SEAM(pb + 6);
        }
        if (EN(7) && IN(pb + 7)) REPS(7) { PHASE_ENV(); ph_x2b_post(q, l, ldsl, lane, wave, blk, G); SEAM(pb + 7); }
        if (EN(8) && IN(pb + 8)) REPS(8) { PHASE_ENV();
            pg8::GridOrder S; S.init(QWS(O_MIX, bf16_t), 1024, QWS(O_WOUT, bf16_t) + (size_t)l * 1024 * 1024, 1024, T, 1024, G, blk, 0);
            EpiWout E{PROBE_DUMMY(8) ? QWS(O_HH, bf16_t) : QWS(O_XR, bf16_t), QWS(O_MOD, float) + (size_t)(l * 4) * 6144 + 2048};
            pg8::gemm_phase(ldsl, 1024, 1024, 1024, S, E, tid);
            SEAM(pb + 8);
        }
        if (EN(9) && IN(pb + 9)) REPS(9) { PHASE_ENV(); ph_router(q, l, lds, tid, lane, wave, blk, G, PROBE_DUMMY(9) ? 32 : 0); SEAM(pb + 9); }
        if ((EN(10) && IN(pb + 10)) || (EN(11) && IN(pb + 11))) {
            PHASE_ENV();
            if (tid < 32) moe_cnt[tid] = (int)__hip_atomic_load(QWS(O_CTL, unsigned) + CW_CNT + l * 64 + tid, __ATOMIC_RELAXED, __HIP_MEMORY_SCOPE_AGENT);
            __syncthreads();
            if (tid == 0) { int run = 0; for (int e = 0; e < 32; ++e) { moe_pre[e] = run; run += (moe_cnt[e] + 255) >> 8; } moe_pre[32] = run; }
            __syncthreads();
        }
        if (EN(10) && IN(pb + 10)) REPS(10) { PHASE_ENV();
            LAS unsigned* tokl = (LAS unsigned*)(ldsl + LDS_X);
            MoeOrderT<true> S{moe_pre, (const char*)QWS(O_XS, bf16_t), (const char*)(QWS(O_EW1, bf16_t) + (size_t)l * NE * 2048 * 1024), G, blk, 8, (size_t)256 * 1024 * 2, tokl};
            { const int* TOKT = QWS(O_YS, int);
              int tv_[MOE_NTAB / 2]; bool ok_[MOE_NTAB / 2];
#pragma unroll
              for (int k_ = 0; k_ < MOE_NTAB / 2; ++k_) { const int idx = k_ * NTHREADS + tid, ui_ = idx >> 8, r_ = idx & 255; Unit u_; const bool has_ = S.next(ui_, u_);
                  const int orow_ = has_ ? u_.orow : 0, e_ = has_ ? u_.aux : 0; ok_[k_] = has_ && ((orow_ & (CAP - 1)) + r_ < moe_cnt[e_]); tv_[k_] = TOKT[ok_[k_] ? orow_ + r_ : 0]; }
#pragma unroll
              for (int k_ = 0; k_ < MOE_NTAB / 2; ++k_) tokl[k_ * NTHREADS + tid] = ok_[k_] ? (unsigned)tv_[k_] * 2048u : 0u;
              __syncthreads(); }
            EpiSwiglu E{QWS(O_HH, bf16_t), q.in[37] + (size_t)l * NE * 2048};
            pg8::gemm_phase(ldsl, 1024, 1024, 1024, S, E, tid);
            if (G == 256 && l + 1 < NL && rep_ == 0) { PHASE_ENV(); const int nrb = moe_pre[32], rem_rb = nrb & 31, nshort = (32 - rem_rb) * 8; const int q_ = (blk & 7) * 4 + ((blk >> 3) & 3);
                if (rem_rb == 0 || nshort < 64) ph_s5fill(q, tid, blk, G, l + 1, l + 2);
                else if (q_ >= rem_rb) ph_s5fill(q, tid, (q_ - rem_rb) * 8 + (blk >> 5), nshort, l + 1, l + 2); }
            SEAM(pb + 10);
        }
        if (EN(11) && IN(pb + 11)) REPS(11) { PHASE_ENV();
            MoeOrderT<false> S{moe_pre, (const char*)QWS(O_HH, bf16_t), (const char*)(QWS(O_EW2, bf16_t) + (size_t)l * NE * 1024 * 1024), G, blk, 4, (size_t)256 * 1024 * 2, nullptr};
            EpiBf16T<true> E{QWS(O_XS, bf16_t), 1024, q.in[39] + (size_t)l * NE * 1024, 1024, 1024};
            pg8::gemm_phase(ldsl, 1024, 1024, 1024, S, E, tid);
            SEAM(pb + 11);
        }
    }
    if (EN(21) && IN(N_PHASES - 1)) { PHASE_ENV(); ph_combine_norm(q, NL - 1, NL, lane, wave, blk, G, nullptr); }
}

extern "C" void kernel_launch(void* const* d_in, const int* in_sizes, int n_in, void* d_out, int out_size, void* d_ws, size_t ws_size, hipStream_t stream) {
    static int grid = 0;
    if (grid == 0) {
        if (n_in != 40 || out_size != T * D || ws_size < WS_END) { fprintf(stderr, "kernel_launch: unexpected shapes (n_in %d out %d ws %zu)\n", n_in, out_size, ws_size); grid = -1; return; }
        int dev = 0, cus = 0, per_cu = 0;
        if (hipGetDevice(&dev) != hipSuccess || hipDeviceGetAttribute(&cus, hipDeviceAttributeMultiprocessorCount, dev) != hipSuccess) { grid = -1; return; }
        if (hipFuncSetAttribute((const void*)enc_fwd, hipFuncAttributeMaxDynamicSharedMemorySize, LDS_BYTES) != hipSuccess) { fprintf(stderr, "kernel_launch: hipFuncSetAttribute failed\n"); grid = -1; return; }
        if (hipOccupancyMaxActiveBlocksPerMultiprocessor(&per_cu, (const void*)enc_fwd, NTHREADS, LDS_BYTES) != hipSuccess || per_cu < 1) fprintf(stderr, "kernel_launch: occupancy query reports %d\n", per_cu);
        (void)hipGetLastError();
        if (cus * MOE_NTAB < 2304) { fprintf(stderr, "kernel_launch: %d CUs: too few for the expert GEMM's row-offset table\n", cus); grid = -1; return; }
        grid = cus;
    }
    if (grid < 0) return;
    (void)hipMemsetAsync((char*)d_ws + O_CTL, 0, CTL_BYTES, stream);
    P a{};
    for (int i = 0; i < 40; ++i) a.in[i] = (const float*)d_in[i];
    a.out = (float*)d_out; a.ws = (unsigned char*)d_ws;
#if MK_LAUNCH_PER_PHASE
    for (int ph = 0; ph < N_PHASES; ++ph) { a.lo = ph; a.hi = ph + 1; hipLaunchKernelGGL(enc_fwd, dim3(grid), dim3(NTHREADS), LDS_BYTES, stream, a); }
#else
    a.lo = 0; a.hi = N_PHASES;
    hipLaunchKernelGGL(enc_fwd, dim3(grid), dim3(NTHREADS), LDS_BYTES, stream, a);
#endif
}
```

```cpp
#include <hip/hip_runtime.h>
#include <cstdio>
#include <cstdint>

#define LAS __attribute__((address_space(3)))
typedef unsigned short bf16_t;
typedef short bf16x8 __attribute__((ext_vector_type(8)));
typedef short s16x4 __attribute__((ext_vector_type(4)));
typedef float f32x4 __attribute__((ext_vector_type(4)));
typedef float f32x2 __attribute__((ext_vector_type(2)));
typedef unsigned u32x4 __attribute__((ext_vector_type(4)));
typedef unsigned u32x2 __attribute__((ext_vector_type(2)));

#ifndef MK_LAUNCH_PER_PHASE
#define MK_LAUNCH_PER_PHASE 0
#endif

constexpr int T = 16384, D = 1024, NL = 4, SEQ = 4096, NE = 32, CAP = 16384;
constexpr int NPROJ = 3072;
constexpr int NTHREADS = 512;
constexpr size_t MiB = 1u << 20;
constexpr size_t O_CTL = 0, CTL_BYTES = 1 * MiB;
constexpr size_t O_MOD = 1 * MiB;
constexpr size_t O_S5M = 1 * MiB + 512 * 1024;
constexpr size_t O_WIN = 2 * MiB;
constexpr size_t O_WOUT = 26 * MiB;
constexpr size_t O_W1C = 34 * MiB;
constexpr size_t O_W2B = 36 * MiB;
constexpr size_t O_WGLU = 42 * MiB;
constexpr size_t O_WS5S = 43 * MiB;
constexpr size_t O_WS5Y = 75 * MiB;
constexpr size_t O_EW1 = 235 * MiB;
constexpr size_t O_EW2 = 747 * MiB;
constexpr size_t O_H1 = 1003 * MiB;
constexpr size_t O_PROJ = 1035 * MiB;
constexpr size_t O_ZS = 1131 * MiB;
constexpr size_t O_HID = 1143 * MiB;
constexpr size_t O_QN = 1155 * MiB;
constexpr size_t O_KN = 1167 * MiB;
constexpr size_t O_R = 1179 * MiB;
constexpr size_t O_K = 1203 * MiB;
constexpr size_t O_V = 1227 * MiB;
constexpr size_t O_A = 1251 * MiB;
constexpr size_t O_GATE = 1275 * MiB;
constexpr size_t O_DEC = 1299 * MiB;
constexpr size_t O_KD = 1347 * MiB;
constexpr size_t O_BV = 1395 * MiB;
constexpr size_t O_YS = 1443 * MiB;
constexpr size_t O_KT = O_YS + 40 * MiB;
constexpr size_t O_XR = O_YS + 8 * MiB;
constexpr size_t O_RKB = 1491 * MiB;
constexpr size_t O_AS5 = 1492 * MiB;
constexpr size_t O_SLOC = 1502 * MiB;
constexpr size_t O_YG = 1506 * MiB;
constexpr size_t O_MIX = 1514 * MiB;
constexpr size_t O_SLOT = 1546 * MiB;
constexpr size_t O_GV = 1547 * MiB;
constexpr size_t O_XS = 1548 * MiB;
constexpr size_t O_HH = 2572 * MiB;
constexpr size_t O_PHI = O_HH, O_GM = O_HH + 32 * MiB, O_PSIT = O_HH + 64 * MiB, O_YLT = O_HH + 128 * MiB, O_SB = O_HH + 192 * MiB;
constexpr size_t WS_END = 3596 * MiB;
constexpr int CW_BAR = 4096;
constexpr int CW_CNT = 8192;
constexpr int LDS_BYTES = 147456;
constexpr int LDS_MISC = 147456 - 256;
constexpr int LDS_X = 131072;

struct P { const float* in[40]; float* out; unsigned char* ws; int lo, hi; };

typedef __bf16 bf16x2_t __attribute__((ext_vector_type(2)));
__device__ __forceinline__ unsigned cvt_pk_bf16(float lo, float hi) { const f32x2 v = {lo, hi}; return __builtin_bit_cast(unsigned, __builtin_convertvector(v, bf16x2_t)); }
__device__ __forceinline__ float bf2f(bf16_t v) { return __uint_as_float(((unsigned)v) << 16); }
__device__ __forceinline__ bf16_t f2bf(float f) { unsigned u = __float_as_uint(f); u += 0x7FFFu + ((u >> 16) & 1u); return (bf16_t)(u >> 16); }
__device__ __forceinline__ float wsum(float v) {
#pragma unroll
    for (int o = 32; o > 0; o >>= 1) v += __shfl_xor(v, o);
    return v; }
__device__ __forceinline__ float wmaxf(float v) {
#pragma unroll
    for (int o = 32; o > 0; o >>= 1) v = fmaxf(v, __shfl_xor(v, o));
    return v; }
__device__ __forceinline__ int wmini(int v) {
#pragma unroll
    for (int o = 32; o > 0; o >>= 1) v = min(v, __shfl_xor(v, o));
    return v; }
__device__ __forceinline__ float frcp(float x) { return __builtin_amdgcn_rcpf(x); }
__device__ __forceinline__ float sigmoidf_(float x) { return frcp(1.0f + __expf(-x)); }
__device__ __forceinline__ float gelu_tanh(float x) { const float u = 0.7978845608f * (x + 0.044715f * x * x * x); return x * frcp(1.0f + __expf(-2.0f * u)); }

__device__ __forceinline__ f32x4 bf4_to_f32(u32x2 v) { f32x4 r; r[0] = __uint_as_float(v.x << 16); r[1] = __uint_as_float(v.x & 0xFFFF0000u); r[2] = __uint_as_float(v.y << 16); r[3] = __uint_as_float(v.y & 0xFFFF0000u); return r; }
__device__ __forceinline__ u32x2 f32_to_bf4(f32x4 v) { u32x2 w; w.x = cvt_pk_bf16(v[0], v[1]); w.y = cvt_pk_bf16(v[2], v[3]); return w; }
__device__ __forceinline__ unsigned f2h_bits(float f) { return (unsigned)__builtin_bit_cast(unsigned short, (_Float16)f); }
__device__ __forceinline__ float h2f_bits(unsigned h) { return (float)__builtin_bit_cast(_Float16, (unsigned short)h); }
__device__ __forceinline__ u32x2 f32_to_h4(f32x4 v) { u32x2 w; w.x = f2h_bits(v[0]) | (f2h_bits(v[1]) << 16); w.y = f2h_bits(v[2]) | (f2h_bits(v[3]) << 16); return w; }
__device__ __forceinline__ f32x4 h4_to_f32(u32x2 w) { f32x4 r; r[0] = h2f_bits(w.x & 0xFFFFu); r[1] = h2f_bits(w.x >> 16); r[2] = h2f_bits(w.y & 0xFFFFu); r[3] = h2f_bits(w.y >> 16); return r; }
__device__ __forceinline__ float hsum4(f32x4 v) { return (v[0] + v[1]) + (v[2] + v[3]); }
template <int CTRL> __device__ __forceinline__ float dpp_add(float v) { return v + __builtin_bit_cast(float, __builtin_amdgcn_update_dpp(0, __builtin_bit_cast(int, v), CTRL, 0xF, 0xF, true)); }
__device__ __forceinline__ float row16_sum(float v) { v = dpp_add<0xB1>(v); v = dpp_add<0x4E>(v); v = dpp_add<0x124>(v); v = dpp_add<0x128>(v); return v; }

template <int CTRL> __device__ __forceinline__ float dpp_mov(float v) { return __builtin_bit_cast(float, __builtin_amdgcn_update_dpp(0, __builtin_bit_cast(int, v), CTRL, 0xF, 0xF, true)); }
template <int CTRL> __device__ __forceinline__ int dpp_movi(int v) { return __builtin_amdgcn_update_dpp(0, v, CTRL, 0xF, 0xF, true); }
__device__ __forceinline__ void swap16(float& a, float& b) { asm volatile("s_nop 1\n\tv_permlane16_swap_b32 %0, %1\n\ts_nop 0" : "+v"(a), "+v"(b)); }
__device__ __forceinline__ void swap32(float& a, float& b) { asm volatile("s_nop 1\n\tv_permlane32_swap_b32 %0, %1\n\ts_nop 0" : "+v"(a), "+v"(b)); }
__device__ __forceinline__ float xchg16(float send, int lane) { float a = send, b = send; swap16(a, b); return (lane & 16) ? a : b; }
__device__ __forceinline__ float xchg32(float send, int lane) { float a = send, b = send; swap32(a, b); return (lane & 32) ? a : b; }
__device__ __forceinline__ float wave_sum_all(float v) { v = row16_sum(v); { float a = v, b = v; swap16(a, b); v = a + b; } { float a = v, b = v; swap32(a, b); v = a + b; } return v; }
__device__ __forceinline__ float wave_max_all(float v) { v = fmaxf(v, dpp_mov<0xB1>(v)); v = fmaxf(v, dpp_mov<0x4E>(v)); v = fmaxf(v, dpp_mov<0x124>(v)); v = fmaxf(v, dpp_mov<0x128>(v));
    { float a = v, b = v; swap16(a, b); v = fmaxf(a, b); } { float a = v, b = v; swap32(a, b); v = fmaxf(a, b); } return v; }
__device__ __forceinline__ int wave_min_all(int v) { v = min(v, dpp_movi<0xB1>(v)); v = min(v, dpp_movi<0x4E>(v)); v = min(v, dpp_movi<0x124>(v)); v = min(v, dpp_movi<0x128>(v));
    { float a = __builtin_bit_cast(float, v), b = a; swap16(a, b); v = min(__builtin_bit_cast(int, a), __builtin_bit_cast(int, b)); } { float a = __builtin_bit_cast(float, v), b = a; swap32(a, b); v = min(__builtin_bit_cast(int, a), __builtin_bit_cast(int, b)); } return v; }


#define LDS_BARRIER() do { asm volatile("s_waitcnt lgkmcnt(0)" ::: "memory"); __builtin_amdgcn_s_barrier(); asm volatile("" ::: "memory"); } while (0)

#define XB_TMO      128
#define XB_XCNT(j)  (256  + 64 * (j))
#define XB_XSUB(j)  (1280 + 64 * (j))
#define XB_XGEN(j)  (2304 + 64 * (j))
#define XB_TOP      3328
#define XB_TOPGEN   3392
#define XCD_BAR_WORDS 3456
#define XB_SPIN_CAP (1u << 22)
__device__ __forceinline__ unsigned xb_ld(unsigned* p)              { return __hip_atomic_load(p, __ATOMIC_RELAXED, __HIP_MEMORY_SCOPE_AGENT); }
__device__ __forceinline__ unsigned xb_add(unsigned* p, unsigned v) { return __hip_atomic_fetch_add(p, v, __ATOMIC_RELAXED, __HIP_MEMORY_SCOPE_AGENT); }
__device__ __forceinline__ unsigned xb_xcc_id() { return (unsigned)__builtin_amdgcn_s_getreg((3 << 11) | 20) & 0xFu; }
#define XB_SPIN(cond, bar) do { unsigned _sp = 0; while (cond) { __builtin_amdgcn_s_sleep(1); \
    if ((++_sp & 255u) == 0u) { if (xb_ld(&(bar)[XB_TMO])) break; if (_sp > XB_SPIN_CAP) { atomicAdd(&(bar)[XB_TMO], 1u); break; } } } } while (0)
struct XcdBarrier { unsigned* bar; unsigned x; volatile LAS unsigned* st; };
__device__ __forceinline__ XcdBarrier xcd_barrier_post(unsigned* bar, volatile LAS unsigned* st) {
    XcdBarrier b; b.bar = bar; b.x = xb_xcc_id(); b.st = st;
    if (threadIdx.x == 0) (void)xb_add(&bar[XB_XCNT(b.x)], 1u);
    return b;
}
__device__ __forceinline__ void xcd_barrier_complete(unsigned* bar, unsigned x, unsigned& nloc, unsigned& nx) {
    const unsigned G = gridDim.x * gridDim.y * gridDim.z;
    unsigned sum, cnt, mine, sp = 0u;
    for (;;) {
        sum = 0u; cnt = 0u; mine = 0u;
#pragma unroll
        for (unsigned j = 0; j < 16; ++j) { const unsigned c = xb_ld(&bar[XB_XCNT(j)]); sum += c; cnt += (c > 0u) ? 1u : 0u; mine = (j == x) ? c : mine; }
        if (sum == G) break;
        __builtin_amdgcn_s_sleep(1);
        if ((++sp & 255u) == 0u) { if (xb_ld(&bar[XB_TMO])) break; if (sp > XB_SPIN_CAP) { atomicAdd(&bar[XB_TMO], 1u); break; } }
    }
    nloc = mine > 0u ? mine : 1u; nx = cnt > 0u ? cnt : 1u;
}
__device__ __forceinline__ void xcd_barrier(const XcdBarrier& b) {
    asm volatile("s_waitcnt vmcnt(0)" ::: "memory");
    __syncthreads();
    if (threadIdx.x == 0) {
        unsigned* bar = b.bar;
        __builtin_amdgcn_s_waitcnt(0);
        unsigned nloc = b.st[0], nx = b.st[1];
        if (nloc == 0u) { xcd_barrier_complete(bar, b.x, nloc, nx); b.st[0] = nloc; b.st[1] = nx; }
        const unsigned old = xb_add(&bar[XB_XSUB(b.x)], 1u);
        const unsigned gen = old / nloc;
        if (old + 1u == (gen + 1u) * nloc) {
            __builtin_amdgcn_fence(__ATOMIC_RELEASE, "agent");
            asm volatile("s_waitcnt vmcnt(0)" ::: "memory");
            const unsigned og = xb_add(&bar[XB_TOP], 1u);
            const unsigned tg = og / nx;
            if (og + 1u == (tg + 1u) * nx) xb_add(&bar[XB_TOPGEN], 1u);
            else XB_SPIN(xb_ld(&bar[XB_TOPGEN]) == tg, bar);
            __builtin_amdgcn_fence(__ATOMIC_ACQUIRE, "agent");
            xb_add(&bar[XB_XGEN(b.x)], 1u);
            asm volatile("s_waitcnt vmcnt(0)" ::: "memory");
        } else {
            XB_SPIN(xb_ld(&bar[XB_XGEN(b.x)]) == gen, bar);
            __builtin_amdgcn_fence(__ATOMIC_ACQUIRE, "agent");
            asm volatile("s_waitcnt vmcnt(0)" ::: "memory");
        }
    }
    __syncthreads();
}

namespace pg8 {
constexpr int BM = 256, BK = 64, HALF = 128, HTB = HALF * BK * 2, STAGE_BYTES = 8 * HTB, NXCD = 8, WGM = 8;
__host__ __device__ __forceinline__ int lds_byte(int r, int c) { const int st = (r >> 4) * 2 + (c >> 5), rr = r & 15, cc = c & 31, ob = rr * 64 + cc * 2; return st * 1024 + (ob ^ (((ob >> 9) & 1) << 5)); }
__host__ __device__ __forceinline__ void stage_rc(int b, int& R, int& C) { const int st = b / 1024, sb = b % 1024, swz = sb ^ (((sb >> 9) & 1) << 5); R = (st >> 1) * 16 + swz / 64; C = (st & 1) * 32 + (swz % 64) / 2; }
__host__ __device__ __forceinline__ int perm32(int rho) { const int n = rho >> 4, i = rho & 15; return 8 * (i >> 2) + 4 * n + (i & 3); }

struct Unit { const char* a; const char* b; int orow, ocol, aux; };

template <class Epi, class Sched>
__device__ __forceinline__ void gemm_phase(LAS unsigned char* lds, const int K, const int lda, const int ldb, const Sched& S, const Epi& E, const int tid_in) {
    const int tid = tid_in, wid = __builtin_amdgcn_readfirstlane(tid >> 6), lane = tid & 63, wr = wid >> 2, wc = wid & 3, fr = lane & 15, fq = lane >> 4;
    const int nt = K / BK;
    constexpr bool GA = Sched::GATHER;
    unsigned voffA[2], voffB[2]; int rowA[2]; unsigned gc[2][2], gn[2][2];
#pragma unroll
    for (int i = 0; i < 2; ++i) { int R, C; stage_rc(tid * 16 + i * 8192, R, C); const int Rb = Epi::PERM ? ((R & ~31) + perm32(R & 31)) : R;
        voffA[i] = GA ? (unsigned)C * 2u : (unsigned)(R * lda + C) * 2u; voffB[i] = (unsigned)(Rb * ldb + C) * 2u; rowA[i] = R; }
#define PG8_GLOAD(g, ui_) do { if constexpr (GA) { _Pragma("unroll") for (int h_ = 0; h_ < 2; ++h_) _Pragma("unroll") for (int i_ = 0; i_ < 2; ++i_) g[h_][i_] = S.tok_off((ui_), h_ * 128 + rowA[i_]) + voffA[i_]; } } while (0)
#define PG8_STAGE_A(bufoff, base, kb, h, g) do { if constexpr (GA) { _Pragma("unroll") for (int _i = 0; _i < 2; ++_i) \
        __builtin_amdgcn_global_load_lds((const unsigned*)((const char*)(base) + (kb) + g[h][_i]), (LAS unsigned*)(lds + (bufoff) + ldsw + _i * 8192), 16, 0, 0); } \
        else PG8_STAGE(bufoff, (base) + (kb) + (h) * hstepA, voffA); } while (0)
    const size_t kstep = (size_t)(BK * 2);
    const size_t hstepA = (size_t)HALF * lda * 2, hstepB = (size_t)HALF * ldb * 2;
    const unsigned ldsw = (unsigned)wid * 1024u;
    const int aoff = lds_byte(wr * 64 + fr, fq * 8), boff = lds_byte(wc * 32 + fr, fq * 8);
#define PG8_SA(b, h) (((b) * 2 + (h)) * HTB)
#define PG8_SB(b, h) ((4 + (b) * 2 + (h)) * HTB)
#define PG8_STAGE(bufoff, gbase, voff) do { _Pragma("unroll") for (int _i = 0; _i < 2; ++_i) \
        __builtin_amdgcn_global_load_lds((const unsigned*)((const char*)(gbase) + (voff)[_i]), (LAS unsigned*)(lds + (bufoff) + ldsw + _i * 8192), 16, 0, 0); } while (0)
#define PG8_LDA(dst, b, h) do { _Pragma("unroll") for (int m = 0; m < 4; ++m) _Pragma("unroll") for (int k = 0; k < 2; ++k) dst[m][k] = *(const LAS bf16x8*)(lds + PG8_SA(b, h) + aoff + m * 2048 + k * 1024); } while (0)
#define PG8_LDB(dst, b, h) do { _Pragma("unroll") for (int n = 0; n < 2; ++n) _Pragma("unroll") for (int k = 0; k < 2; ++k) dst[n][k] = *(const LAS bf16x8*)(lds + PG8_SB(b, h) + boff + n * 2048 + k * 1024); } while (0)
#define PG8_MMA(ai, bj, At, Bt) do { __builtin_amdgcn_s_setprio(1); _Pragma("unroll") for (int m = 0; m < 4; ++m) _Pragma("unroll") for (int n = 0; n < 2; ++n) _Pragma("unroll") for (int k = 0; k < 2; ++k) \
        acc[ai][bj][m][n] = __builtin_amdgcn_mfma_f32_16x16x32_bf16(Bt[n][k], At[m][k], acc[ai][bj][m][n], 0, 0, 0); __builtin_amdgcn_s_setprio(0); } while (0)
#define PG8_WAIT_V(n) asm volatile("s_waitcnt vmcnt(" #n ")" ::: "memory")
#define PG8_WAIT_L(n) asm volatile("s_waitcnt lgkmcnt(" #n ")" ::: "memory")
#define PG8_BAR __builtin_amdgcn_s_barrier()
#define PG8_SCHED __builtin_amdgcn_sched_barrier(0)
    Unit cur, nxt; int ui = 0;
    if (!S.next(0, cur)) return;
    f32x4 acc[2][2][4][2];
#pragma unroll
    for (int a = 0; a < 2; ++a)
#pragma unroll
        for (int b = 0; b < 2; ++b)
#pragma unroll
            for (int m = 0; m < 4; ++m)
#pragma unroll
                for (int n = 0; n < 2; ++n) acc[a][b][m][n] = (f32x4){0.f, 0.f, 0.f, 0.f};
    bf16x8 At[4][2], B0[2][2], B1[2][2];
    const char* cA = cur.a; const char* cB = cur.b;
    PG8_GLOAD(gc, 0);
    PG8_STAGE(PG8_SB(0, 0), cB, voffB); PG8_STAGE(PG8_SB(0, 1), cB + hstepB, voffB); PG8_STAGE_A(PG8_SA(0, 0), cA, 0, 0, gc); PG8_STAGE_A(PG8_SA(0, 1), cA, 0, 1, gc);
    if (wr == 1) PG8_BAR;
    PG8_WAIT_V(2); PG8_BAR;
    PG8_STAGE(PG8_SB(1, 0), cB + kstep, voffB); PG8_STAGE_A(PG8_SA(1, 0), cA, kstep, 0, gc); PG8_STAGE(PG8_SB(1, 1), cB + hstepB + kstep, voffB);
    PG8_WAIT_V(6); PG8_BAR;
    for (;;) {
        const bool has_next = S.next(ui + 1, nxt);
        const char* nA = has_next ? nxt.a : cA; const char* nB = has_next ? nxt.b : cB;
        if constexpr (GA) { if (has_next) PG8_GLOAD(gn, ui + 1); else {
#pragma unroll
            for (int h_ = 0; h_ < 2; ++h_)
#pragma unroll
                for (int i_ = 0; i_ < 2; ++i_) gn[h_][i_] = gc[h_][i_]; } }
#pragma unroll 1
        for (int t = 0; t < nt; t += 2) {
            const bool last = (t == nt - 2);
            const size_t k1 = (size_t)(t + 1) * kstep, k2 = last ? (size_t)0 : (size_t)(t + 2) * kstep, k3 = k2 + kstep;
            const char* a2 = last ? nA : cA; const char* b2 = last ? nB : cB;
            unsigned g2[2][2];
#pragma unroll
            for (int h_ = 0; h_ < 2; ++h_)
#pragma unroll
                for (int i_ = 0; i_ < 2; ++i_) g2[h_][i_] = GA ? (last ? gn[h_][i_] : gc[h_][i_]) : 0u;
            PG8_LDB(B0, 0, 0); PG8_LDB(B1, 0, 1); PG8_SCHED; PG8_LDA(At, 0, 0); PG8_STAGE_A(PG8_SA(1, 1), cA, k1, 1, gc);
            PG8_WAIT_V(8); PG8_WAIT_L(0); PG8_BAR; PG8_MMA(0, 0, At, B0); PG8_MMA(0, 1, At, B1); PG8_BAR; PG8_SCHED;
            PG8_LDA(At, 0, 1); PG8_STAGE(PG8_SB(0, 0), b2 + k2, voffB); PG8_STAGE(PG8_SB(0, 1), b2 + k2 + hstepB, voffB); PG8_STAGE_A(PG8_SA(0, 0), a2, k2, 0, g2);
            PG8_WAIT_V(8); PG8_WAIT_L(0); PG8_BAR; PG8_MMA(1, 0, At, B0); PG8_MMA(1, 1, At, B1); PG8_BAR; PG8_SCHED;
            PG8_LDB(B0, 1, 0); PG8_LDB(B1, 1, 1); PG8_SCHED; PG8_LDA(At, 1, 0); PG8_STAGE_A(PG8_SA(0, 1), a2, k2, 1, g2);
            PG8_WAIT_V(8); PG8_WAIT_L(0); PG8_BAR; PG8_MMA(0, 0, At, B0); PG8_MMA(0, 1, At, B1); PG8_BAR; PG8_SCHED;
            PG8_LDA(At, 1, 1); PG8_STAGE(PG8_SB(1, 0), b2 + k3, voffB); PG8_STAGE(PG8_SB(1, 1), b2 + k3 + hstepB, voffB); PG8_STAGE_A(PG8_SA(1, 0), a2, k3, 0, g2);
            PG8_WAIT_V(8); PG8_WAIT_L(0); PG8_BAR; PG8_MMA(1, 0, At, B0); PG8_MMA(1, 1, At, B1); PG8_BAR; PG8_SCHED;
        }
        if (wr == 0) PG8_BAR;
        E(acc, cur, wr, wc, fr, fq);
        if constexpr (Epi::DRAIN) __builtin_amdgcn_s_waitcnt(0x0F70);
        if (!has_next) break;
#pragma unroll
        for (int a = 0; a < 2; ++a)
#pragma unroll
            for (int b = 0; b < 2; ++b)
#pragma unroll
                for (int m = 0; m < 4; ++m)
#pragma unroll
                    for (int n = 0; n < 2; ++n) acc[a][b][m][n] = (f32x4){0.f, 0.f, 0.f, 0.f};
        cur = nxt; cA = nA; cB = nB; ++ui;
        if constexpr (GA) {
#pragma unroll
            for (int h_ = 0; h_ < 2; ++h_)
#pragma unroll
                for (int i_ = 0; i_ < 2; ++i_) gc[h_][i_] = gn[h_][i_]; }
        if (wr == 1) PG8_BAR;
    }
    PG8_WAIT_V(0);
    PG8_BAR;
#undef PG8_SA
#undef PG8_SB
#undef PG8_STAGE
#undef PG8_STAGE_A
#undef PG8_GLOAD
#undef PG8_LDA
#undef PG8_LDB
#undef PG8_MMA
#undef PG8_WAIT_V
#undef PG8_WAIT_L
#undef PG8_BAR
#undef PG8_SCHED
}

struct GridOrder {
    static constexpr bool GATHER = false; __device__ __forceinline__ unsigned tok_off(int, int) const { return 0u; }
    const char* A; const char* B; size_t tA, tB; int nM, nN, nwg, G, c;
    __device__ __forceinline__ void init(const void* A_, int lda, const void* B_, int ldb, int M, int N, int G_, int blk, int off) {
        A = (const char*)A_; B = (const char*)B_; tA = (size_t)256 * lda * 2; tB = (size_t)256 * ldb * 2; nM = M / BM; nN = N / BM; nwg = nM * nN; G = G_; c = (blk - off + G_) % G_; }
    __device__ __forceinline__ bool next(int i, Unit& u) const {
        const long L = (long)i * G + c; if (L >= nwg) return false;
        int wgid = (int)L; { const int q = nwg / NXCD, r = nwg % NXCD, xcd = wgid % NXCD, off = wgid / NXCD; wgid = (xcd < r ? xcd * (q + 1) : r * (q + 1) + (xcd - r) * q) + off; }
        const int nig = WGM * nN, gid = wgid / nig, fm = gid * WGM, gsz = (nM - fm) < WGM ? (nM - fm) : WGM;
        const int pm = fm + ((wgid % nig) % gsz), pn = (wgid % nig) / gsz;
        u.a = A + (size_t)pm * tA; u.b = B + (size_t)pn * tB; u.orow = pm * BM; u.ocol = pn * BM; u.aux = 0; return true;
    }
};
}
using pg8::Unit;

#define EPI_LOOP_ROWS for (int ai = 0; ai < 2; ++ai) _Pragma("unroll") for (int m = 0; m < 4; ++m)
template <bool DRAIN_> struct EpiBf16T {
    static constexpr bool PERM = true, DRAIN = DRAIN_;
    bf16_t* O; int ldc; const float* bias; int ncols;
    int biasld;
    __device__ __forceinline__ void operator()(const f32x4 (&acc)[2][2][4][2], const Unit& u, int wr, int wc, int fr, int fq) const {
        const int row0 = u.orow + wr * 64 + fr, col0 = u.ocol + wc * 32 + 8 * fq;
        f32x4 bv[2][2];
#pragma unroll
        for (int bj = 0; bj < 2; ++bj)
#pragma unroll
            for (int n = 0; n < 2; ++n) bv[bj][n] = bias ? *(const f32x4*)(bias + (size_t)u.aux * biasld + col0 + bj * 128 + 4 * n) : (f32x4){0.f, 0.f, 0.f, 0.f};
#pragma unroll
        EPI_LOOP_ROWS { bf16_t* rowp = O + (size_t)(row0 + ai * 128 + m * 16) * ldc + col0;
#pragma unroll
            for (int bj = 0; bj < 2; ++bj) { if (col0 + bj * 128 < ncols) { const f32x4 v0 = acc[ai][bj][m][0] + bv[bj][0], v1 = acc[ai][bj][m][1] + bv[bj][1];
                u32x4 w; w.x = cvt_pk_bf16(v0[0], v0[1]); w.y = cvt_pk_bf16(v0[2], v0[3]); w.z = cvt_pk_bf16(v1[0], v1[1]); w.w = cvt_pk_bf16(v1[2], v1[3]);
                *(u32x4*)(rowp + bj * 128) = w; } } }
    }
};
struct EpiLvl1 {
    static constexpr bool PERM = true, DRAIN = false;
    bf16_t* O;
    __device__ __forceinline__ void operator()(const f32x4 (&acc)[2][2][4][2], const Unit& u, int wr, int wc, int fr, int fq) const {
        const int row0 = u.orow + wr * 64 + fr, col0 = u.ocol + wc * 32 + 8 * fq;
#pragma unroll
        EPI_LOOP_ROWS { bf16_t* rowp = O + (size_t)(row0 + ai * 128 + m * 16) * 384 + col0;
#pragma unroll
            for (int bj = 0; bj < 2; ++bj) { const int c = col0 + bj * 128; if (c < 384) { f32x4 v0 = acc[ai][bj][m][0], v1 = acc[ai][bj][m][1];
#pragma unroll
                for (int j = 0; j < 4; ++j) {
                    if (c < 128) { v0[j] = 1.0f - 2.0f * frcp(__expf(2.0f * fminf(fmaxf(v0[j], -15.f), 15.f)) + 1.0f); v1[j] = 1.0f - 2.0f * frcp(__expf(2.0f * fminf(fmaxf(v1[j], -15.f), 15.f)) + 1.0f); }
                    else if (c >= 256) { v0[j] = sigmoidf_(v0[j]); v1[j] = sigmoidf_(v1[j]); } }
                u32x4 w; w.x = cvt_pk_bf16(v0[0], v0[1]); w.y = cvt_pk_bf16(v0[2], v0[3]); w.z = cvt_pk_bf16(v1[0], v1[1]); w.w = cvt_pk_bf16(v1[2], v1[3]);
                *(u32x4*)(rowp + bj * 128) = w; } } }
    }
};
struct EpiLvl2 {
    static constexpr bool PERM = false, DRAIN = false;
    const float* w0; const float* a0; const float* k_a;
    unsigned char* ws;
    template <int BJ, int N_>
    __device__ __forceinline__ void part(const f32x4 (&acc)[2][2][4][2], int row0, int col0) const {
        const int c = col0 + BJ * 128 + N_ * 16;
        const int seg = c / 384, cc = c - seg * 384;
        if (seg < 2) {
            bf16_t* DEC = (bf16_t*)(ws + O_DEC) + (size_t)seg * T * 384;
            const f32x4 w0v = *(const f32x4*)(w0 + seg * 384 + cc);
#pragma unroll
            for (int ai = 0; ai < 2; ++ai)
#pragma unroll
                for (int m = 0; m < 4; ++m) { const size_t ro = (size_t)(row0 + ai * 128 + m * 16) * 384 + cc; f32x4 o;
#pragma unroll
                    for (int j = 0; j < 4; ++j) { const float pre = w0v[j] + acc[ai][BJ][m][N_][j]; o[j] = __expf(-0.60653065971f * sigmoidf_(pre)); }
                    *(u32x2*)(DEC + ro) = f32_to_h4(o); }
        } else if (seg < 4) {
            const int d = seg - 2; const f32x4 a0v = *(const f32x4*)(a0 + d * 384 + cc), kav = *(const f32x4*)(k_a + cc);
            const bf16_t* Kb = (const bf16_t*)(ws + O_K); const bf16_t* Ab = (const bf16_t*)(ws + O_A);
            bf16_t* KD = (bf16_t*)(ws + O_KD) + (size_t)d * T * 384; bf16_t* BV = (bf16_t*)(ws + O_BV) + (size_t)d * T * 384;
            u32x2 kraw[2][4], araw[2][4];
#pragma unroll
            for (int ai = 0; ai < 2; ++ai)
#pragma unroll
                for (int m = 0; m < 4; ++m) { const size_t ro = (size_t)(row0 + ai * 128 + m * 16) * 384 + cc; kraw[ai][m] = *(const u32x2*)(Kb + ro); araw[ai][m] = *(const u32x2*)(Ab + ro); }
#pragma unroll
            for (int ai = 0; ai < 2; ++ai)
#pragma unroll
                for (int m = 0; m < 4; ++m) { const size_t ro = (size_t)(row0 + ai * 128 + m * 16) * 384 + cc; const f32x4 kv = bf4_to_f32(kraw[ai][m]), av = bf4_to_f32(araw[ai][m]); f32x4 okd, obv;
#pragma unroll
                    for (int j = 0; j < 4; ++j) { const float as = sigmoidf_(a0v[j] + acc[ai][BJ][m][N_][j]); okd[j] = kv[j] * (1.0f + (as - 1.0f) * kav[j]); obv[j] = -av[j] * as; }
                    *(u32x2*)(KD + ro) = f32_to_bf4(okd); *(u32x2*)(BV + ro) = f32_to_bf4(obv); }
        } else if (seg == 4) {
            bf16_t* GATE = (bf16_t*)(ws + O_GATE);
#pragma unroll
            for (int ai = 0; ai < 2; ++ai)
#pragma unroll
                for (int m = 0; m < 4; ++m) { const size_t ro = (size_t)(row0 + ai * 128 + m * 16) * 384 + cc; *(u32x2*)(GATE + ro) = f32_to_bf4(acc[ai][BJ][m][N_]); }
        }
    }
    __device__ __forceinline__ void operator()(const f32x4 (&acc)[2][2][4][2], const Unit& u, int wr, int wc, int fr, int fq) const {
        const int row0 = u.orow + wr * 64 + fr, col0 = u.ocol + wc * 32 + 4 * fq;
        part<0, 0>(acc, row0, col0); part<0, 1>(acc, row0, col0); part<1, 0>(acc, row0, col0); part<1, 1>(acc, row0, col0);
    }
};
struct EpiF32 {
    static constexpr bool PERM = false, DRAIN = false;
    float* C; int ldc;
    __device__ __forceinline__ void operator()(const f32x4 (&acc)[2][2][4][2], const Unit& u, int wr, int wc, int fr, int fq) const {
        const int row0 = u.orow + wr * 64 + fr, col0 = u.ocol + wc * 32 + 4 * fq;
#pragma unroll
        EPI_LOOP_ROWS { float* rowp = C + (size_t)(row0 + ai * 128 + m * 16) * ldc + col0;
#pragma unroll
            for (int bj = 0; bj < 2; ++bj)
#pragma unroll
                for (int n = 0; n < 2; ++n) *(f32x4*)(rowp + bj * 128 + n * 16) = acc[ai][bj][m][n]; }
    }
};
struct EpiS5Y {
    static constexpr bool PERM = true, DRAIN = false;
    bf16_t* YG;
    __device__ __forceinline__ void operator()(const f32x4 (&acc)[2][2][4][2], const Unit& u, int wr, int wc, int fr, int fq) const {
        const int row0 = u.orow + wr * 64 + fr, col0 = u.ocol + wc * 32 + 8 * fq;
#pragma unroll
        EPI_LOOP_ROWS { const int chunk = row0 + ai * 128 + m * 16;
#pragma unroll
            for (int bj = 0; bj < 2; ++bj) { const int nn = col0 + bj * 128, t = nn >> 4, ho = nn & 15; const f32x4 v0 = acc[ai][bj][m][0], v1 = acc[ai][bj][m][1];
                u32x4 w; w.x = cvt_pk_bf16(gelu_tanh(v0[0]), gelu_tanh(v0[1])); w.y = cvt_pk_bf16(gelu_tanh(v0[2]), gelu_tanh(v0[3])); w.z = cvt_pk_bf16(gelu_tanh(v1[0]), gelu_tanh(v1[1])); w.w = cvt_pk_bf16(gelu_tanh(v1[2]), gelu_tanh(v1[3]));
                *(u32x4*)(YG + (size_t)(chunk * 64 + t) * 256 + u.aux * 16 + ho) = w; } }
    }
};
struct EpiGlu {
    static constexpr bool PERM = true, DRAIN = false;
    const bf16_t* YG; bf16_t* MIX;
    __device__ __forceinline__ void operator()(const f32x4 (&acc)[2][2][4][2], const Unit& u, int wr, int wc, int fr, int fq) const {
        const int row0 = u.orow + wr * 64 + fr, col0 = u.ocol + wc * 32 + 8 * fq;
        u32x4 yraw[2][4][2];
#pragma unroll
        EPI_LOOP_ROWS {
#pragma unroll
            for (int bj = 0; bj < 2; ++bj) yraw[ai][m][bj] = *(const u32x4*)(YG + (size_t)(row0 + ai * 128 + m * 16) * 256 + col0 + bj * 128); }
#pragma unroll
        EPI_LOOP_ROWS { const size_t row = (size_t)(row0 + ai * 128 + m * 16);
#pragma unroll
            for (int bj = 0; bj < 2; ++bj) { const int c = col0 + bj * 128; const u32x4 yv = yraw[ai][m][bj]; const f32x4 v0 = acc[ai][bj][m][0], v1 = acc[ai][bj][m][1];
                float y[8]; y[0] = __uint_as_float(yv.x << 16); y[1] = __uint_as_float(yv.x & 0xFFFF0000u); y[2] = __uint_as_float(yv.y << 16); y[3] = __uint_as_float(yv.y & 0xFFFF0000u);
                y[4] = __uint_as_float(yv.z << 16); y[5] = __uint_as_float(yv.z & 0xFFFF0000u); y[6] = __uint_as_float(yv.w << 16); y[7] = __uint_as_float(yv.w & 0xFFFF0000u);
                u32x4 w; w.x = cvt_pk_bf16(y[0] * sigmoidf_(v0[0]), y[1] * sigmoidf_(v0[1])); w.y = cvt_pk_bf16(y[2] * sigmoidf_(v0[2]), y[3] * sigmoidf_(v0[3]));
                w.z = cvt_pk_bf16(y[4] * sigmoidf_(v1[0]), y[5] * sigmoidf_(v1[1])); w.w = cvt_pk_bf16(y[6] * sigmoidf_(v1[2]), y[7] * sigmoidf_(v1[3]));
                *(u32x4*)(MIX + row * 1024 + c) = w; } }
    }
};
struct EpiWout {
    static constexpr bool PERM = false, DRAIN = false;
    bf16_t* X; const float* gate;
    __device__ __forceinline__ void operator()(const f32x4 (&acc)[2][2][4][2], const Unit& u, int wr, int wc, int fr, int fq) const {
        const int row0 = u.orow + wr * 64 + fr, col0 = u.ocol + wc * 32 + 4 * fq; const int b = u.orow >> 12;
        f32x4 gv[2][2];
#pragma unroll
        for (int bj = 0; bj < 2; ++bj)
#pragma unroll
            for (int n = 0; n < 2; ++n) gv[bj][n] = *(const f32x4*)(gate + (size_t)b * 6144 + col0 + bj * 128 + n * 16);
        u32x2 old[2][4][2][2];
#pragma unroll
        for (int ai = 0; ai < 2; ++ai)
#pragma unroll
            for (int m = 0; m < 4; ++m)
#pragma unroll
                for (int bj = 0; bj < 2; ++bj)
#pragma unroll
                    for (int n = 0; n < 2; ++n) old[ai][m][bj][n] = *(const u32x2*)(X + (size_t)(row0 + ai * 128 + m * 16) * 1024 + col0 + bj * 128 + n * 16);
#pragma unroll
        for (int ai = 0; ai < 2; ++ai)
#pragma unroll
            for (int m = 0; m < 4; ++m)
#pragma unroll
                for (int bj = 0; bj < 2; ++bj)
#pragma unroll
                    for (int n = 0; n < 2; ++n) *(u32x2*)(X + (size_t)(row0 + ai * 128 + m * 16) * 1024 + col0 + bj * 128 + n * 16) = f32_to_bf4(bf4_to_f32(old[ai][m][bj][n]) + gv[bj][n] * acc[ai][bj][m][n]);
    }
};
struct EpiSwiglu {
    static constexpr bool PERM = true, DRAIN = false;
    bf16_t* HH; const float* b1;
    __device__ __forceinline__ void operator()(const f32x4 (&acc)[2][2][4][2], const Unit& u, int wr, int wc, int fr, int fq) const {
        const int row0 = u.orow + wr * 64 + fr, col0 = u.ocol + wc * 32 + 8 * fq;
        f32x4 bv[2][2];
#pragma unroll
        for (int bj = 0; bj < 2; ++bj)
#pragma unroll
            for (int n = 0; n < 2; ++n) bv[bj][n] = *(const f32x4*)(b1 + (size_t)u.aux * 2048 + col0 + bj * 128 + 4 * n);
#pragma unroll
        EPI_LOOP_ROWS { bf16_t* rowp = HH + (size_t)(row0 + ai * 128 + m * 16) * 1024 + (col0 >> 1);
#pragma unroll
            for (int bj = 0; bj < 2; ++bj) { const f32x4 v0 = acc[ai][bj][m][0] + bv[bj][0], v1 = acc[ai][bj][m][1] + bv[bj][1];
                float o[4];
#pragma unroll
                for (int j = 0; j < 4; ++j) { const float g = fminf(j < 2 ? v0[2 * j] : v1[2 * j - 4], 7.0f); const float li = fminf(fmaxf(j < 2 ? v0[2 * j + 1] : v1[2 * j - 3], -7.0f), 7.0f);
                    o[j] = g * sigmoidf_(1.702f * g) * (li + 1.0f); }
                u32x2 w; w.x = cvt_pk_bf16(o[0], o[1]); w.y = cvt_pk_bf16(o[2], o[3]);
                *(u32x2*)(rowp + bj * 64) = w; } }
    }
};

struct S5SOrder {
    static constexpr bool GATHER = false; __device__ __forceinline__ unsigned tok_off(int, int) const { return 0u; }
    const char* A; const char* B; int G, c;
    __device__ __forceinline__ bool next(int i, Unit& u) const { const int L = i * G + c; if (L >= 16) return false;
        u.a = A + (size_t)L * 256 * 1280 * 2; u.b = B + (size_t)L * 256 * 1024 * 2; u.orow = L * 256; u.ocol = 0; u.aux = L; return true; }
};
struct S5YOrder {
    static constexpr bool GATHER = false; __device__ __forceinline__ unsigned tok_off(int, int) const { return 0u; }
    const char* A; const char* B; int G, c;
    __device__ __forceinline__ bool next(int i, Unit& u) const { const int L = i * G + c; if (L >= 64) return false; const int g = L >> 2, pn = L & 3;
        u.a = A + (size_t)g * 256 * 1280 * 2; u.b = B + (size_t)(g * 1024 + pn * 256) * 1280 * 2; u.orow = 0; u.ocol = pn * 256; u.aux = g; return true; }
};
template <bool GATHER_> struct MoeOrderT {
    static constexpr bool GATHER = GATHER_;
    const LAS int* pre; const char* A; const char* B; int G, c, npn; size_t tB; const LAS unsigned* tokl;
    __device__ __forceinline__ unsigned tok_off(int ui, int r) const { return tokl[ui * 256 + r]; }
    __device__ __forceinline__ bool next(int i, Unit& u) const {
        int rbg, pn;
        if (G == 256) { const int xcd = c & 7, j = c >> 3; if (npn == 8) { rbg = i * 32 + xcd * 4 + (j & 3); pn = j >> 2; } else { rbg = i * 64 + xcd * 8 + (j & 7); pn = j >> 3; } }
        else { const int L = i * G + c; rbg = L / npn; pn = L - rbg * npn; }
        if (rbg >= pre[32]) return false;
        int e = 0;
#pragma unroll 1
        for (int s = 16; s > 0; s >>= 1) if (pre[e + s] <= rbg) e += s;
        const int rb = rbg - pre[e];
        u.a = GATHER_ ? A : A + (size_t)(e * 64 + rb) * (256 * 1024 * 2); u.b = B + (size_t)(e * npn + pn) * tB; u.orow = (e * 64 + rb) * 256; u.ocol = pn * 256; u.aux = e; return true;
    }
};
constexpr int CONV_EARLY = 336;
constexpr int MOE_NTAB = 14;

#define WSP(off, type) ((type*)(p.ws + (off)))

__device__ __forceinline__ void ph_mod(const P& p, unsigned char* lds, int tid, int blk, int G) {
    float* cond = (float*)lds;
    float* red = cond + 4096;
    for (int i = tid; i < 4096; i += NTHREADS) { const float c = p.in[1][i]; cond[i] = c / (1.0f + __expf(-c)); }
    __syncthreads();
    float* MOD = WSP(O_MOD, float);
    for (int item = blk; item < 256; item += G) {
        const int l = item >> 6, cb = item & 63;
        const int col = tid % 96, part = tid / 96;
        if (part < 5) {
            float a0 = 0.f, a1 = 0.f, a2 = 0.f, a3 = 0.f;
            const int d0 = part * 205, d1 = min(1024, d0 + 205);
            const float* w = p.in[2] + (size_t)l * 1024 * 6144 + cb * 96 + col;
            for (int db = d0; db < d1; db += 32) {
                float wv[32];
#pragma unroll
                for (int u = 0; u < 32; ++u) { const int d = min(db + u, d1 - 1); wv[u] = w[(size_t)d * 6144]; }
#pragma unroll
                for (int u = 0; u < 32; ++u) { const int d = db + u; const float x = d < d1 ? wv[u] : 0.f; const int dc = min(d, 1023); a0 += cond[dc] * x; a1 += cond[1024 + dc] * x; a2 += cond[2048 + dc] * x; a3 += cond[3072 + dc] * x; } }
            red[(part * 4 + 0) * 96 + col] = a0; red[(part * 4 + 1) * 96 + col] = a1; red[(part * 4 + 2) * 96 + col] = a2; red[(part * 4 + 3) * 96 + col] = a3;
        }
        __syncthreads();
        if (tid < 384) { const int b = tid / 96, c2 = tid % 96; float s = 0.f;
            for (int q = 0; q < 5; ++q) s += red[(q * 4 + b) * 96 + c2];
            MOD[(size_t)(l * 4 + b) * 6144 + cb * 96 + c2] = s + p.in[3][l * 6144 + cb * 96 + c2]; }
        __syncthreads();
    }
}

struct ConvTile { const float* src; bf16_t* dst; int N, kt, nt; };
__device__ __forceinline__ void conv_load(const ConvTile& t, int tid, f32x4 (&r)[8]) {
#pragma unroll
    for (int i = 0; i < 8; ++i) { const int idx = i * NTHREADS + tid, kk = idx >> 6, n = t.nt * 256 + (idx & 63) * 4;
        r[i] = (f32x4){0.f, 0.f, 0.f, 0.f};
        if (n < t.N) r[i] = __builtin_nontemporal_load((const f32x4*)(t.src + (size_t)(t.kt * 64 + kk) * t.N + n)); }
}
__device__ __forceinline__ void conv_to_lds(int tid, const f32x4 (&r)[8], float* tile) {
#pragma unroll
    for (int i = 0; i < 8; ++i) { const int idx = i * NTHREADS + tid, kk = idx >> 6, n4 = (idx & 63) * 4; float* d = tile + kk * 257 + n4; d[0] = r[i][0]; d[1] = r[i][1]; d[2] = r[i][2]; d[3] = r[i][3]; }
}
__device__ __forceinline__ void conv_from_lds(const ConvTile& t, int tid, const float* tile) {
    const int n = tid >> 1, kh = tid & 1; bf16_t* d = t.dst + (size_t)(t.nt * 256 + n) * 1024 + t.kt * 64 + kh * 32;
#pragma unroll
    for (int q = 0; q < 4; ++q) { float f[8];
#pragma unroll
        for (int j = 0; j < 8; ++j) f[j] = tile[(kh * 32 + q * 8 + j) * 257 + n];
        u32x4 w; w.x = cvt_pk_bf16(f[0], f[1]); w.y = cvt_pk_bf16(f[2], f[3]); w.z = cvt_pk_bf16(f[4], f[5]); w.w = cvt_pk_bf16(f[6], f[7]);
        *(u32x4*)(d + q * 8) = w; }
}
__device__ __forceinline__ bool conv_tile_a(const P& p, int g, ConvTile& t) {
    if (g < NL * 192) { const int l = g / 192, r = g % 192; t.src = p.in[6] + (size_t)l * 1024 * 2944; t.dst = WSP(O_WIN, bf16_t) + (size_t)l * 3072 * 1024; t.N = 2944; t.kt = r / 12; t.nt = r % 12; return true; }
    g -= NL * 192;
    if (g < NL * 64) { const int l = g >> 6, r = g & 63; t.src = p.in[7] + (size_t)l * 1024 * 1024; t.dst = WSP(O_WOUT, bf16_t) + (size_t)l * 1024 * 1024; t.N = 1024; t.kt = r >> 2; t.nt = r & 3; return true; }
    return false;
}
__device__ __forceinline__ bool conv_tile_b(const P& p, int l, int g, ConvTile& t) {
    if (g < 4096) { const int e = g >> 7, r = g & 127; t.src = p.in[36] + (size_t)(l * NE + e) * 1024 * 2048; t.dst = WSP(O_EW1, bf16_t) + (size_t)(l * NE + e) * 2048 * 1024; t.N = 2048; t.kt = r >> 3; t.nt = r & 7; return true; }
    g -= 4096;
    if (g < 2048) { const int e = g >> 6, r = g & 63; t.src = p.in[38] + (size_t)(l * NE + e) * 1024 * 1024; t.dst = WSP(O_EW2, bf16_t) + (size_t)(l * NE + e) * 1024 * 1024; t.N = 1024; t.kt = r >> 2; t.nt = r & 3; return true; }
    return false;
}
template <bool LIST_B> __device__ __forceinline__ void ph_convert(const P& p, int l, unsigned char* lds, int tid, int cblk, int CG, int g0, int g1) {
    float* tile = (float*)lds;
    ConvTile ta, tb, tc, tn; f32x4 ra[8], rb[8], rc[8];
    int g = g0 + cblk;
#define CONV_NEXT(t, has) do { has = g < g1 && (LIST_B ? conv_tile_b(p, l, g, t) : conv_tile_a(p, g, t)); g += CG; } while (0)
    bool ha, hb, hc, hn;
    CONV_NEXT(ta, ha); CONV_NEXT(tb, hb); CONV_NEXT(tc, hc);
    if (ha) conv_load(ta, tid, ra);
    if (hb) conv_load(tb, tid, rb);
    if (hc) conv_load(tc, tid, rc);
#define CONV_STEP(t, r, h) do { conv_to_lds(tid, r, tile); CONV_NEXT(tn, hn); if (hn) conv_load(tn, tid, r); LDS_BARRIER(); conv_from_lds(t, tid, tile); LDS_BARRIER(); t = tn; h = hn; } while (0)
#pragma unroll 1
    while (ha) {
        CONV_STEP(ta, ra, ha);
        if (!hb) break;
        CONV_STEP(tb, rb, hb);
        if (!hc) break;
        CONV_STEP(tc, rc, hc);
    }
#undef CONV_NEXT
#undef CONV_STEP
}
__device__ __forceinline__ void ph_smallw(const P& p, int tid, int blk, int G) {
    bf16_t* W1C = WSP(O_W1C, bf16_t); bf16_t* W2B = WSP(O_W2B, bf16_t); bf16_t* WGLU = WSP(O_WGLU, bf16_t);
    const int gt = blk * NTHREADS + tid, gs = G * NTHREADS;
    for (int idx = gt; idx < NL * 512 * 384; idx += gs) { const int l = idx / (512 * 384), r = idx % (512 * 384), n = r / 384, k = r % 384; float v = 0.f;
        if (n < 64) v = p.in[19][((size_t)(l * 2 + 0) * 384 + k) * 64 + n];
        else if (n < 128) v = p.in[19][((size_t)(l * 2 + 1) * 384 + k) * 64 + n - 64];
        else if (n < 192) v = p.in[22][((size_t)(l * 2 + 0) * 384 + k) * 64 + n - 128];
        else if (n < 256) v = p.in[22][((size_t)(l * 2 + 1) * 384 + k) * 64 + n - 192];
        else if (n < 384) v = p.in[24][((size_t)l * 384 + k) * 128 + n - 256];
        W1C[idx] = f2bf(v); }
    for (int idx = gt; idx < NL * 2048 * 384; idx += gs) { const int l = idx / (2048 * 384), r = idx % (2048 * 384), n = r / 384, k = r % 384; float v = 0.f;
        if (n < 1920) { const int seg = n / 384, cc = n % 384;
            if (seg == 0) { if (k < 64) v = p.in[20][((size_t)(l * 2 + 0) * 64 + k) * 384 + cc]; }
            else if (seg == 1) { if (k >= 64 && k < 128) v = p.in[20][((size_t)(l * 2 + 1) * 64 + k - 64) * 384 + cc]; }
            else if (seg == 2) { if (k >= 128 && k < 192) v = p.in[23][((size_t)(l * 2 + 0) * 64 + k - 128) * 384 + cc]; }
            else if (seg == 3) { if (k >= 192 && k < 256) v = p.in[23][((size_t)(l * 2 + 1) * 64 + k - 192) * 384 + cc]; }
            else { if (k >= 256) v = p.in[25][((size_t)l * 128 + k - 256) * 384 + cc]; } }
        W2B[idx] = f2bf(v); }
    for (int idx = gt; idx < NL * 256 * 256; idx += gs) { const int l = idx >> 16, n = (idx >> 8) & 255, k = idx & 255; WGLU[idx] = f2bf(p.in[16][((size_t)l * 256 + k) * 256 + n]); }
}
__device__ __forceinline__ void cpowz(double zre, double zim, int n, float& ore, float& oim) {
    const float mag = __expf((float)(zre * (double)n));
    double rev = zim * (double)n * 0.15915494309189535; rev -= rint(rev);
    const float r = (float)rev;
    ore = mag * __builtin_amdgcn_cosf(r); oim = mag * __builtin_amdgcn_sinf(r);
}
__device__ __forceinline__ void ph_s5ops(const P& p, unsigned char* lds, int tid, int blk, int G) {
    double* zr = (double*)lds;
    double* zi = zr + 128;
    float* qre = (float*)(zi + 128);
    float* qim = qre + 128;
    float* bbr = qim + 128;
    float* bbi = bbr + 2048;
    float* ccr = bbi + 2048;
    float* cci = ccr + 2048;
    float* pwr = cci + 2048;
    float* pwi = pwr + 320;
    float* kt = pwi + 320;
    const int nit = (G == 256) ? 16 : (NL * 16 * 64 - blk + G - 1) / G; int lgcur = -1;
    for (int k_ = 0; k_ < nit; ++k_) { const int item = (G == 256) ? blk * 16 + k_ : blk + k_ * G;
        const int l = item >> 10, g = (item >> 6) & 15, j = item & 63;
        if ((item >> 6) != lgcur) { lgcur = item >> 6;
        if (tid < 128) { const int dir = tid >> 6, pp = tid & 63; const int li = ((l * 2 + dir) * 16 + g) * 64 + pp;
            const double lre = (double)p.in[8][li], lim = (double)p.in[9][li]; const double dt = exp((double)p.in[10][(l * 2 + dir) * 16 + g]);
            const double zre = lre * dt, zim = lim * dt; zr[tid] = zre; zi[tid] = zim;
            float er, ei; cpowz(zre, zim, 1, er, ei);
            const double nr = (double)er - 1.0, ni = (double)ei, den = lre * lre + lim * lim;
            qre[tid] = (float)((nr * lre + ni * lim) / den); qim[tid] = (float)((ni * lre - nr * lim) / den);
            if (j == 0) { float m64r, m64i; cpowz(zre, zim, 64, m64r, m64i); float* S5M = WSP(O_S5M, float); S5M[(size_t)li * 2] = m64r; S5M[(size_t)li * 2 + 1] = m64i; } }
        __syncthreads();
        { float brv[4], biv[4], crv[4], civ[4];
#pragma unroll
          for (int k = 0; k < 4; ++k) { const int i = k * NTHREADS + tid; const int dir = i >> 10, pp = (i >> 4) & 63;
            const size_t gi = ((size_t)((l * 2 + dir) * 16 + g) * 64 + pp) * 16 + (i & 15);
            const int ho = (i >> 6) & 15, p2 = i & 63;
            const size_t ci = ((size_t)((l * 2 + dir) * 16 + g) * 16 + ho) * 64 + p2;
            brv[k] = p.in[11][gi]; biv[k] = p.in[12][gi]; crv[k] = p.in[13][ci]; civ[k] = p.in[14][ci]; }
#pragma unroll
          for (int k = 0; k < 4; ++k) { const int i = k * NTHREADS + tid; const int dir = i >> 10, pp = (i >> 4) & 63;
            const float qr = qre[dir * 64 + pp], qi = qim[dir * 64 + pp];
            bbr[i] = qr * brv[k] - qi * biv[k]; bbi[i] = qr * biv[k] + qi * brv[k]; ccr[i] = crv[k]; cci[i] = civ[k]; } }
        }
        if (tid < 320) { const int tb = tid >> 6, pp = tid & 63; float a, b;
            if (tb < 2) cpowz(zr[tb * 64 + pp], zi[tb * 64 + pp], j, a, b);
            else if (tb == 2) cpowz(zr[pp], zi[pp], j + 1, a, b);
            else if (tb == 3) cpowz(zr[64 + pp], zi[64 + pp], 64 - j, a, b);
            else cpowz(zr[pp], zi[pp], 63 - j, a, b);
            pwr[tid] = a; pwi[tid] = b; }
        __syncthreads();
        bf16_t* Wy = WSP(O_WS5Y, bf16_t) + (size_t)(l * 16 + g) * 1024 * 1280;
        bf16_t* Ws = WSP(O_WS5S, bf16_t) + (size_t)(l * 16 + g) * 256 * 1024;
        if (tid < 128) { const int dir = tid >> 6, ln = tid & 63, i16 = ln & 15, kq = ln >> 4;
            f32x4 acc = {0.f, 0.f, 0.f, 0.f};
#pragma unroll 4
            for (int st = 0; st < 16; ++st) { const int pp = 4 * st + kq;
                const float cr = ccr[(dir * 16 + i16) * 64 + pp], ci = cci[(dir * 16 + i16) * 64 + pp], wr_ = pwr[dir * 64 + pp], wi_ = pwi[dir * 64 + pp];
                const float tr = cr * wr_ - ci * wi_, ti = cr * wi_ + ci * wr_;
                acc = __builtin_amdgcn_mfma_f32_16x16x4f32(tr, bbr[(dir * 64 + pp) * 16 + i16], acc, 0, 0, 0);
                acc = __builtin_amdgcn_mfma_f32_16x16x4f32(-ti, bbi[(dir * 64 + pp) * 16 + i16], acc, 0, 0, 0); }
            float* KT = WSP(O_KT, float) + ((size_t)((l * 16 + g) * 2 + dir) * 64 + j) * 256;
#pragma unroll
            for (int r = 0; r < 4; ++r) KT[(4 * kq + r) * 16 + i16] = acc[r]; }
        { const int kp = tid & 255, dir = kp >> 7, comp = (kp >> 6) & 1, pp = kp & 63; const float wr_ = pwr[(2 + dir) * 64 + pp], wi_ = pwi[(2 + dir) * 64 + pp];
#pragma unroll
          for (int q = 0; q < 8; ++q) { const int ho = (tid >> 8) * 8 + q; const float cr = ccr[(dir * 16 + ho) * 64 + pp], ci = cci[(dir * 16 + ho) * 64 + pp];
              const float gr = cr * wr_ - ci * wi_, gi = cr * wi_ + ci * wr_;
              Wy[(size_t)(j * 16 + ho) * 1280 + 1024 + kp] = f2bf(comp == 0 ? gr : -gi); } }
        { const int kp = tid & 255, dir = kp >> 7, comp = (kp >> 6) & 1, pp = kp & 63; const int tb = dir == 0 ? 4 : 1; const float wr_ = pwr[tb * 64 + pp], wi_ = pwi[tb * 64 + pp];
          float f[8];
#pragma unroll
          for (int q = 0; q < 8; ++q) { const int hi = (tid >> 8) * 8 + q; const float br = bbr[(dir * 64 + pp) * 16 + hi], bi = bbi[(dir * 64 + pp) * 16 + hi];
              f[q] = comp == 0 ? (wr_ * br - wi_ * bi) : (wr_ * bi + wi_ * br); }
          u32x4 w; w.x = cvt_pk_bf16(f[0], f[1]); w.y = cvt_pk_bf16(f[2], f[3]); w.z = cvt_pk_bf16(f[4], f[5]); w.w = cvt_pk_bf16(f[6], f[7]);
          *(u32x4*)(Ws + (size_t)kp * 1024 + j * 16 + (tid >> 8) * 8) = w; }
        __syncthreads();
    }
}

__device__ __forceinline__ void ph_s5fill(const P& p, int tid, int blk, int G, int l0, int l1) {
    const float* KT = WSP(O_KT, float);
    for (int item = blk; item < (l1 - l0) * 16 * 64; item += G) {
        const int l = l0 + (item >> 10), g = (item >> 6) & 15, t = item & 63;
        bf16_t* Wy = WSP(O_WS5Y, bf16_t) + (size_t)(l * 16 + g) * 1024 * 1280;
        const float* kf = KT + (size_t)((l * 16 + g) * 2 + 0) * 64 * 256; const float* kr = KT + (size_t)((l * 16 + g) * 2 + 1) * 64 * 256;
        f32x4 va[4][2], vb[4][2];
#pragma unroll
        for (int r = 0; r < 4; ++r) { const int idx = r * NTHREADS + tid, ho = idx >> 7, k8 = idx & 127, sI = k8 >> 1, hi0 = (k8 & 1) * 8;
            const float* qa = kf + (size_t)max(t - sI, 0) * 256 + ho * 16 + hi0; const float* qb = kr + (size_t)max(sI - t, 0) * 256 + ho * 16 + hi0;
            va[r][0] = *(const f32x4*)qa; va[r][1] = *(const f32x4*)(qa + 4); vb[r][0] = *(const f32x4*)qb; vb[r][1] = *(const f32x4*)(qb + 4); }
#pragma unroll
        for (int r = 0; r < 4; ++r) { const int idx = r * NTHREADS + tid, ho = idx >> 7, k8 = idx & 127, sI = k8 >> 1, hi0 = (k8 & 1) * 8;
            const float fa = sI <= t ? 1.0f : 0.f, fb = sI >= t ? 1.0f : 0.f;
            f32x4 v0 = va[r][0] * fa + vb[r][0] * fb, v1 = va[r][1] * fa + vb[r][1] * fb;
            const float dd = sI == t ? p.in[15][(l * 16 + g) * 16 + ho] : 0.f; const int dpos = ho - hi0;
#pragma unroll
            for (int e = 0; e < 4; ++e) { v0[e] += (dpos == e) ? dd : 0.f; v1[e] += (dpos == e + 4) ? dd : 0.f; }
            u32x4 w; w.x = cvt_pk_bf16(v0[0], v0[1]); w.y = cvt_pk_bf16(v0[2], v0[3]); w.z = cvt_pk_bf16(v1[0], v1[1]); w.w = cvt_pk_bf16(v1[2], v1[3]);
            *(u32x4*)(Wy + (size_t)(t * 16 + ho) * 1280 + sI * 16 + hi0) = w; }
    }
}

__device__ __forceinline__ void ph_combine_norm(const P& p, int lsrc, int ldst, int lane, int wave, int blk, int G, bf16_t* xrdst) {
    const float* MOD = WSP(O_MOD, float);
    const bf16_t* Y = WSP(O_XS, bf16_t); const int* SLOT = WSP(O_SLOT, int); const float* GV = WSP(O_GV, float);
    bf16_t* H1 = WSP(O_H1, bf16_t);
    f32x4 gw[4], gfv[4], shv[4], scv[4]; int bcur = -1;
    if (ldst < NL) {
#pragma unroll
        for (int i = 0; i < 4; ++i) gw[i] = *(const f32x4*)(p.in[4] + ldst * 1024 + i * 256 + lane * 4); }
    for (int row = blk * 8 + wave; row < T; row += G * 8) {
        const int b = row >> 12;
        if (b != bcur) { bcur = b;
#pragma unroll
            for (int i = 0; i < 4; ++i) { const int c = i * 256 + lane * 4;
                if (lsrc >= 0) gfv[i] = *(const f32x4*)(MOD + (size_t)(lsrc * 4 + b) * 6144 + 5120 + c);
                if (ldst < NL) { shv[i] = *(const f32x4*)(MOD + (size_t)(ldst * 4 + b) * 6144 + c); scv[i] = *(const f32x4*)(MOD + (size_t)(ldst * 4 + b) * 6144 + 1024 + c) + 1.0f; } } }
        f32x4 x[4];
        if (lsrc < 0) {
#pragma unroll
            for (int i = 0; i < 4; ++i) x[i] = *(const f32x4*)(p.in[0] + (size_t)row * 1024 + i * 256 + lane * 4);
        } else { u32x2 xb[4];
#pragma unroll
            for (int i = 0; i < 4; ++i) xb[i] = *(const u32x2*)(WSP(O_XR, bf16_t) + (size_t)row * 1024 + i * 256 + lane * 4);
#pragma unroll
            for (int i = 0; i < 4; ++i) x[i] = bf4_to_f32(xb[i]); }
        if (lsrc >= 0) {
            f32x4 acc[4] = {{0.f, 0.f, 0.f, 0.f}, {0.f, 0.f, 0.f, 0.f}, {0.f, 0.f, 0.f, 0.f}, {0.f, 0.f, 0.f, 0.f}};
#pragma unroll
            for (int k = 0; k < 4; ++k) { const int slot = SLOT[row * 4 + k]; const float gk = GV[row * 4 + k]; const bf16_t* yr = Y + (size_t)slot * 1024;
#pragma unroll
                for (int i = 0; i < 4; ++i) { const u32x2 v = *(const u32x2*)(yr + i * 256 + lane * 4);
                    acc[i][0] += gk * __uint_as_float(v.x << 16); acc[i][1] += gk * __uint_as_float(v.x & 0xFFFF0000u); acc[i][2] += gk * __uint_as_float(v.y << 16); acc[i][3] += gk * __uint_as_float(v.y & 0xFFFF0000u); } }
#pragma unroll
            for (int i = 0; i < 4; ++i) x[i] = x[i] + gfv[i] * acc[i];
        }
        if (ldst < NL) {
#pragma unroll
            for (int i = 0; i < 4; ++i) { const u32x2 w = f32_to_bf4(x[i]); *(u32x2*)(xrdst + (size_t)row * 1024 + i * 256 + lane * 4) = w; x[i] = bf4_to_f32(w); }
        } else {
#pragma unroll
            for (int i = 0; i < 4; ++i) *(f32x4*)(p.out + (size_t)row * 1024 + i * 256 + lane * 4) = x[i];
        }
        if (ldst < NL) {
            float ss = 0.f;
#pragma unroll
            for (int i = 0; i < 4; ++i) ss += x[i][0] * x[i][0] + x[i][1] * x[i][1] + x[i][2] * x[i][2] + x[i][3] * x[i][3];
            ss = wave_sum_all(ss); const float rstd = rsqrtf(ss * (1.0f / 1024.0f) + 1e-6f);
#pragma unroll
            for (int i = 0; i < 4; ++i) { const int c = i * 256 + lane * 4;
                const f32x4 h = x[i] * rstd * gw[i] * scv[i] + shv[i];
                u32x2 w; w.x = cvt_pk_bf16(h[0], h[1]); w.y = cvt_pk_bf16(h[2], h[3]); *(u32x2*)(H1 + (size_t)row * 1024 + c) = w; }
        }
    }
}

__device__ __forceinline__ void ph_prepass(const P& p, int l, int lane, int wave, int blk, int G) {
    const bf16_t* PROJ = WSP(O_PROJ, bf16_t);
    bf16_t* ZS = WSP(O_ZS, bf16_t); bf16_t* QN = WSP(O_QN, bf16_t); bf16_t* KN = WSP(O_KN, bf16_t); bf16_t* AS5 = WSP(O_AS5, bf16_t);
    bf16_t* R = WSP(O_R, bf16_t); bf16_t* K = WSP(O_K, bf16_t); bf16_t* V = WSP(O_V, bf16_t); bf16_t* A = WSP(O_A, bf16_t); float* RKB = WSP(O_RKB, float);
    const float* mu = p.in[17] + l * 1536; const float* k_k = p.in[26] + l * 384; const float* r_k = p.in[28] + l * 384;
    const int r4 = lane >> 4, j4 = (lane & 15) * 4;
    const f32x4 qg = *(const f32x4*)(p.in[31] + l * 64 + j4), kg = *(const f32x4*)(p.in[32] + l * 64 + j4);
    const int c0 = r4 * 64 + j4, c1 = min(4 + r4, 5) * 64 + j4;
    f32x4 muv[2][4], kkv[2], rkv2[2];
#pragma unroll
    for (int pass = 0; pass < 2; ++pass) { const int c = pass ? c1 : c0;
#pragma unroll
        for (int part = 0; part < 4; ++part) muv[pass][part] = *(const f32x4*)(mu + part * 384 + c);
        kkv[pass] = *(const f32x4*)(k_k + c); rkv2[pass] = *(const f32x4*)(r_k + c); }
#pragma unroll 1
    for (int run = blk * 8 + wave; run < T / 8; run += G * 8) {
        const int base = run * 8, t0 = base & 4095;
        u32x2 rows[4][2][4], aux[2][5];
#define PP_ROW(slot, tk, valid) do { _Pragma("unroll") for (int part_ = 0; part_ < 4; ++part_) { const bf16_t* s0_ = PROJ + (size_t)(tk) * NPROJ + 256 + part_ * 384; \
            rows[slot][0][part_] = (valid) ? *(const u32x2*)(s0_ + c0) : (u32x2){0u, 0u}; rows[slot][1][part_] = (valid) ? *(const u32x2*)(s0_ + c1) : (u32x2){0u, 0u}; } } while (0)
#define PP_AUX(slot, tk) do { const bf16_t* s0_ = PROJ + (size_t)(tk) * NPROJ; aux[slot][0] = *(const u32x2*)(s0_ + lane * 4); aux[slot][1] = *(const u32x2*)(s0_ + 1792 + c0); aux[slot][2] = *(const u32x2*)(s0_ + 2176 + c0); \
            aux[slot][3] = *(const u32x2*)(s0_ + 1792 + c1); aux[slot][4] = *(const u32x2*)(s0_ + 2176 + c1); } while (0)
        PP_ROW(0, base - 1, t0 > 0); PP_ROW(1, base, true); PP_ROW(2, base + 1, true); PP_AUX(0, base);
#pragma unroll
        for (int it = 0; it < 8; ++it) {
            const int tok = base + it; const int sp = it & 3, sc = (it + 1) & 3, sn = (it + 2) & 3, snn = (it + 3) & 3;
            if (it < 7) { PP_ROW(snn, tok + 2, t0 + it + 2 <= 4095); PP_AUX((it + 1) & 1, tok + 1); }
            { const int g = lane >> 2, hi0 = (lane & 3) * 4; *(u32x2*)(AS5 + ((size_t)g * 256 + (tok >> 6)) * 1280 + (tok & 63) * 16 + hi0) = aux[it & 1][0]; }
#pragma unroll
            for (int pass = 0; pass < 2; ++pass) {
                const int hd_ = pass * 4 + r4; const bool act = hd_ < 6; const int hd = act ? hd_ : 5; const int c = hd * 64 + j4;
                f32x4 xs[4];
#pragma unroll
                for (int part = 0; part < 4; ++part) { const f32x4 cur = bf4_to_f32(rows[sc][pass][part]), pv = bf4_to_f32(rows[sp][pass][part]), nx = bf4_to_f32(rows[sn][pass][part]);
                    xs[part] = cur + ((pv + nx) * 0.5f - cur) * muv[pass][part]; }
                const f32x4 kr = xs[1] * kkv[pass];
                const float n2 = row16_sum(hsum4(kr * kr)); const float rk = row16_sum(hsum4(xs[0] * xs[1] * rkv2[pass]));
                const f32x4 qv = bf4_to_f32(aux[it & 1][1 + 2 * pass]), kv = bf4_to_f32(aux[it & 1][2 + 2 * pass]);
                const float mq = row16_sum(hsum4(qv * qv)) * (1.0f / 64.0f), mk = row16_sum(hsum4(kv * kv)) * (1.0f / 64.0f);
                if (act) { const size_t o = (size_t)tok * 384 + c;
                    *(u32x2*)(R + o) = f32_to_bf4(xs[0]); *(u32x2*)(K + o) = f32_to_bf4(xs[1]); *(u32x2*)(V + o) = f32_to_bf4(xs[2]); *(u32x2*)(ZS + o) = f32_to_bf4(xs[3]);
                    *(u32x2*)(A + o) = f32_to_bf4(kr * (-1.0f / fmaxf(sqrtf(n2), 1e-12f)));
                    if ((lane & 15) == 0) RKB[tok * 8 + hd] = rk;
                    *(u32x2*)(QN + o) = f32_to_bf4(qv * (rsqrtf(mq + 1e-6f) * 0.125f) * qg); *(u32x2*)(KN + o) = f32_to_bf4(kv * rsqrtf(mk + 1e-6f) * kg); }
            }
        }
#undef PP_ROW
#undef PP_AUX
    }
}

__device__ __forceinline__ void ph_na(const P& p, int l, unsigned char* lds, int tid, int lane, int wave, int blk, int G) {
    float* rpb = (float*)lds;
    unsigned char* vb = lds + 11264 + wave * 4608;
    { float rv[6];
#pragma unroll
      for (int k = 0; k < 6; ++k) { const int i = k * NTHREADS + tid; rv[k] = p.in[33][l * 2790 + (i < 2790 ? i : 0)]; }
#pragma unroll
      for (int k = 0; k < 6; ++k) { const int i = k * NTHREADS + tid; if (i < 2790) rpb[i] = rv[k]; } }
    __syncthreads();
    const bf16_t* QN = WSP(O_QN, bf16_t); const bf16_t* KN = WSP(O_KN, bf16_t); const bf16_t* PROJ = WSP(O_PROJ, bf16_t); bf16_t* MIX = WSP(O_MIX, bf16_t);
    const int q16 = lane & 15, g = lane >> 4;
    const unsigned vaddr = (unsigned)(size_t)(LAS unsigned char*)vb + (unsigned)((4 * g + (q16 >> 2)) * 144 + (q16 & 3) * 8);
    for (int unit = blk * 8 + wave; unit < 6144; unit += G * 8) {
        const int nb = unit & 3, r = (unit >> 2) & 63, bh = unit >> 8, h = bh % 6, b = bh / 6;
        const int rs = min(max(r - 4, 0), 56), kb0 = min(max(16 * nb - 8, 0), 32);
        const int tq = b * 4096 + r * 64 + 16 * nb + q16;
        const bf16x8 qf0 = *(const bf16x8*)(QN + (size_t)tq * 384 + h * 64 + 8 * g), qf1 = *(const bf16x8*)(QN + (size_t)tq * 384 + h * 64 + 32 + 8 * g);
        f32x4 s[16];
        bf16x8 kf[2][4][2];
#define NA_KLOAD(set, gi) do { _Pragma("unroll") for (int jj = 0; jj < 4; ++jj) { const int j_ = (gi) * 4 + jj; const int tk = b * 4096 + (rs + (j_ >> 1)) * 64 + kb0 + (j_ & 1) * 16 + q16; \
            const bf16_t* kp = KN + (size_t)tk * 384 + h * 64 + 8 * g; kf[set][jj][0] = *(const bf16x8*)kp; kf[set][jj][1] = *(const bf16x8*)(kp + 32); } } while (0)
        NA_KLOAD(0, 0);
        u32x4 vr[2][4];
#define NA_VLOAD(set, s2_) do { const int tv = b * 4096 + (rs + (s2_)) * 64 + kb0 + (lane >> 1); const bf16_t* vp = PROJ + (size_t)tv * NPROJ + 2560 + h * 64 + (lane & 1) * 32; \
            vr[set][0] = *(const u32x4*)vp; vr[set][1] = *(const u32x4*)(vp + 8); vr[set][2] = *(const u32x4*)(vp + 16); vr[set][3] = *(const u32x4*)(vp + 24); } while (0)
#pragma unroll
        for (int gi = 0; gi < 4; ++gi) {
            if (gi < 3) NA_KLOAD((gi + 1) & 1, gi + 1); else NA_VLOAD(0, 0);
#pragma unroll
            for (int jj = 0; jj < 4; ++jj) { f32x4 z = {0.f, 0.f, 0.f, 0.f};
                z = __builtin_amdgcn_mfma_f32_16x16x32_bf16(kf[gi & 1][jj][0], qf0, z, 0, 0, 0); z = __builtin_amdgcn_mfma_f32_16x16x32_bf16(kf[gi & 1][jj][1], qf1, z, 0, 0, 0); s[gi * 4 + jj] = z; }
            __builtin_amdgcn_sched_barrier(0); }
        const int qc = 16 * nb + q16, cst = min(max(qc - 8, 0), 48);
        float mx = -3.0e38f;
#pragma unroll
        for (int j = 0; j < 16; ++j)
#pragma unroll
            for (int i = 0; i < 4; ++i) { const int kc = kb0 + (j & 1) * 16 + 4 * g + i; const bool valid = (kc >= cst) && (kc < cst + 16);
                const int dy = rs + (j >> 1) - r + 7, dx = min(max(kc - qc + 15, 0), 30);
                const float v = valid ? s[j][i] + rpb[(h * 15 + dy) * 31 + dx] : -3.0e38f; s[j][i] = v; mx = fmaxf(mx, v); }
        { float a = mx, b = mx; swap16(a, b); mx = fmaxf(a, b); } { float a = mx, b = mx; swap32(a, b); mx = fmaxf(a, b); }
        float sum = 0.f;
#pragma unroll
        for (int j = 0; j < 16; ++j)
#pragma unroll
            for (int i = 0; i < 4; ++i) { const float e = __expf(s[j][i] - mx); s[j][i] = e; sum += e; }
        { float a = sum, b = sum; swap16(a, b); sum = a + b; } { float a = sum, b = sum; swap32(a, b); sum = a + b; }
        const float inv = 1.0f / sum;
        f32x4 o[4] = {{0.f, 0.f, 0.f, 0.f}, {0.f, 0.f, 0.f, 0.f}, {0.f, 0.f, 0.f, 0.f}, {0.f, 0.f, 0.f, 0.f}};
#pragma unroll
        for (int s2 = 0; s2 < 8; ++s2) {
            if (s2 < 7) NA_VLOAD((s2 + 1) & 1, s2 + 1);
            unsigned char* vw = vb + (lane >> 1) * 144 + (lane & 1) * 64;
            *(u32x4*)vw = vr[s2 & 1][0]; *(u32x4*)(vw + 16) = vr[s2 & 1][1]; *(u32x4*)(vw + 32) = vr[s2 & 1][2]; *(u32x4*)(vw + 48) = vr[s2 & 1][3];
            s16x4 lo[4], hi[4];
            asm volatile("s_waitcnt lgkmcnt(0)\n\t"
                         "ds_read_b64_tr_b16 %0, %8\n\tds_read_b64_tr_b16 %1, %8 offset:32\n\tds_read_b64_tr_b16 %2, %8 offset:64\n\tds_read_b64_tr_b16 %3, %8 offset:96\n\t"
                         "ds_read_b64_tr_b16 %4, %8 offset:2304\n\tds_read_b64_tr_b16 %5, %8 offset:2336\n\tds_read_b64_tr_b16 %6, %8 offset:2368\n\tds_read_b64_tr_b16 %7, %8 offset:2400\n\t"
                         "s_waitcnt lgkmcnt(0)"
                         : "=&v"(lo[0]), "=&v"(lo[1]), "=&v"(lo[2]), "=&v"(lo[3]), "=&v"(hi[0]), "=&v"(hi[1]), "=&v"(hi[2]), "=&v"(hi[3]) : "v"(vaddr) : "memory");
            bf16x8 pa;
            { const f32x4 a = s[2 * s2] * inv, c = s[2 * s2 + 1] * inv; u32x4 w; w.x = cvt_pk_bf16(a[0], a[1]); w.y = cvt_pk_bf16(a[2], a[3]); w.z = cvt_pk_bf16(c[0], c[1]); w.w = cvt_pk_bf16(c[2], c[3]); pa = __builtin_bit_cast(bf16x8, w); }
#pragma unroll
            for (int nt = 0; nt < 4; ++nt) { bf16x8 bfr; bfr[0] = lo[nt][0]; bfr[1] = lo[nt][1]; bfr[2] = lo[nt][2]; bfr[3] = lo[nt][3]; bfr[4] = hi[nt][0]; bfr[5] = hi[nt][1]; bfr[6] = hi[nt][2]; bfr[7] = hi[nt][3];
                o[nt] = __builtin_amdgcn_mfma_f32_16x16x32_bf16(pa, bfr, o[nt], 0, 0, 0); }
        }
#undef NA_KLOAD
#undef NA_VLOAD
#pragma unroll
        for (int nt = 0; nt < 4; ++nt)
#pragma unroll
            for (int i = 0; i < 4; ++i) MIX[(size_t)(b * 4096 + r * 64 + 16 * nb + 4 * g + i) * 1024 + 640 + h * 64 + 16 * nt + q16] = f2bf(o[nt][i]);
    }
    __syncthreads();
}

__device__ __forceinline__ void ph_s5carry(const P& p, int l, int tid, int blk) {
    if (blk >= 16) return;
    const int g = blk, b = tid >> 7, dir = (tid >> 6) & 1, pp = tid & 63;
    const int li = ((l * 2 + dir) * 16 + g) * 64 + pp;
    const float mr = WSP(O_S5M, float)[(size_t)li * 2], mi = WSP(O_S5M, float)[(size_t)li * 2 + 1];
    const float* SL = WSP(O_SLOC, float) + (size_t)g * 256 * 256; bf16_t* AS = WSP(O_AS5, bf16_t) + (size_t)g * 256 * 1280;
    float hr = 0.f, hi = 0.f;
#pragma unroll 1
    for (int c0 = 0; c0 < 64; c0 += 16) {
        float sr[16], si[16];
#pragma unroll
        for (int u = 0; u < 16; ++u) { const int cc = c0 + u, c = dir == 0 ? cc : 63 - cc, chunk = b * 64 + c;
            sr[u] = SL[(size_t)chunk * 256 + dir * 128 + pp]; si[u] = SL[(size_t)chunk * 256 + dir * 128 + 64 + pp]; }
#pragma unroll
        for (int u = 0; u < 16; ++u) { const int cc = c0 + u, c = dir == 0 ? cc : 63 - cc, chunk = b * 64 + c;
            AS[(size_t)chunk * 1280 + 1024 + dir * 128 + pp] = f2bf(hr); AS[(size_t)chunk * 1280 + 1024 + dir * 128 + 64 + pp] = f2bf(hi);
            const float nr = mr * hr - mi * hi + sr[u], ni = mr * hi + mi * hr + si[u]; hr = nr; hi = ni; }
    }
}

constexpr int XB = 8192;
#define XOFF(row, col) ((row) * 128 + (((((col) >> 3) ^ (((row) >> 1) & 7))) << 4) + ((col) & 7) * 2)
__device__ __forceinline__ void nt2(const LAS unsigned char* X, const LAS unsigned char* Y, int tm, int tn0, int m16, int g, f32x4 (&acc)[2]) {
    const int ra_ = 16 * tm + m16;
    const bf16x8 a0 = *(const LAS bf16x8*)(X + XOFF(ra_, 8 * g)), a1 = *(const LAS bf16x8*)(X + XOFF(ra_, 32 + 8 * g));
#pragma unroll
    for (int q = 0; q < 2; ++q) { const int rb_ = 16 * (tn0 + q) + m16;
        const bf16x8 b0 = *(const LAS bf16x8*)(Y + XOFF(rb_, 8 * g)), b1 = *(const LAS bf16x8*)(Y + XOFF(rb_, 32 + 8 * g));
        acc[q] = __builtin_amdgcn_mfma_f32_16x16x32_bf16(a0, b0, acc[q], 0, 0, 0); acc[q] = __builtin_amdgcn_mfma_f32_16x16x32_bf16(a1, b1, acc[q], 0, 0, 0); }
}
struct XF { bf16x8 a0, a1, b00, b01, b10, b11; };
__device__ __forceinline__ void xload(XF& f, const LAS unsigned char* X, const LAS unsigned char* Y, int tm, int tn0, int m16, int g) {
    const int ra_ = 16 * tm + m16, rb0_ = 16 * tn0 + m16, rb1_ = rb0_ + 16;
    f.a0 = *(const LAS bf16x8*)(X + XOFF(ra_, 8 * g)); f.a1 = *(const LAS bf16x8*)(X + XOFF(ra_, 32 + 8 * g));
    f.b00 = *(const LAS bf16x8*)(Y + XOFF(rb0_, 8 * g)); f.b01 = *(const LAS bf16x8*)(Y + XOFF(rb0_, 32 + 8 * g));
    f.b10 = *(const LAS bf16x8*)(Y + XOFF(rb1_, 8 * g)); f.b11 = *(const LAS bf16x8*)(Y + XOFF(rb1_, 32 + 8 * g)); }
__device__ __forceinline__ void xmma(const XF& f, f32x4 (&acc)[2]) {
    acc[0] = __builtin_amdgcn_mfma_f32_16x16x32_bf16(f.a0, f.b00, (f32x4){0.f, 0.f, 0.f, 0.f}, 0, 0, 0); acc[1] = __builtin_amdgcn_mfma_f32_16x16x32_bf16(f.a0, f.b10, (f32x4){0.f, 0.f, 0.f, 0.f}, 0, 0, 0);
    acc[0] = __builtin_amdgcn_mfma_f32_16x16x32_bf16(f.a1, f.b01, acc[0], 0, 0, 0); acc[1] = __builtin_amdgcn_mfma_f32_16x16x32_bf16(f.a1, f.b11, acc[1], 0, 0, 0); }
#define X1_L(f, Xb, Yb) xload(f, BUF(Yb), BUF(Xb), tm, tn0, m16, g)
#define X1_M(f, acc) xmma(f, acc)
#define X1_PROD(Xb, Yb) do { acc[0] = (f32x4){0.f, 0.f, 0.f, 0.f}; acc[1] = (f32x4){0.f, 0.f, 0.f, 0.f}; nt2(BUF(Yb), BUF(Xb), tm, tn0, m16, g, acc); } while (0)
#define X1_Q(q, mrow) _Pragma("unroll") for (int q = 0; q < 2; ++q) { const int mrow = 16 * (tn0 + q) + m16; (void)mrow;
#define X1_END }
#define X1_ST4(buf, mrow, v4) (*(LAS u32x2*)(BUF(buf) + XOFF(mrow, nc0)) = f32_to_bf4(v4))
#define X1_LD4(buf, mrow) bf4_to_f32(*(const LAS u32x2*)(BUF(buf) + XOFF(mrow, nc0)))
__device__ __forceinline__ void ph_x1(const P& p, unsigned char* lds_, int tid, int lane, int wave, int ublk, int ustride, int u0, int u1) {
    LAS unsigned char* LB = (LAS unsigned char*)lds_;
#define BUF(i) (LB + (i) * XB)
    LAS float* Gm = (LAS float*)BUF(8);
    LAS float* gC = (LAS float*)(LB + LDS_X);
    const int m16 = lane & 15, g = lane >> 4, tm = wave >> 1, tn0 = (wave & 1) * 2, nc0 = 16 * tm + 4 * g;
    const int half = tid >> 8, s0 = ((tid & 255) >> 4) * 4, j4 = (tid & 15) * 4;
    u32x2 inr[3][4];
#define X1_LOAD(unit) do { const int ch_ = (unit) >> 6, c_ = (unit) & 63, b_ = ch_ / 12, h_ = (ch_ % 12) >> 1, dir_ = ch_ & 1; \
        const bf16_t* f0_ = half ? WSP(O_KD, bf16_t) + (size_t)dir_ * T * 384 : WSP(O_A, bf16_t); const bf16_t* f2_ = half ? WSP(O_V, bf16_t) : WSP(O_BV, bf16_t) + (size_t)dir_ * T * 384; const bf16_t* f1_ = half ? WSP(O_R, bf16_t) : WSP(O_DEC, bf16_t) + (size_t)dir_ * T * 384; \
        _Pragma("unroll") for (int r_ = 0; r_ < 4; ++r_) { const int t_ = dir_ ? (4095 - (64 * c_ + s0 + r_)) : (64 * c_ + s0 + r_); const size_t o_ = (size_t)(b_ * 4096 + t_) * 384 + h_ * 64 + j4; \
            inr[0][r_] = *(const u32x2*)(f0_ + o_); inr[2][r_] = *(const u32x2*)(f2_ + o_); inr[1][r_] = *(const u32x2*)(f1_ + o_); } } while (0)
    int unit = u0 + ublk;
    if (unit < u1) X1_LOAD(unit);
#pragma unroll 1
    for (; unit < u1; unit += ustride) {
        if (half == 0) {
#pragma unroll
            for (int r = 0; r < 4; ++r) *(LAS f32x4*)(Gm + (s0 + r) * 68 + j4) = h4_to_f32(inr[1][r]); }
        LDS_BARRIER();
        { const int jch = tid & 63, seg = tid >> 6; LAS float* segT = (LAS float*)BUF(11);
          float gv[8];
#pragma unroll
          for (int u = 0; u < 8; ++u) gv[u] = Gm[(seg * 8 + u) * 68 + jch];
#pragma unroll
          for (int u = 1; u < 8; ++u) gv[u] = gv[u] * gv[u - 1];
          segT[seg * 64 + jch] = gv[7];
          LDS_BARRIER();
          float pre = 1.0f;
#pragma unroll
          for (int u = 0; u < 7; ++u) { const float tv = segT[u * 64 + jch]; if (u < seg) pre *= tv; }
#pragma unroll
          for (int u = 0; u < 8; ++u) Gm[(seg * 8 + u) * 68 + jch] = gv[u] * pre;
          if (seg == 7) gC[jch] = gv[7] * pre; }
        LDS_BARRIER();
        { f32x4 gg[4], gp;
#pragma unroll
          for (int r = 0; r < 4; ++r) gg[r] = *(const LAS f32x4*)(Gm + (s0 + r) * 68 + j4);
          gp = s0 > 0 ? *(const LAS f32x4*)(Gm + (s0 - 1) * 68 + j4) : (f32x4){1.f, 1.f, 1.f, 1.f};
          f32x4 m0[4], m2[4], m1[4];
#pragma unroll
          for (int r = 0; r < 4; ++r) { f32x4 gi; gi[0] = frcp(gg[r][0]); gi[1] = frcp(gg[r][1]); gi[2] = frcp(gg[r][2]); gi[3] = frcp(gg[r][3]);
              const f32x4 i0 = bf4_to_f32(inr[0][r]), i2 = bf4_to_f32(inr[2][r]);
              if (half == 0) { m0[r] = i0 * (r == 0 ? gp : gg[r - 1]); m2[r] = i2 * gi; m1[r] = m0[r]; }
              else { m0[r] = i0 * gi; m1[r] = bf4_to_f32(inr[1][r]) * gg[r]; m2[r] = i2; } }
          const int bA = half ? 2 : 0, bAT = half ? 6 : 4;
#pragma unroll
          for (int r = 0; r < 4; ++r) *(LAS u32x2*)(BUF(bA) + XOFF(s0 + r, j4)) = f32_to_bf4(m0[r]);
#pragma unroll
          for (int q = 0; q < 4; ++q) *(LAS u32x2*)(BUF(bAT) + XOFF(j4 + q, s0)) = f32_to_bf4((f32x4){m0[0][q], m0[1][q], m0[2][q], m0[3][q]});
          if (half == 0) {
#pragma unroll
              for (int r = 0; r < 4; ++r) *(LAS u32x2*)(BUF(1) + XOFF(s0 + r, j4)) = f32_to_bf4(m2[r]);
#pragma unroll
              for (int q = 0; q < 4; ++q) *(LAS u32x2*)(BUF(5) + XOFF(j4 + q, s0)) = f32_to_bf4((f32x4){m2[0][q], m2[1][q], m2[2][q], m2[3][q]});
          } else {
#pragma unroll
              for (int r = 0; r < 4; ++r) *(LAS u32x2*)(BUF(3) + XOFF(s0 + r, j4)) = f32_to_bf4(m1[r]);
#pragma unroll
              for (int q = 0; q < 4; ++q) *(LAS u32x2*)(BUF(7) + XOFF(j4 + q, s0)) = f32_to_bf4((f32x4){m2[0][q], m2[1][q], m2[2][q], m2[3][q]});
          } }
        LDS_BARRIER();
        { const int un = unit + ustride; if (un < u1) X1_LOAD(un); }
        XF fa, fb, fc, fd; f32x4 acc[2], acb[2], acd[2], ace[2];
        X1_L(fa, 0, 1); X1_L(fb, 1, 0); X1_L(fc, 2, 0);
        X1_M(fa, acc); X1_M(fb, acb); X1_M(fc, acd);
        X1_L(fa, 3, 1); X1_L(fb, 3, 2);
        X1_Q(q, mrow) f32x4 v, w, vt, vk;
#pragma unroll
            for (int i = 0; i < 4; ++i) { v[i] = (nc0 + i) < mrow ? acc[q][i] : 0.f; w[i] = v[i] + ((nc0 + i) == mrow ? 1.0f : 0.f); vt[i] = mrow < (nc0 + i) ? acb[q][i] : 0.f; vk[i] = mrow < (nc0 + i) ? acd[q][i] : 0.f; }
            X1_ST4(8, mrow, v); X1_ST4(13, mrow, w); X1_ST4(9, mrow, vt); X1_ST4(10, mrow, vk); X1_END
        X1_M(fa, acc); X1_M(fb, acb);
        X1_Q(q, mrow) f32x4 v, w;
#pragma unroll
            for (int i = 0; i < 4; ++i) { v[i] = (nc0 + i) <= mrow ? acc[q][i] : 0.f; w[i] = (nc0 + i) <= mrow ? acb[q][i] : 0.f; }
            X1_ST4(11, mrow, v); X1_ST4(12, mrow, w); X1_END
        LDS_BARRIER();
#define X1_DSTAGE(pi, pti, po, pto, wantP, li, lpt, lo, hasL) do { \
            if (wantP) X1_L(fa, pi, pti); X1_L(fb, pti, pi); if (hasL) X1_L(fc, li, lpt); \
            f32x4 lold[2]; if (hasL) { X1_Q(q, mrow) lold[q] = X1_LD4(li, mrow); X1_END } \
            if (wantP) X1_M(fa, acc); X1_M(fb, acb); if (hasL) X1_M(fc, acd); \
            X1_Q(q, mrow) if (wantP) X1_ST4(po, mrow, acc[q]); X1_ST4(pto, mrow, acb[q]); if (hasL) X1_ST4(lo, mrow, acd[q] + lold[q]); X1_END } while (0)
        X1_DSTAGE(8, 9, 0, 1, true, 0, 0, 0, false); LDS_BARRIER();
        X1_DSTAGE(0, 1, 8, 9, true, 13, 1, 2, true); LDS_BARRIER();
        X1_DSTAGE(8, 9, 0, 1, true, 2, 9, 13, true); LDS_BARRIER();
        X1_DSTAGE(0, 1, 8, 9, true, 13, 1, 2, true); LDS_BARRIER();
        X1_DSTAGE(8, 9, 0, 1, false, 2, 9, 13, true); LDS_BARRIER();
        { X1_L(fc, 13, 1); f32x4 lold[2]; X1_Q(q, mrow) lold[q] = X1_LD4(13, mrow); X1_END X1_M(fc, acd); X1_Q(q, mrow) X1_ST4(2, mrow, acd[q] + lold[q]); X1_END }
        LDS_BARRIER();
        X1_L(fa, 4, 2); X1_L(fb, 10, 2); X1_M(fa, acc); X1_M(fb, acb);
        X1_Q(q, mrow) X1_ST4(8, mrow, acc[q]); X1_ST4(9, mrow, acb[q]); X1_END
        LDS_BARRIER();
        const int udir = (unit >> 6) & 1;
        { bf16_t* PHI = WSP(O_PHI, bf16_t) + (size_t)unit * 4096; bf16_t* GMo = WSP(O_GM, bf16_t) + (size_t)unit * 4096;
          X1_L(fa, 5, 8); X1_L(fb, 5, 9); X1_L(fc, 11, 8); X1_L(fd, 11, 9);
          f32x4 ek[2], gr[2], hk[2];
          X1_Q(q, mrow) ek[q] = X1_LD4(6, mrow); gr[q] = X1_LD4(3, mrow); hk[q] = X1_LD4(12, mrow); X1_END
          X1_M(fa, acc); X1_M(fb, acb); X1_M(fc, acd); X1_M(fd, ace);
          X1_Q(q, mrow) f32x4 v; const float gc = gC[mrow];
#pragma unroll
              for (int i = 0; i < 4; ++i) v[i] = gc * (acc[q][i] + ((nc0 + i) == mrow ? 1.0f : 0.f));
              *(u32x2*)(PHI + mrow * 64 + nc0) = f32_to_bf4(v);
              X1_ST4(0, mrow, acb[q] + ek[q]);
              *(u32x2*)(GMo + (udir ? 63 - mrow : mrow) * 64 + nc0) = f32_to_bf4(acd[q] + gr[q]);
              X1_ST4(1, mrow, ace[q] + hk[q]); X1_END }
        LDS_BARRIER();
        { float* PSIT = WSP(O_PSIT, float) + (size_t)unit * 4096; bf16_t* YLT = WSP(O_YLT, bf16_t) + (size_t)unit * 4096;
          const f32x4 gc4 = *(const LAS f32x4*)(gC + nc0);
          X1_L(fa, 7, 0); X1_L(fb, 1, 7); X1_M(fa, acc); X1_M(fb, acb);
          X1_Q(q, mrow) *(f32x4*)(PSIT + mrow * 64 + nc0) = acc[q] * gc4;
              *(u32x2*)(YLT + (udir ? 63 - mrow : mrow) * 64 + nc0) = f32_to_bf4(acb[q]); X1_END }
    }
#undef BUF
#undef X1_LOAD
#undef X1_DSTAGE
}
__device__ __forceinline__ void ph_x2a(const P& p, LAS unsigned char* lds, int tid, int lane, int wave, int blk) {
    if (blk >= 48) return;
    constexpr int SLOT = 24576, NSLOT = 5;
    const int ch = blk;
    const char* PHI = (const char*)(WSP(O_PHI, bf16_t) + (size_t)ch * 64 * 4096); const char* PSIT = (const char*)(WSP(O_PSIT, float) + (size_t)ch * 64 * 4096);
    if (wave >= 4) {
        const int lw = wave - 4;
        unsigned so[6];
#pragma unroll
        for (int q = 0; q < 6; ++q) { const int piece = lw + 4 * q;
            if (piece < 8) { const int row = piece * 8 + (lane >> 3), cp = lane & 7; so[q] = (unsigned)(row * 128 + ((cp ^ (row & 7)) << 4)); }
            else { const int row = (piece - 8) * 4 + (lane >> 4), cp = lane & 15; so[q] = (unsigned)(row * 256 + ((cp ^ (row & 15)) << 4)); } }
#define X2A_ISSUE(c) do { const int cc_ = (c) < 64 ? (c) : 63; const int sl_ = (c) % NSLOT; \
        _Pragma("unroll") for (int q = 0; q < 6; ++q) { const int piece = lw + 4 * q; \
            const char* src_ = piece < 8 ? PHI + (size_t)cc_ * 8192 + so[q] : PSIT + (size_t)cc_ * 16384 + so[q]; \
            __builtin_amdgcn_global_load_lds((const unsigned*)src_, (LAS unsigned*)(lds + sl_ * SLOT + piece * 1024), 16, 0, 0); } } while (0)
        X2A_ISSUE(0); X2A_ISSUE(1); X2A_ISSUE(2); X2A_ISSUE(3);
        asm volatile("s_waitcnt vmcnt(18)" ::: "memory");
        __builtin_amdgcn_s_barrier(); asm volatile("" ::: "memory");
#pragma unroll 1
        for (int c = 0; c < 64; ++c) {
            X2A_ISSUE(c + 4);
            asm volatile("s_waitcnt vmcnt(18)" ::: "memory");
            __builtin_amdgcn_s_barrier(); asm volatile("" ::: "memory");
        }
        asm volatile("s_waitcnt vmcnt(0)" ::: "memory");
#undef X2A_ISSUE
    } else {
        const int vt = wave, m16 = lane & 15, g = lane >> 4;
        u32x4* SB = (u32x4*)(p.ws + O_SB) + (size_t)ch * 64 * 512 + vt * 128 + lane;
        f32x4 D[4] = {{0.f, 0.f, 0.f, 0.f}, {0.f, 0.f, 0.f, 0.f}, {0.f, 0.f, 0.f, 0.f}, {0.f, 0.f, 0.f, 0.f}};
        __builtin_amdgcn_s_barrier(); asm volatile("" ::: "memory");
#pragma unroll 1
        for (int c = 0; c < 64; ++c) {
            const LAS unsigned char* sl = lds + (c % NSLOT) * SLOT;
            bf16x8 bk[2];
#pragma unroll
            for (int ks = 0; ks < 2; ++ks) { u32x4 w; w.x = cvt_pk_bf16(D[2 * ks][0], D[2 * ks][1]); w.y = cvt_pk_bf16(D[2 * ks][2], D[2 * ks][3]); w.z = cvt_pk_bf16(D[2 * ks + 1][0], D[2 * ks + 1][1]); w.w = cvt_pk_bf16(D[2 * ks + 1][2], D[2 * ks + 1][3]);
                bk[ks] = __builtin_bit_cast(bf16x8, w); SB[(size_t)c * 512 + ks * 64] = w; }
#pragma unroll
            for (int tj = 0; tj < 4; ++tj) { const int row = 16 * tj + m16, rx = row & 7;
                u32x2 f[2][2];
#pragma unroll
                for (int ks = 0; ks < 2; ++ks)
#pragma unroll
                    for (int hh = 0; hh < 2; ++hh) { const int o = 64 * ks + 8 * g + 32 * hh; f[ks][hh] = *(const LAS u32x2*)(sl + row * 128 + (((o >> 4) ^ rx) << 4) + (o & 15)); }
                const int prow = 16 * vt + m16; const int pc = 4 * tj + g;
                f32x4 z = *(const LAS f32x4*)(sl + 8192 + prow * 256 + ((pc ^ (prow & 15)) << 4));
                u32x4 a0; a0.x = f[0][0].x; a0.y = f[0][0].y; a0.z = f[0][1].x; a0.w = f[0][1].y;
                u32x4 a1; a1.x = f[1][0].x; a1.y = f[1][0].y; a1.z = f[1][1].x; a1.w = f[1][1].y;
                z = __builtin_amdgcn_mfma_f32_16x16x32_bf16(__builtin_bit_cast(bf16x8, a0), bk[0], z, 0, 0, 0); z = __builtin_amdgcn_mfma_f32_16x16x32_bf16(__builtin_bit_cast(bf16x8, a1), bk[1], z, 0, 0, 0); D[tj] = z; }
            asm volatile("s_waitcnt lgkmcnt(0)" ::: "memory");
            __builtin_amdgcn_s_barrier(); asm volatile("" ::: "memory");
        }
    }
}
__device__ __forceinline__ void ph_x2b_post(const P& p, int l, LAS unsigned char* lds, int lane, int wave, int blk, int G) {
    (void)lds;
    const int m16 = lane & 15, g = lane >> 4;
    const bf16_t* V = WSP(O_V, bf16_t); const bf16_t* GATE = WSP(O_GATE, bf16_t); const float* RKB = WSP(O_RKB, float); bf16_t* MIX = WSP(O_MIX, bf16_t);
#pragma unroll 1
    for (int task = blk * 8 + wave; task < 6144; task += G * 8) {
        const int tt = task & 3, c = (task >> 2) & 63, bh = task >> 8, b = bh / 6, h = bh % 6; const int tok = b * 4096 + 64 * c + 16 * tt + m16;
        u32x2 gm[2][4]; u32x4 sb[2][8]; u32x2 yl[2][4];
#pragma unroll
        for (int dir = 0; dir < 2; ++dir) {
            const int unit = ((b * 6 + h) * 2 + dir) * 64 + (dir ? 63 - c : c);
            const bf16_t* GMi = WSP(O_GM, bf16_t) + (size_t)unit * 4096 + (16 * tt + m16) * 64 + 4 * g; const bf16_t* YL = WSP(O_YLT, bf16_t) + (size_t)unit * 4096 + (16 * tt + m16) * 64 + 4 * g;
            const u32x4* SB = (const u32x4*)(p.ws + O_SB) + (size_t)unit * 512 + lane;
#pragma unroll
            for (int k = 0; k < 4; ++k) gm[dir][k] = *(const u32x2*)(GMi + 16 * k);
#pragma unroll
            for (int k = 0; k < 8; ++k) sb[dir][k] = SB[k * 64];
#pragma unroll
            for (int vt = 0; vt < 4; ++vt) yl[dir][vt] = *(const u32x2*)(YL + 16 * vt);
        }
        u32x2 vin[4], gin[4]; f32x4 lw[4], lb[4];
#pragma unroll
        for (int vt = 0; vt < 4; ++vt) { const size_t o = (size_t)tok * 384 + h * 64 + 16 * vt + 4 * g; vin[vt] = *(const u32x2*)(V + o); gin[vt] = *(const u32x2*)(GATE + o);
            lw[vt] = *(const f32x4*)(p.in[29] + l * 384 + h * 64 + 16 * vt + 4 * g); lb[vt] = *(const f32x4*)(p.in[30] + l * 384 + h * 64 + 16 * vt + 4 * g); }
        const float rkv = RKB[tok * 8 + h];
        f32x4 yy[4]; float s = 0.f;
#pragma unroll
        for (int vt = 0; vt < 4; ++vt) { f32x4 z = bf4_to_f32(yl[0][vt]) + bf4_to_f32(yl[1][vt]);
#pragma unroll
            for (int dir = 0; dir < 2; ++dir) {
                u32x4 g0; g0.x = gm[dir][0].x; g0.y = gm[dir][0].y; g0.z = gm[dir][1].x; g0.w = gm[dir][1].y; u32x4 g1; g1.x = gm[dir][2].x; g1.y = gm[dir][2].y; g1.z = gm[dir][3].x; g1.w = gm[dir][3].y;
                z = __builtin_amdgcn_mfma_f32_16x16x32_bf16(__builtin_bit_cast(bf16x8, sb[dir][2 * vt]), __builtin_bit_cast(bf16x8, g0), z, 0, 0, 0);
                z = __builtin_amdgcn_mfma_f32_16x16x32_bf16(__builtin_bit_cast(bf16x8, sb[dir][2 * vt + 1]), __builtin_bit_cast(bf16x8, g1), z, 0, 0, 0); }
            yy[vt] = z; s += hsum4(z); }
        s += xchg16(s, lane); s += xchg32(s, lane);
        const float mean = s * (1.0f / 64.0f); float q = 0.f;
#pragma unroll
        for (int vt = 0; vt < 4; ++vt) { yy[vt] = yy[vt] - mean; q += hsum4(yy[vt] * yy[vt]); }
        q += xchg16(q, lane); q += xchg32(q, lane);
        const float rstd = rsqrtf(q * (1.0f / 64.0f) + 64e-5f);
#pragma unroll
        for (int vt = 0; vt < 4; ++vt) { const f32x4 vv = bf4_to_f32(vin[vt]), gg = bf4_to_f32(gin[vt]);
            const f32x4 out = (yy[vt] * rstd * lw[vt] + lb[vt] + rkv * vv) * gg;
            *(u32x2*)(MIX + (size_t)tok * 1024 + 256 + h * 64 + 16 * vt + 4 * g) = f32_to_bf4(out); }
    }
}

__device__ __forceinline__ void ph_router(const P& p, int l, unsigned char* lds, int tid, int lane, int wave, int blk, int G, int cnt_off) {
    constexpr int WTS = 1028;
    float* WT = (float*)lds;
    constexpr int RM = LDS_X + 512;
    int* sel = (int*)(lds + RM);
    float* gat = (float*)(lds + RM + 1024);
    int* lpos = (int*)(lds + RM + 2048);
    float* rstd_s = (float*)(lds + RM + 3072);
    int* lcnt = (int*)(lds + RM + 3328);
    int* gbase = (int*)(lds + RM + 3456);
    float* bpart = (float*)(lds + RM + 12288);
    const float* rw = p.in[34] + (size_t)l * 1024 * 32;
    const float* MOD = WSP(O_MOD, float);
    unsigned* CNT = WSP(O_CTL, unsigned) + CW_CNT + l * 64 + cnt_off;
    bf16_t* XS = WSP(O_XS, bf16_t); int* SLOT = WSP(O_SLOT, int); float* GV = WSP(O_GV, float); int* TOKT = WSP(O_YS, int);
    float* lgt = (float*)(lds + RM + 4096);
    const int m16 = lane & 15, kq = lane >> 4, ttile = wave >> 1, etile = wave & 1;
    int fb = -1;
    for (int item = blk; item < T / 64; item += G) {
        const int b = item >> 6;
        const float* m = MOD + (size_t)(l * 4 + b) * 6144;
        if (b != fb) {
            if (fb >= 0) __syncthreads();
            fb = b;
            float bs[4] = {0.f, 0.f, 0.f, 0.f};
#pragma unroll 1
            for (int i0 = 0; i0 < 16; i0 += 8) {
                f32x4 v[8]; float g2v[8], scv[8], shv[8];
#pragma unroll
                for (int i = 0; i < 8; ++i) { const int idx4 = (i0 + i) * NTHREADS + tid, d = idx4 >> 3, e4 = (idx4 & 7) * 4; v[i] = *(const f32x4*)(rw + d * 32 + e4);
                    g2v[i] = p.in[5][l * 1024 + d]; scv[i] = m[4096 + d]; shv[i] = m[3072 + d]; }
#pragma unroll
                for (int i = 0; i < 8; ++i) { const int idx4 = (i0 + i) * NTHREADS + tid, d = idx4 >> 3, e4 = (idx4 & 7) * 4; const float gm = g2v[i] * (scv[i] + 1.0f), sh = shv[i];
                    WT[(e4 + 0) * WTS + d] = v[i][0] * gm; WT[(e4 + 1) * WTS + d] = v[i][1] * gm; WT[(e4 + 2) * WTS + d] = v[i][2] * gm; WT[(e4 + 3) * WTS + d] = v[i][3] * gm;
                    bs[0] += sh * v[i][0]; bs[1] += sh * v[i][1]; bs[2] += sh * v[i][2]; bs[3] += sh * v[i][3]; } }
#pragma unroll
            for (int j = 0; j < 4; ++j) { float s = dpp_add<0x128>(bs[j]); s += xchg16(s, lane); s += xchg32(s, lane); bs[j] = s; }
            if (lane < 8) { bpart[wave * 32 + lane * 4 + 0] = bs[0]; bpart[wave * 32 + lane * 4 + 1] = bs[1]; bpart[wave * 32 + lane * 4 + 2] = bs[2]; bpart[wave * 32 + lane * 4 + 3] = bs[3]; }
        }
        if (tid < 32) lcnt[tid] = 0;
        __syncthreads();
        { const int tl = ttile * 16 + m16, row = item * 64 + tl;
          const bf16_t* xr = WSP(O_XR, bf16_t) + (size_t)row * 1024 + kq * 256; const float* wt = WT + (etile * 16 + m16) * WTS + kq * 256;
          f32x4 acc = {0.f, 0.f, 0.f, 0.f}, acc1 = {0.f, 0.f, 0.f, 0.f}; float ss = 0.f;
          u32x2 xa[8], xb[8];
#define RT_LOAD(buf, j0) do { _Pragma("unroll") for (int u_ = 0; u_ < 8; ++u_) buf[u_] = *(const u32x2*)(xr + 4 * ((j0) + u_)); } while (0)
#define RT_MMA(buf, j0) do { _Pragma("unroll") for (int u_ = 0; u_ < 8; ++u_) { const f32x4 xv = bf4_to_f32(buf[u_]); const f32x4 wv = *(const f32x4*)(wt + 4 * ((j0) + u_)); \
              ss += xv[0] * xv[0] + xv[1] * xv[1] + xv[2] * xv[2] + xv[3] * xv[3]; \
              acc = __builtin_amdgcn_mfma_f32_16x16x4f32(xv[0], wv[0], acc, 0, 0, 0); acc1 = __builtin_amdgcn_mfma_f32_16x16x4f32(xv[1], wv[1], acc1, 0, 0, 0); \
              acc = __builtin_amdgcn_mfma_f32_16x16x4f32(xv[2], wv[2], acc, 0, 0, 0); acc1 = __builtin_amdgcn_mfma_f32_16x16x4f32(xv[3], wv[3], acc1, 0, 0, 0); } } while (0)
          RT_LOAD(xa, 0); RT_LOAD(xb, 8);
#pragma unroll
          for (int jb = 0; jb < 64; jb += 16) {
              RT_MMA(xa, jb); __builtin_amdgcn_sched_barrier(0); if (jb + 16 < 64) RT_LOAD(xa, jb + 16); __builtin_amdgcn_sched_barrier(0);
              RT_MMA(xb, jb + 8); __builtin_amdgcn_sched_barrier(0); if (jb + 24 < 64) RT_LOAD(xb, jb + 24); __builtin_amdgcn_sched_barrier(0); }
#undef RT_LOAD
#undef RT_MMA
          acc = acc + acc1;
          ss += xchg16(ss, lane); ss += xchg32(ss, lane);
          if (etile == 0 && kq == 0) rstd_s[tl] = rsqrtf(ss * (1.0f / 1024.0f) + 1e-6f);
#pragma unroll
          for (int i = 0; i < 4; ++i) lgt[(ttile * 16 + 4 * kq + i) * 32 + etile * 16 + m16] = acc[i]; }
        __syncthreads();
        { const int me = lane >> 1; float rbias = p.in[35][l * 32 + me];
#pragma unroll
          for (int w = 0; w < 8; ++w) rbias += bpart[w * 32 + me];
#pragma unroll 1
          for (int it = 0; it < 8; ++it) {
            const int tl = wave * 8 + it;
            float val = lgt[tl * 32 + me] * rstd_s[tl] + rbias;
            float tv[4]; int te[4];
#pragma unroll
            for (int k = 0; k < 4; ++k) { const float mxv = wave_max_all(val); const int idx = wave_min_all(val == mxv ? me : 64); tv[k] = mxv; te[k] = idx; if (me == idx) val = -3.0e38f; }
            const float e1 = __expf(tv[1] - tv[0]), e2 = __expf(tv[2] - tv[0]), e3 = __expf(tv[3] - tv[0]); const float inv = 1.0f / (1.0f + e1 + e2 + e3);
            if (lane == 0) {
                const float gg[4] = {inv, e1 * inv, e2 * inv, e3 * inv};
#pragma unroll
                for (int k = 0; k < 4; ++k) { sel[tl * 4 + k] = te[k]; gat[tl * 4 + k] = gg[k]; lpos[tl * 4 + k] = atomicAdd(&lcnt[te[k]], 1); } }
          } }
        __syncthreads();
        if (tid < 32) gbase[tid] = (int)__hip_atomic_fetch_add(CNT + tid, (unsigned)lcnt[tid], __ATOMIC_RELAXED, __HIP_MEMORY_SCOPE_AGENT);
        __syncthreads();
        { f32x4 gmv[4], shv[4], scv_[4];
#pragma unroll
          for (int i = 0; i < 4; ++i) { const int c = i * 256 + lane * 4; gmv[i] = *(const f32x4*)(p.in[5] + l * 1024 + c); scv_[i] = *(const f32x4*)(m + 4096 + c); shv[i] = *(const f32x4*)(m + 3072 + c); }
#pragma unroll
          for (int i = 0; i < 4; ++i) gmv[i] = gmv[i] * (scv_[i] + 1.0f);
#pragma unroll 1
          for (int it0 = 0; it0 < 8; it0 += 4) {
            u32x2 xrow[4][4];
#pragma unroll
            for (int u = 0; u < 4; ++u)
#pragma unroll
                for (int i = 0; i < 4; ++i) xrow[u][i] = *(const u32x2*)(WSP(O_XR, bf16_t) + (size_t)(item * 64 + wave * 8 + it0 + u) * 1024 + i * 256 + lane * 4);
#pragma unroll
          for (int u = 0; u < 4; ++u) { const int it = it0 + u;
            const int tl = wave * 8 + it, row = item * 64 + tl; const float rstd = rstd_s[tl];
            u32x2 w[4];
#pragma unroll
            for (int i = 0; i < 4; ++i) { const f32x4 x = bf4_to_f32(xrow[u][i]);
                const f32x4 hh = x * rstd * gmv[i] + shv[i];
                w[i].x = cvt_pk_bf16(hh[0], hh[1]); w[i].y = cvt_pk_bf16(hh[2], hh[3]); }
#pragma unroll
            for (int i = 0; i < 4; ++i) *(u32x2*)(XS + (size_t)row * 1024 + i * 256 + lane * 4) = w[i];
            if (lane < 4) { const int k = lane; const int e = sel[tl * 4 + k]; const int slot = e * CAP + gbase[e] + lpos[tl * 4 + k];
                SLOT[row * 4 + k] = slot; GV[row * 4 + k] = gat[tl * 4 + k]; TOKT[slot] = row; }
          } } }
        __syncthreads();
    }
}


#if defined(__HIP_DEVICE_COMPILE__)
typedef const __attribute__((address_space(4))) P* KargPtr;
__device__ __forceinline__ P load_params() { KargPtr kp = (KargPtr)__builtin_amdgcn_kernarg_segment_ptr(); asm volatile("" : "+s"(kp)); P r;
    for (int i = 0; i < 40; ++i) r.in[i] = kp->in[i];
    r.out = kp->out; r.ws = kp->ws; r.lo = kp->lo; r.hi = kp->hi; return r; }
#else
__device__ __forceinline__ P load_params() { return P{}; }
#endif
__device__ __forceinline__ int fresh_tid(int wave_s) { asm volatile("" : "+s"(wave_s)); int ln = __builtin_amdgcn_mbcnt_hi(~0u, __builtin_amdgcn_mbcnt_lo(~0u, 0u)); asm volatile("" : "+v"(ln)); return wave_s * 64 + ln; }
#define PHASE_ENV() const P q = load_params(); int blk = blk0, G = G0; asm volatile("" : "+s"(blk), "+s"(G)); const int tid = fresh_tid(wave_s0), lane = tid & 63, wave = __builtin_amdgcn_readfirstlane(tid >> 6); (void)lane; (void)wave

constexpr int PH_PER_LAYER = 12, N_PHASES = 2 + NL * PH_PER_LAYER + 1;
__global__ void __launch_bounds__(NTHREADS, 2) enc_fwd(P p) {
    extern __shared__ __attribute__((aligned(16))) unsigned char lds[];
    const int blk0 = blockIdx.x, G0 = gridDim.x, wave_s0 = __builtin_amdgcn_readfirstlane(threadIdx.x >> 6);
    LAS unsigned char* ldsl = (LAS unsigned char*)lds;
    volatile LAS unsigned* MISC = (volatile LAS unsigned*)(ldsl + LDS_MISC);
    LAS int* moe_pre = (LAS int*)(ldsl + LDS_MISC - 256); LAS int* moe_cnt = (LAS int*)(ldsl + LDS_MISC - 512);
    if (threadIdx.x < 64) MISC[threadIdx.x] = 0u;
    __syncthreads();
#if MK_LAUNCH_PER_PHASE
#define GRID_BAR() do { } while (0)
#else
    XcdBarrier bar = xcd_barrier_post((unsigned*)(p.ws + O_CTL) + CW_BAR, MISC + 8);
#define GRID_BAR() xcd_barrier(bar)
#endif
    const int lo = p.lo, hi = p.hi;
#ifndef EN_MASK
#define EN_MASK 0xFFFFFFFFu
#endif
#define EN(j) ((EN_MASK >> (j)) & 1u)
#ifndef REP_MASK
#define REP_MASK 0u
#endif
#define PROBE_DUMMY(j) (((REP_MASK >> (j)) & 1u) && rep_ == 0)
#define REPS(j) for (int rep_ = 0; rep_ <= (int)((REP_MASK >> (j)) & 1u); ++rep_)
#define IN(k) (lo <= (k) && (k) < hi)
#define SEAM(k) do { if (IN((k) + 1)) { GRID_BAR(); if ((REP_MASK >> 14) & 1u) GRID_BAR(); } } while (0)
#define QWS(off, type) ((type*)(q.ws + (off)))

    if (EN(20) && IN(0)) REPS(20) { { PHASE_ENV(); ph_mod(q, lds, tid, blk, G); } { PHASE_ENV(); ph_convert<false>(q, 0, lds, tid, blk, G, 0, 1 << 30); } { PHASE_ENV(); ph_smallw(q, tid, blk, G); } { PHASE_ENV(); ph_s5ops(q, lds, tid, blk, G); } SEAM(0); }
    if (EN(22) && IN(1)) REPS(22) { { PHASE_ENV(); ph_s5fill(q, tid, blk, G, 0, G == 256 ? 1 : NL); } { PHASE_ENV(); ph_combine_norm(q, -1, 0, lane, wave, blk, G, QWS(O_XR, bf16_t)); } SEAM(1); }

#pragma unroll 1
    for (int l = 0; l < NL; ++l) {
        const int pb = 2 + l * PH_PER_LAYER;
        if (l > 0 && EN(0) && IN(pb + 0)) REPS(0) { PHASE_ENV(); ph_combine_norm(q, l - 1, l, lane, wave, blk, G, PROBE_DUMMY(0) ? QWS(O_HH, bf16_t) : QWS(O_XR, bf16_t)); SEAM(pb + 0); }
        if (EN(1) && IN(pb + 1)) REPS(1) { PHASE_ENV();
            pg8::GridOrder S; S.init(QWS(O_H1, bf16_t), 1024, QWS(O_WIN, bf16_t) + (size_t)l * 3072 * 1024, 1024, T, NPROJ, G, blk, 0);
            EpiBf16T<false> E{QWS(O_PROJ, bf16_t), NPROJ, nullptr, NPROJ, 0};
            pg8::gemm_phase(ldsl, 1024, 1024, 1024, S, E, tid);
            SEAM(pb + 1);
        }
        if (EN(2) && IN(pb + 2)) REPS(2) { PHASE_ENV(); ph_prepass(q, l, lane, wave, blk, G); SEAM(pb + 2); }
        if (EN(3) && IN(pb + 3)) REPS(3) {
            { PHASE_ENV(); pg8::GridOrder S; S.init(QWS(O_ZS, bf16_t), 384, QWS(O_W1C, bf16_t) + (size_t)l * 512 * 384, 384, T, 512, G, blk, 0);
              EpiLvl1 E{QWS(O_HID, bf16_t)};
              pg8::gemm_phase(ldsl, 384, 384, 384, S, E, tid); }
            { PHASE_ENV(); S5SOrder S{(const char*)QWS(O_AS5, bf16_t), (const char*)(QWS(O_WS5S, bf16_t) + (size_t)l * 16 * 256 * 1024), G, (blk - 128 + G) % G};
              EpiF32 E{QWS(O_SLOC, float), 256};
              pg8::gemm_phase(ldsl, 1024, 1280, 1024, S, E, tid); }
            { PHASE_ENV(); if (G == 256 && blk >= 144) ph_convert<true>(q, l, lds, tid, blk - 144, 112, 0, CONV_EARLY); }
            SEAM(pb + 3);
        }
        if (EN(4) && IN(pb + 4)) REPS(4) {
            { PHASE_ENV(); pg8::GridOrder S; S.init(QWS(O_HID, bf16_t), 384, QWS(O_W2B, bf16_t) + (size_t)l * 2048 * 384, 384, T, 2048, G, blk, 0);
              EpiLvl2 E{q.in[18] + l * 768, q.in[21] + l * 768, q.in[27] + l * 384, q.ws};
              pg8::gemm_phase(ldsl, 384, 384, 384, S, E, tid); }
            { PHASE_ENV(); ph_s5carry(q, l, tid, blk); }
            SEAM(pb + 4);
        }
        if (EN(5) && IN(pb + 5)) REPS(5) {
            { PHASE_ENV(); S5YOrder S{(const char*)QWS(O_AS5, bf16_t), (const char*)(QWS(O_WS5Y, bf16_t) + (size_t)l * 16 * 1024 * 1280), G, blk};
              EpiS5Y E{QWS(O_YG, bf16_t)};
              pg8::gemm_phase(ldsl, 1280, 1280, 1280, S, E, tid); }
            { PHASE_ENV(); if (G > 64) { if (blk >= 64) ph_na(q, l, lds, tid, lane, wave, blk - 64, G - 64); } else ph_na(q, l, lds, tid, lane, wave, blk, G); }
            { PHASE_ENV(); if (G == 256) { if (blk < 64) ph_x1(q, lds, tid, lane, wave, blk, 64, 0, 896); else ph_x1(q, lds, tid, lane, wave, blk - 64, 192, 896, 3072); } else ph_x1(q, lds, tid, lane, wave, blk, G, 0, 3072); }
            SEAM(pb + 5);
        }
        if (EN(6) && IN(pb + 6)) REPS(6) {
            { PHASE_ENV(); ph_x2a(q, ldsl, tid, lane, wave, blk); }
            { PHASE_ENV(); pg8::GridOrder S; S.init(QWS(O_YG, bf16_t), 256, QWS(O_WGLU, bf16_t) + (size_t)l * 65536, 256, T, 256, G, blk, 192 % G);
              EpiGlu E{QWS(O_YG, bf16_t), QWS(O_MIX, bf16_t)};
              pg8::gemm_phase(ldsl, 256, 256, 256, S, E, tid); }
            { PHASE_ENV();
              if (G == 256) { constexpr int t0 = CONV_EARLY, rr = 6144 - t0, ta = t0 + (336 * rr) / 6144, tb = t0 + (1936 * rr) / 6144;
                  if (blk < 48) ph_convert<true>(q, l, lds, tid, blk, 48, t0, ta); else if (blk >= 192) ph_convert<true>(q, l, lds, tid, blk - 192, 64, ta, tb); else ph_convert<true>(q, l, lds, tid, blk - 48, 144, tb, 6144); }
              else if (G > 48) { if (blk >= 48) ph_convert<true>(q, l, lds, tid, blk - 48, G - 48, 480, 6144); else ph_convert<true>(q, l, lds, tid, blk, 48, 0, 480); } else ph_convert<true>(q, l, lds, tid, blk, G, 0, 6144); }
            SEAM(pb + 6);
        }
        if (EN(7) && IN(pb + 7)) REPS(7) { PHASE_ENV(); ph_x2b_post(q, l, ldsl, lane, wave, blk, G); SEAM(pb + 7); }
        if (EN(8) && IN(pb + 8)) REPS(8) { PHASE_ENV();
            pg8::GridOrder S; S.init(QWS(O_MIX, bf16_t), 1024, QWS(O_WOUT, bf16_t) + (size_t)l * 1024 * 1024, 1024, T, 1024, G, blk, 0);
            EpiWout E{PROBE_DUMMY(8) ? QWS(O_HH, bf16_t) : QWS(O_XR, bf16_t), QWS(O_MOD, float) + (size_t)(l * 4) * 6144 + 2048};
            pg8::gemm_phase(ldsl, 1024, 1024, 1024, S, E, tid);
            SEAM(pb + 8);
        }
        if (EN(9) && IN(pb + 9)) REPS(9) { PHASE_ENV(); ph_router(q, l, lds, tid, lane, wave, blk, G, PROBE_DUMMY(9) ? 32 : 0); SEAM(pb + 9); }
        if ((EN(10) && IN(pb + 10)) || (EN(11) && IN(pb + 11))) {
            PHASE_ENV();
            if (tid < 32) moe_cnt[tid] = (int)__hip_atomic_load(QWS(O_CTL, unsigned) + CW_CNT + l * 64 + tid, __ATOMIC_RELAXED, __HIP_MEMORY_SCOPE_AGENT);
            __syncthreads();
            if (tid == 0) { int run = 0; for (int e = 0; e < 32; ++e) { moe_pre[e] = run; run += (moe_cnt[e] + 255) >> 8; } moe_pre[32] = run; }
            __syncthreads();
        }
        if (EN(10) && IN(pb + 10)) REPS(10) { PHASE_ENV();
            LAS unsigned* tokl = (LAS unsigned*)(ldsl + LDS_X);
            MoeOrderT<true> S{moe_pre, (const char*)QWS(O_XS, bf16_t), (const char*)(QWS(O_EW1, bf16_t) + (size_t)l * NE * 2048 * 1024), G, blk, 8, (size_t)256 * 1024 * 2, tokl};
            { const int* TOKT = QWS(O_YS, int);
              int tv_[MOE_NTAB / 2]; bool ok_[MOE_NTAB / 2];
#pragma unroll
              for (int k_ = 0; k_ < MOE_NTAB / 2; ++k_) { const int idx = k_ * NTHREADS + tid, ui_ = idx >> 8, r_ = idx & 255; Unit u_; const bool has_ = S.next(ui_, u_);
                  const int orow_ = has_ ? u_.orow : 0, e_ = has_ ? u_.aux : 0; ok_[k_] = has_ && ((orow_ & (CAP - 1)) + r_ < moe_cnt[e_]); tv_[k_] = TOKT[ok_[k_] ? orow_ + r_ : 0]; }
#pragma unroll
              for (int k_ = 0; k_ < MOE_NTAB / 2; ++k_) tokl[k_ * NTHREADS + tid] = ok_[k_] ? (unsigned)tv_[k_] * 2048u : 0u;
              __syncthreads(); }
            EpiSwiglu E{QWS(O_HH, bf16_t), q.in[37] + (size_t)l * NE * 2048};
            pg8::gemm_phase(ldsl, 1024, 1024, 1024, S, E, tid);
            if (G == 256 && l + 1 < NL && rep_ == 0) { PHASE_ENV(); const int nrb = moe_pre[32], rem_rb = nrb & 31, nshort = (32 - rem_rb) * 8; const int q_ = (blk & 7) * 4 + ((blk >> 3) & 3);
                if (rem_rb == 0 || nshort < 64) ph_s5fill(q, tid, blk, G, l + 1, l + 2);
                else if (q_ >= rem_rb) ph_s5fill(q, tid, (q_ - rem_rb) * 8 + (blk >> 5), nshort, l + 1, l + 2); }
            SEAM(pb + 10);
        }
        if (EN(11) && IN(pb + 11)) REPS(11) { PHASE_ENV();
            MoeOrderT<false> S{moe_pre, (const char*)QWS(O_HH, bf16_t), (const char*)(QWS(O_EW2, bf16_t) + (size_t)l * NE * 1024 * 1024), G, blk, 4, (size_t)256 * 1024 * 2, nullptr};
            EpiBf16T<true> E{QWS(O_XS, bf16_t), 1024, q.in[39] + (size_t)l * NE * 1024, 1024, 1024};
            pg8::gemm_phase(ldsl, 1024, 1024, 1024, S, E, tid);
            SEAM(pb + 11);
        }
    }
    if (EN(21) && IN(N_PHASES - 1)) { PHASE_ENV(); ph_combine_norm(q, NL - 1, NL, lane, wave, blk, G, nullptr); }
}

extern "C" void kernel_launch(void* const* d_in, const int* in_sizes, int n_in, void* d_out, int out_size, void* d_ws, size_t ws_size, hipStream_t stream) {
    static int grid = 0;
    if (grid == 0) {
        if (n_in != 40 || out_size != T * D || ws_size < WS_END) { fprintf(stderr, "kernel_launch: unexpected shapes (n_in %d out %d ws %zu)\n", n_in, out_size, ws_size); grid = -1; return; }
        int dev = 0, cus = 0, per_cu = 0;
        if (hipGetDevice(&dev) != hipSuccess || hipDeviceGetAttribute(&cus, hipDeviceAttributeMultiprocessorCount, dev) != hipSuccess) { grid = -1; return; }
        if (hipFuncSetAttribute((const void*)enc_fwd, hipFuncAttributeMaxDynamicSharedMemorySize, LDS_BYTES) != hipSuccess) { fprintf(stderr, "kernel_launch: hipFuncSetAttribute failed\n"); grid = -1; return; }
        if (hipOccupancyMaxActiveBlocksPerMultiprocessor(&per_cu, (const void*)enc_fwd, NTHREADS, LDS_BYTES) != hipSuccess || per_cu < 1) fprintf(stderr, "kernel_launch: occupancy query reports %d\n", per_cu);
        (void)hipGetLastError();
        if (cus * MOE_NTAB < 2304) { fprintf(stderr, "kernel_launch: %d CUs: too few for the expert GEMM's row-offset table\n", cus); grid = -1; return; }
        grid = cus;
    }
    if (grid < 0) return;
    (void)hipMemsetAsync((char*)d_ws + O_CTL, 0, CTL_BYTES, stream);
    P a{};
    for (int i = 0; i < 40; ++i) a.in[i] = (const float*)d_in[i];
    a.out = (float*)d_out; a.ws = (unsigned char*)d_ws;
#if MK_LAUNCH_PER_PHASE
    for (int ph = 0; ph < N_PHASES; ++ph) { a.lo = ph; a.hi = ph + 1; hipLaunchKernelGGL(enc_fwd, dim3(grid), dim3(NTHREADS), LDS_BYTES, stream, a); }
#else
    a.lo = 0; a.hi = N_PHASES;
    hipLaunchKernelGGL(enc_fwd, dim3(grid), dim3(NTHREADS), LDS_BYTES, stream, a);
#endif
}
```

```cpp
#include <hip/hip_runtime.h>
#include <cstdio>
#include <cstdint>

#define LAS __attribute__((address_space(3)))
typedef unsigned short bf16_t;
typedef short bf16x8 __attribute__((ext_vector_type(8)));
typedef short s16x4 __attribute__((ext_vector_type(4)));
typedef float f32x4 __attribute__((ext_vector_type(4)));
typedef float f32x2 __attribute__((ext_vector_type(2)));
typedef unsigned u32x4 __attribute__((ext_vector_type(4)));
typedef unsigned u32x2 __attribute__((ext_vector_type(2)));

#ifndef MK_LAUNCH_PER_PHASE
#define MK_LAUNCH_PER_PHASE 0
#endif

constexpr int T = 16384, D = 1024, NL = 4, SEQ = 4096, NE = 32, CAP = 16384;
constexpr int NPROJ = 3072;
constexpr int NTHREADS = 512;
constexpr size_t MiB = 1u << 20;
constexpr size_t O_CTL = 0, CTL_BYTES = 1 * MiB;
constexpr size_t O_MOD = 1 * MiB;
constexpr size_t O_S5M = 1 * MiB + 512 * 1024;
constexpr size_t O_WIN = 2 * MiB;
constexpr size_t O_WOUT = 26 * MiB;
constexpr size_t O_W1C = 34 * MiB;
constexpr size_t O_W2B = 36 * MiB;
constexpr size_t O_WGLU = 42 * MiB;
constexpr size_t O_WS5S = 43 * MiB;
constexpr size_t O_WS5Y = 75 * MiB;
constexpr size_t O_EW1 = 235 * MiB;
constexpr size_t O_EW2 = 747 * MiB;
constexpr size_t O_H1 = 1003 * MiB;
constexpr size_t O_PROJ = 1035 * MiB;
constexpr size_t O_ZS = 1131 * MiB;
constexpr size_t O_HID = 1143 * MiB;
constexpr size_t O_QN = 1155 * MiB;
constexpr size_t O_KN = 1167 * MiB;
constexpr size_t O_R = 1179 * MiB;
constexpr size_t O_K = 1203 * MiB;
constexpr size_t O_V = 1227 * MiB;
constexpr size_t O_A = 1251 * MiB;
constexpr size_t O_GATE = 1275 * MiB;
constexpr size_t O_DEC = 1299 * MiB;
constexpr size_t O_KD = 1347 * MiB;
constexpr size_t O_BV = 1395 * MiB;
constexpr size_t O_YS = 1443 * MiB;
constexpr size_t O_KT = O_YS + 40 * MiB;
constexpr size_t O_XR = O_YS + 8 * MiB;
constexpr size_t O_RKB = 1491 * MiB;
constexpr size_t O_AS5 = 1492 * MiB;
constexpr size_t O_SLOC = 1502 * MiB;
constexpr size_t O_YG = 1506 * MiB;
constexpr size_t O_MIX = 1514 * MiB;
constexpr size_t O_SLOT = 1546 * MiB;
constexpr size_t O_GV = 1547 * MiB;
constexpr size_t O_XS = 1548 * MiB;
constexpr size_t O_HH = 2572 * MiB;
constexpr size_t O_PHI = O_HH, O_GM = O_HH + 32 * MiB, O_PSIT = O_HH + 64 * MiB, O_YLT = O_HH + 128 * MiB, O_SB = O_HH + 192 * MiB;
constexpr size_t WS_END = 3596 * MiB;
constexpr int CW_BAR = 4096;
constexpr int CW_CNT = 8192;
constexpr int LDS_BYTES = 147456;
constexpr int LDS_MISC = 147456 - 256;
constexpr int LDS_X = 131072;

struct P { const float* in[40]; float* out; unsigned char* ws; int lo, hi; };

typedef __bf16 bf16x2_t __attribute__((ext_vector_type(2)));
__device__ __forceinline__ unsigned cvt_pk_bf16(float lo, float hi) { const f32x2 v = {lo, hi}; return __builtin_bit_cast(unsigned, __builtin_convertvector(v, bf16x2_t)); }
__device__ __forceinline__ float bf2f(bf16_t v) { return __uint_as_float(((unsigned)v) << 16); }
__device__ __forceinline__ bf16_t f2bf(float f) { unsigned u = __float_as_uint(f); u += 0x7FFFu + ((u >> 16) & 1u); return (bf16_t)(u >> 16); }
__device__ __forceinline__ float wsum(float v) {
#pragma unroll
    for (int o = 32; o > 0; o >>= 1) v += __shfl_xor(v, o);
    return v; }
__device__ __forceinline__ float wmaxf(float v) {
#pragma unroll
    for (int o = 32; o > 0; o >>= 1) v = fmaxf(v, __shfl_xor(v, o));
    return v; }
__device__ __forceinline__ int wmini(int v) {
#pragma unroll
    for (int o = 32; o > 0; o >>= 1) v = min(v, __shfl_xor(v, o));
    return v; }
__device__ __forceinline__ float frcp(float x) { return __builtin_amdgcn_rcpf(x); }
__device__ __forceinline__ float sigmoidf_(float x) { return frcp(1.0f + __expf(-x)); }
__device__ __forceinline__ float gelu_tanh(float x) { const float u = 0.7978845608f * (x + 0.044715f * x * x * x); return x * frcp(1.0f + __expf(-2.0f * u)); }

__device__ __forceinline__ f32x4 bf4_to_f32(u32x2 v) { f32x4 r; r[0] = __uint_as_float(v.x << 16); r[1] = __uint_as_float(v.x & 0xFFFF0000u); r[2] = __uint_as_float(v.y << 16); r[3] = __uint_as_float(v.y & 0xFFFF0000u); return r; }
__device__ __forceinline__ u32x2 f32_to_bf4(f32x4 v) { u32x2 w; w.x = cvt_pk_bf16(v[0], v[1]); w.y = cvt_pk_bf16(v[2], v[3]); return w; }
__device__ __forceinline__ unsigned f2h_bits(float f) { return (unsigned)__builtin_bit_cast(unsigned short, (_Float16)f); }
__device__ __forceinline__ float h2f_bits(unsigned h) { return (float)__builtin_bit_cast(_Float16, (unsigned short)h); }
__device__ __forceinline__ u32x2 f32_to_h4(f32x4 v) { u32x2 w; w.x = f2h_bits(v[0]) | (f2h_bits(v[1]) << 16); w.y = f2h_bits(v[2]) | (f2h_bits(v[3]) << 16); return w; }
__device__ __forceinline__ f32x4 h4_to_f32(u32x2 w) { f32x4 r; r[0] = h2f_bits(w.x & 0xFFFFu); r[1] = h2f_bits(w.x >> 16); r[2] = h2f_bits(w.y & 0xFFFFu); r[3] = h2f_bits(w.y >> 16); return r; }
__device__ __forceinline__ float hsum4(f32x4 v) { return (v[0] + v[1]) + (v[2] + v[3]); }
template <int CTRL> __device__ __forceinline__ float dpp_add(float v) { return v + __builtin_bit_cast(float, __builtin_amdgcn_update_dpp(0, __builtin_bit_cast(int, v), CTRL, 0xF, 0xF, true)); }
__device__ __forceinline__ float row16_sum(float v) { v = dpp_add<0xB1>(v); v = dpp_add<0x4E>(v); v = dpp_add<0x124>(v); v = dpp_add<0x128>(v); return v; }

template <int CTRL> __device__ __forceinline__ float dpp_mov(float v) { return __builtin_bit_cast(float, __builtin_amdgcn_update_dpp(0, __builtin_bit_cast(int, v), CTRL, 0xF, 0xF, true)); }
template <int CTRL> __device__ __forceinline__ int dpp_movi(int v) { return __builtin_amdgcn_update_dpp(0, v, CTRL, 0xF, 0xF, true); }
__device__ __forceinline__ void swap16(float& a, float& b) { asm volatile("s_nop 1\n\tv_permlane16_swap_b32 %0, %1\n\ts_nop 0" : "+v"(a), "+v"(b)); }
__device__ __forceinline__ void swap32(float& a, float& b) { asm volatile("s_nop 1\n\tv_permlane32_swap_b32 %0, %1\n\ts_nop 0" : "+v"(a), "+v"(b)); }
__device__ __forceinline__ float xchg16(float send, int lane) { float a = send, b = send; swap16(a, b); return (lane & 16) ? a : b; }
__device__ __forceinline__ float xchg32(float send, int lane) { float a = send, b = send; swap32(a, b); return (lane & 32) ? a : b; }
__device__ __forceinline__ float wave_sum_all(float v) { v = row16_sum(v); { float a = v, b = v; swap16(a, b); v = a + b; } { float a = v, b = v; swap32(a, b); v = a + b; } return v; }
__device__ __forceinline__ float wave_max_all(float v) { v = fmaxf(v, dpp_mov<0xB1>(v)); v = fmaxf(v, dpp_mov<0x4E>(v)); v = fmaxf(v, dpp_mov<0x124>(v)); v = fmaxf(v, dpp_mov<0x128>(v));
    { float a = v, b = v; swap16(a, b); v = fmaxf(a, b); } { float a = v, b = v; swap32(a, b); v = fmaxf(a, b); } return v; }
__device__ __forceinline__ int wave_min_all(int v) { v = min(v, dpp_movi<0xB1>(v)); v = min(v, dpp_movi<0x4E>(v)); v = min(v, dpp_movi<0x124>(v)); v = min(v, dpp_movi<0x128>(v));
    { float a = __builtin_bit_cast(float, v), b = a; swap16(a, b); v = min(__builtin_bit_cast(int, a), __builtin_bit_cast(int, b)); } { float a = __builtin_bit_cast(float, v), b = a; swap32(a, b); v = min(__builtin_bit_cast(int, a), __builtin_bit_cast(int, b)); } return v; }


#define LDS_BARRIER() do { asm volatile("s_waitcnt lgkmcnt(0)" ::: "memory"); __builtin_amdgcn_s_barrier(); asm volatile("" ::: "memory"); } while (0)

#define XB_TMO      128
#define XB_XCNT(j)  (256  + 64 * (j))
#define XB_XSUB(j)  (1280 + 64 * (j))
#define XB_XGEN(j)  (2304 + 64 * (j))
#define XB_TOP      3328
#define XB_TOPGEN   3392
#define XCD_BAR_WORDS 3456
#define XB_SPIN_CAP (1u << 22)
__device__ __forceinline__ unsigned xb_ld(unsigned* p)              { return __hip_atomic_load(p, __ATOMIC_RELAXED, __HIP_MEMORY_SCOPE_AGENT); }
__device__ __forceinline__ unsigned xb_add(unsigned* p, unsigned v) { return __hip_atomic_fetch_add(p, v, __ATOMIC_RELAXED, __HIP_MEMORY_SCOPE_AGENT); }
__device__ __forceinline__ unsigned xb_xcc_id() { return (unsigned)__builtin_amdgcn_s_getreg((3 << 11) | 20) & 0xFu; }
#define XB_SPIN(cond, bar) do { unsigned _sp = 0; while (cond) { __builtin_amdgcn_s_sleep(1); \
    if ((++_sp & 255u) == 0u) { if (xb_ld(&(bar)[XB_TMO])) break; if (_sp > XB_SPIN_CAP) { atomicAdd(&(bar)[XB_TMO], 1u); break; } } } } while (0)
struct XcdBarrier { unsigned* bar; unsigned x; volatile LAS unsigned* st; };
__device__ __forceinline__ XcdBarrier xcd_barrier_post(unsigned* bar, volatile LAS unsigned* st) {
    XcdBarrier b; b.bar = bar; b.x = xb_xcc_id(); b.st = st;
    if (threadIdx.x == 0) (void)xb_add(&bar[XB_XCNT(b.x)], 1u);
    return b;
}
__device__ __forceinline__ void xcd_barrier_complete(unsigned* bar, unsigned x, unsigned& nloc, unsigned& nx) {
    const unsigned G = gridDim.x * gridDim.y * gridDim.z;
    unsigned sum, cnt, mine, sp = 0u;
    for (;;) {
        sum = 0u; cnt = 0u; mine = 0u;
#pragma unroll
        for (unsigned j = 0; j < 16; ++j) { const unsigned c = xb_ld(&bar[XB_XCNT(j)]); sum += c; cnt += (c > 0u) ? 1u : 0u; mine = (j == x) ? c : mine; }
        if (sum == G) break;
        __builtin_amdgcn_s_sleep(1);
        if ((++sp & 255u) == 0u) { if (xb_ld(&bar[XB_TMO])) break; if (sp > XB_SPIN_CAP) { atomicAdd(&bar[XB_TMO], 1u); break; } }
    }
    nloc = mine > 0u ? mine : 1u; nx = cnt > 0u ? cnt : 1u;
}
__device__ __forceinline__ void xcd_barrier(const XcdBarrier& b) {
    asm volatile("s_waitcnt vmcnt(0)" ::: "memory");
    __syncthreads();
    if (threadIdx.x == 0) {
        unsigned* bar = b.bar;
        __builtin_amdgcn_s_waitcnt(0);
        unsigned nloc = b.st[0], nx = b.st[1];
        if (nloc == 0u) { xcd_barrier_complete(bar, b.x, nloc, nx); b.st[0] = nloc; b.st[1] = nx; }
        const unsigned old = xb_add(&bar[XB_XSUB(b.x)], 1u);
        const unsigned gen = old / nloc;
        if (old + 1u == (gen + 1u) * nloc) {
            __builtin_amdgcn_fence(__ATOMIC_RELEASE, "agent");
            asm volatile("s_waitcnt vmcnt(0)" ::: "memory");
            const unsigned og = xb_add(&bar[XB_TOP], 1u);
            const unsigned tg = og / nx;
            if (og + 1u == (tg + 1u) * nx) xb_add(&bar[XB_TOPGEN], 1u);
            else XB_SPIN(xb_ld(&bar[XB_TOPGEN]) == tg, bar);
            __builtin_amdgcn_fence(__ATOMIC_ACQUIRE, "agent");
            xb_add(&bar[XB_XGEN(b.x)], 1u);
            asm volatile("s_waitcnt vmcnt(0)" ::: "memory");
        } else {
            XB_SPIN(xb_ld(&bar[XB_XGEN(b.x)]) == gen, bar);
            __builtin_amdgcn_fence(__ATOMIC_ACQUIRE, "agent");
            asm volatile("s_waitcnt vmcnt(0)" ::: "memory");
        }
    }
    __syncthreads();
}

namespace pg8 {
constexpr int BM = 256, BK = 64, HALF = 128, HTB = HALF * BK * 2, STAGE_BYTES = 8 * HTB, NXCD = 8, WGM = 8;
__host__ __device__ __forceinline__ int lds_byte(int r, int c) { const int st = (r >> 4) * 2 + (c >> 5), rr = r & 15, cc = c & 31, ob = rr * 64 + cc * 2; return st * 1024 + (ob ^ (((ob >> 9) & 1) << 5)); }
__host__ __device__ __forceinline__ void stage_rc(int b, int& R, int& C) { const int st = b / 1024, sb = b % 1024, swz = sb ^ (((sb >> 9) & 1) << 5); R = (st >> 1) * 16 + swz / 64; C = (st & 1) * 32 + (swz % 64) / 2; }
__host__ __device__ __forceinline__ int perm32(int rho) { const int n = rho >> 4, i = rho & 15; return 8 * (i >> 2) + 4 * n + (i & 3); }

struct Unit { const char* a; const char* b; int orow, ocol, aux; };

template <class Epi, class Sched>
__device__ __forceinline__ void gemm_phase(LAS unsigned char* lds, const int K, const int lda, const int ldb, const Sched& S, const Epi& E, const int tid_in) {
    const int tid = tid_in, wid = __builtin_amdgcn_readfirstlane(tid >> 6), lane = tid & 63, wr = wid >> 2, wc = wid & 3, fr = lane & 15, fq = lane >> 4;
    const int nt = K / BK;
    constexpr bool GA = Sched::GATHER;
    unsigned voffA[2], voffB[2]; int rowA[2]; unsigned gc[2][2], gn[2][2];
#pragma unroll
    for (int i = 0; i < 2; ++i) { int R, C; stage_rc(tid * 16 + i * 8192, R, C); const int Rb = Epi::PERM ? ((R & ~31) + perm32(R & 31)) : R;
        voffA[i] = GA ? (unsigned)C * 2u : (unsigned)(R * lda + C) * 2u; voffB[i] = (unsigned)(Rb * ldb + C) * 2u; rowA[i] = R; }
#define PG8_GLOAD(g, ui_) do { if constexpr (GA) { _Pragma("unroll") for (int h_ = 0; h_ < 2; ++h_) _Pragma("unroll") for (int i_ = 0; i_ < 2; ++i_) g[h_][i_] = S.tok_off((ui_), h_ * 128 + rowA[i_]) + voffA[i_]; } } while (0)
#define PG8_STAGE_A(bufoff, base, kb, h, g) do { if constexpr (GA) { _Pragma("unroll") for (int _i = 0; _i < 2; ++_i) \
        __builtin_amdgcn_global_load_lds((const unsigned*)((const char*)(base) + (kb) + g[h][_i]), (LAS unsigned*)(lds + (bufoff) + ldsw + _i * 8192), 16, 0, 0); } \
        else PG8_STAGE(bufoff, (base) + (kb) + (h) * hstepA, voffA); } while (0)
    const size_t kstep = (size_t)(BK * 2);
    const size_t hstepA = (size_t)HALF * lda * 2, hstepB = (size_t)HALF * ldb * 2;
    const unsigned ldsw = (unsigned)wid * 1024u;
    const int aoff = lds_byte(wr * 64 + fr, fq * 8), boff = lds_byte(wc * 32 + fr, fq * 8);
#define PG8_SA(b, h) (((b) * 2 + (h)) * HTB)
#define PG8_SB(b, h) ((4 + (b) * 2 + (h)) * HTB)
#define PG8_STAGE(bufoff, gbase, voff) do { _Pragma("unroll") for (int _i = 0; _i < 2; ++_i) \
        __builtin_amdgcn_global_load_lds((const unsigned*)((const char*)(gbase) + (voff)[_i]), (LAS unsigned*)(lds + (bufoff) + ldsw + _i * 8192), 16, 0, 0); } while (0)
#define PG8_LDA(dst, b, h) do { _Pragma("unroll") for (int m = 0; m < 4; ++m) _Pragma("unroll") for (int k = 0; k < 2; ++k) dst[m][k] = *(const LAS bf16x8*)(lds + PG8_SA(b, h) + aoff + m * 2048 + k * 1024); } while (0)
#define PG8_LDB(dst, b, h) do { _Pragma("unroll") for (int n = 0; n < 2; ++n) _Pragma("unroll") for (int k = 0; k < 2; ++k) dst[n][k] = *(const LAS bf16x8*)(lds + PG8_SB(b, h) + boff + n * 2048 + k * 1024); } while (0)
#define PG8_MMA(ai, bj, At, Bt) do { __builtin_amdgcn_s_setprio(1); _Pragma("unroll") for (int m = 0; m < 4; ++m) _Pragma("unroll") for (int n = 0; n < 2; ++n) _Pragma("unroll") for (int k = 0; k < 2; ++k) \
        acc[ai][bj][m][n] = __builtin_amdgcn_mfma_f32_16x16x32_bf16(Bt[n][k], At[m][k], acc[ai][bj][m][n], 0, 0, 0); __builtin_amdgcn_s_setprio(0); } while (0)
#define PG8_WAIT_V(n) asm volatile("s_waitcnt vmcnt(" #n ")" ::: "memory")
#define PG8_WAIT_L(n) asm volatile("s_waitcnt lgkmcnt(" #n ")" ::: "memory")
#define PG8_BAR __builtin_amdgcn_s_barrier()
#define PG8_SCHED __builtin_amdgcn_sched_barrier(0)
    Unit cur, nxt; int ui = 0;
    if (!S.next(0, cur)) return;
    f32x4 acc[2][2][4][2];
#pragma unroll
    for (int a = 0; a < 2; ++a)
#pragma unroll
        for (int b = 0; b < 2; ++b)
#pragma unroll
            for (int m = 0; m < 4; ++m)
#pragma unroll
                for (int n = 0; n < 2; ++n) acc[a][b][m][n] = (f32x4){0.f, 0.f, 0.f, 0.f};
    bf16x8 At[4][2], B0[2][2], B1[2][2];
    const char* cA = cur.a; const char* cB = cur.b;
    PG8_GLOAD(gc, 0);
    PG8_STAGE(PG8_SB(0, 0), cB, voffB); PG8_STAGE(PG8_SB(0, 1), cB + hstepB, voffB); PG8_STAGE_A(PG8_SA(0, 0), cA, 0, 0, gc); PG8_STAGE_A(PG8_SA(0, 1), cA, 0, 1, gc);
    if (wr == 1) PG8_BAR;
    PG8_WAIT_V(2); PG8_BAR;
    PG8_STAGE(PG8_SB(1, 0), cB + kstep, voffB); PG8_STAGE_A(PG8_SA(1, 0), cA, kstep, 0, gc); PG8_STAGE(PG8_SB(1, 1), cB + hstepB + kstep, voffB);
    PG8_WAIT_V(6); PG8_BAR;
    for (;;) {
        const bool has_next = S.next(ui + 1, nxt);
        const char* nA = has_next ? nxt.a : cA; const char* nB = has_next ? nxt.b : cB;
        if constexpr (GA) { if (has_next) PG8_GLOAD(gn, ui + 1); else {
#pragma unroll
            for (int h_ = 0; h_ < 2; ++h_)
#pragma unroll
                for (int i_ = 0; i_ < 2; ++i_) gn[h_][i_] = gc[h_][i_]; } }
#pragma unroll 1
        for (int t = 0; t < nt; t += 2) {
            const bool last = (t == nt - 2);
            const size_t k1 = (size_t)(t + 1) * kstep, k2 = last ? (size_t)0 : (size_t)(t + 2) * kstep, k3 = k2 + kstep;
            const char* a2 = last ? nA : cA; const char* b2 = last ? nB : cB;
            unsigned g2[2][2];
#pragma unroll
            for (int h_ = 0; h_ < 2; ++h_)
#pragma unroll
                for (int i_ = 0; i_ < 2; ++i_) g2[h_][i_] = GA ? (last ? gn[h_][i_] : gc[h_][i_]) : 0u;
            PG8_LDB(B0, 0, 0); PG8_LDB(B1, 0, 1); PG8_SCHED; PG8_LDA(At, 0, 0); PG8_STAGE_A(PG8_SA(1, 1), cA, k1, 1, gc);
            PG8_WAIT_V(8); PG8_WAIT_L(0); PG8_BAR; PG8_MMA(0, 0, At, B0); PG8_MMA(0, 1, At, B1); PG8_BAR; PG8_SCHED;
            PG8_LDA(At, 0, 1); PG8_STAGE(PG8_SB(0, 0), b2 + k2, voffB); PG8_STAGE(PG8_SB(0, 1), b2 + k2 + hstepB, voffB); PG8_STAGE_A(PG8_SA(0, 0), a2, k2, 0, g2);
            PG8_WAIT_V(8); PG8_WAIT_L(0); PG8_BAR; PG8_MMA(1, 0, At, B0); PG8_MMA(1, 1, At, B1); PG8_BAR; PG8_SCHED;
            PG8_LDB(B0, 1, 0); PG8_LDB(B1, 1, 1); PG8_SCHED; PG8_LDA(At, 1, 0); PG8_STAGE_A(PG8_SA(0, 1), a2, k2, 1, g2);
            PG8_WAIT_V(8); PG8_WAIT_L(0); PG8_BAR; PG8_MMA(0, 0, At, B0); PG8_MMA(0, 1, At, B1); PG8_BAR; PG8_SCHED;
            PG8_LDA(At, 1, 1); PG8_STAGE(PG8_SB(1, 0), b2 + k3, voffB); PG8_STAGE(PG8_SB(1, 1), b2 + k3 + hstepB, voffB); PG8_STAGE_A(PG8_SA(1, 0), a2, k3, 0, g2);
            PG8_WAIT_V(8); PG8_WAIT_L(0); PG8_BAR; PG8_MMA(1, 0, At, B0); PG8_MMA(1, 1, At, B1); PG8_BAR; PG8_SCHED;
        }
        if (wr == 0) PG8_BAR;
        E(acc, cur, wr, wc, fr, fq);
        if constexpr (Epi::DRAIN) __builtin_amdgcn_s_waitcnt(0x0F70);
        if (!has_next) break;
#pragma unroll
        for (int a = 0; a < 2; ++a)
#pragma unroll
            for (int b = 0; b < 2; ++b)
#pragma unroll
                for (int m = 0; m < 4; ++m)
#pragma unroll
                    for (int n = 0; n < 2; ++n) acc[a][b][m][n] = (f32x4){0.f, 0.f, 0.f, 0.f};
        cur = nxt; cA = nA; cB = nB; ++ui;
        if constexpr (GA) {
#pragma unroll
            for (int h_ = 0; h_ < 2; ++h_)
#pragma unroll
                for (int i_ = 0; i_ < 2; ++i_) gc[h_][i_] = gn[h_][i_]; }
        if (wr == 1) PG8_BAR;
    }
    PG8_WAIT_V(0);
    PG8_BAR;
#undef PG8_SA
#undef PG8_SB
#undef PG8_STAGE
#undef PG8_STAGE_A
#undef PG8_GLOAD
#undef PG8_LDA
#undef PG8_LDB
#undef PG8_MMA
#undef PG8_WAIT_V
#undef PG8_WAIT_L
#undef PG8_BAR
#undef PG8_SCHED
}

struct GridOrder {
    static constexpr bool GATHER = false; __device__ __forceinline__ unsigned tok_off(int, int) const { return 0u; }
    const char* A; const char* B; size_t tA, tB; int nM, nN, nwg, G, c;
    __device__ __forceinline__ void init(const void* A_, int lda, const void* B_, int ldb, int M, int N, int G_, int blk, int off) {
        A = (const char*)A_; B = (const char*)B_; tA = (size_t)256 * lda * 2; tB = (size_t)256 * ldb * 2; nM = M / BM; nN = N / BM; nwg = nM * nN; G = G_; c = (blk - off + G_) % G_; }
    __device__ __forceinline__ bool next(int i, Unit& u) const {
        const long L = (long)i * G + c; if (L >= nwg) return false;
        int wgid = (int)L; { const int q = nwg / NXCD, r = nwg % NXCD, xcd = wgid % NXCD, off = wgid / NXCD; wgid = (xcd < r ? xcd * (q + 1) : r * (q + 1) + (xcd - r) * q) + off; }
        const int nig = WGM * nN, gid = wgid / nig, fm = gid * WGM, gsz = (nM - fm) < WGM ? (nM - fm) : WGM;
        const int pm = fm + ((wgid % nig) % gsz), pn = (wgid % nig) / gsz;
        u.a = A + (size_t)pm * tA; u.b = B + (size_t)pn * tB; u.orow = pm * BM; u.ocol = pn * BM; u.aux = 0; return true;
    }
};
}
using pg8::Unit;

#define EPI_LOOP_ROWS for (int ai = 0; ai < 2; ++ai) _Pragma("unroll") for (int m = 0; m < 4; ++m)
template <bool DRAIN_> struct EpiBf16T {
    static constexpr bool PERM = true, DRAIN = DRAIN_;
    bf16_t* O; int ldc; const float* bias; int ncols;
    int biasld;
    __device__ __forceinline__ void operator()(const f32x4 (&acc)[2][2][4][2], const Unit& u, int wr, int wc, int fr, int fq) const {
        const int row0 = u.orow + wr * 64 + fr, col0 = u.ocol + wc * 32 + 8 * fq;
        f32x4 bv[2][2];
#pragma unroll
        for (int bj = 0; bj < 2; ++bj)
#pragma unroll
            for (int n = 0; n < 2; ++n) bv[bj][n] = bias ? *(const f32x4*)(bias + (size_t)u.aux * biasld + col0 + bj * 128 + 4 * n) : (f32x4){0.f, 0.f, 0.f, 0.f};
#pragma unroll
        EPI_LOOP_ROWS { bf16_t* rowp = O + (size_t)(row0 + ai * 128 + m * 16) * ldc + col0;
#pragma unroll
            for (int bj = 0; bj < 2; ++bj) { if (col0 + bj * 128 < ncols) { const f32x4 v0 = acc[ai][bj][m][0] + bv[bj][0], v1 = acc[ai][bj][m][1] + bv[bj][1];
                u32x4 w; w.x = cvt_pk_bf16(v0[0], v0[1]); w.y = cvt_pk_bf16(v0[2], v0[3]); w.z = cvt_pk_bf16(v1[0], v1[1]); w.w = cvt_pk_bf16(v1[2], v1[3]);
                *(u32x4*)(rowp + bj * 128) = w; } } }
    }
};
struct EpiLvl1 {
    static constexpr bool PERM = true, DRAIN = false;
    bf16_t* O;
    __device__ __forceinline__ void operator()(const f32x4 (&acc)[2][2][4][2], const Unit& u, int wr, int wc, int fr, int fq) const {
        const int row0 = u.orow + wr * 64 + fr, col0 = u.ocol + wc * 32 + 8 * fq;
#pragma unroll
        EPI_LOOP_ROWS { bf16_t* rowp = O + (size_t)(row0 + ai * 128 + m * 16) * 384 + col0;
#pragma unroll
            for (int bj = 0; bj < 2; ++bj) { const int c = col0 + bj * 128; if (c < 384) { f32x4 v0 = acc[ai][bj][m][0], v1 = acc[ai][bj][m][1];
#pragma unroll
                for (int j = 0; j < 4; ++j) {
                    if (c < 128) { v0[j] = 1.0f - 2.0f * frcp(__expf(2.0f * fminf(fmaxf(v0[j], -15.f), 15.f)) + 1.0f); v1[j] = 1.0f - 2.0f * frcp(__expf(2.0f * fminf(fmaxf(v1[j], -15.f), 15.f)) + 1.0f); }
                    else if (c >= 256) { v0[j] = sigmoidf_(v0[j]); v1[j] = sigmoidf_(v1[j]); } }
                u32x4 w; w.x = cvt_pk_bf16(v0[0], v0[1]); w.y = cvt_pk_bf16(v0[2], v0[3]); w.z = cvt_pk_bf16(v1[0], v1[1]); w.w = cvt_pk_bf16(v1[2], v1[3]);
                *(u32x4*)(rowp + bj * 128) = w; } } }
    }
};
struct EpiLvl2 {
    static constexpr bool PERM = false, DRAIN = false;
    const float* w0; const float* a0; const float* k_a;
    unsigned char* ws;
    template <int BJ, int N_>
    __device__ __forceinline__ void part(const f32x4 (&acc)[2][2][4][2], int row0, int col0) const {
        const int c = col0 + BJ * 128 + N_ * 16;
        const int seg = c / 384, cc = c - seg * 384;
        if (seg < 2) {
            bf16_t* DEC = (bf16_t*)(ws + O_DEC) + (size_t)seg * T * 384;
            const f32x4 w0v = *(const f32x4*)(w0 + seg * 384 + cc);
#pragma unroll
            for (int ai = 0; ai < 2; ++ai)
#pragma unroll
                for (int m = 0; m < 4; ++m) { const size_t ro = (size_t)(row0 + ai * 128 + m * 16) * 384 + cc; f32x4 o;
#pragma unroll
                    for (int j = 0; j < 4; ++j) { const float pre = w0v[j] + acc[ai][BJ][m][N_][j]; o[j] = __expf(-0.60653065971f * sigmoidf_(pre)); }
                    *(u32x2*)(DEC + ro) = f32_to_h4(o); }
        } else if (seg < 4) {
            const int d = seg - 2; const f32x4 a0v = *(const f32x4*)(a0 + d * 384 + cc), kav = *(const f32x4*)(k_a + cc);
            const bf16_t* Kb = (const bf16_t*)(ws + O_K); const bf16_t* Ab = (const bf16_t*)(ws + O_A);
            bf16_t* KD = (bf16_t*)(ws + O_KD) + (size_t)d * T * 384; bf16_t* BV = (bf16_t*)(ws + O_BV) + (size_t)d * T * 384;
            u32x2 kraw[2][4], araw[2][4];
#pragma unroll
            for (int ai = 0; ai < 2; ++ai)
#pragma unroll
                for (int m = 0; m < 4; ++m) { const size_t ro = (size_t)(row0 + ai * 128 + m * 16) * 384 + cc; kraw[ai][m] = *(const u32x2*)(Kb + ro); araw[ai][m] = *(const u32x2*)(Ab + ro); }
#pragma unroll
            for (int ai = 0; ai < 2; ++ai)
#pragma unroll
                for (int m = 0; m < 4; ++m) { const size_t ro = (size_t)(row0 + ai * 128 + m * 16) * 384 + cc; const f32x4 kv = bf4_to_f32(kraw[ai][m]), av = bf4_to_f32(araw[ai][m]); f32x4 okd, obv;
#pragma unroll
                    for (int j = 0; j < 4; ++j) { const float as = sigmoidf_(a0v[j] + acc[ai][BJ][m][N_][j]); okd[j] = kv[j] * (1.0f + (as - 1.0f) * kav[j]); obv[j] = -av[j] * as; }
                    *(u32x2*)(KD + ro) = f32_to_bf4(okd); *(u32x2*)(BV + ro) = f32_to_bf4(obv); }
        } else if (seg == 4) {
            bf16_t* GATE = (bf16_t*)(ws + O_GATE);
#pragma unroll
            for (int ai = 0; ai < 2; ++ai)
#pragma unroll
                for (int m = 0; m < 4; ++m) { const size_t ro = (size_t)(row0 + ai * 128 + m * 16) * 384 + cc; *(u32x2*)(GATE + ro) = f32_to_bf4(acc[ai][BJ][m][N_]); }
        }
    }
    __device__ __forceinline__ void operator()(const f32x4 (&acc)[2][2][4][2], const Unit& u, int wr, int wc, int fr, int fq) const {
        const int row0 = u.orow + wr * 64 + fr, col0 = u.ocol + wc * 32 + 4 * fq;
        part<0, 0>(acc, row0, col0); part<0, 1>(acc, row0, col0); part<1, 0>(acc, row0, col0); part<1, 1>(acc, row0, col0);
    }
};
struct EpiF32 {
    static constexpr bool PERM = false, DRAIN = false;
    float* C; int ldc;
    __device__ __forceinline__ void operator()(const f32x4 (&acc)[2][2][4][2], const Unit& u, int wr, int wc, int fr, int fq) const {
        const int row0 = u.orow + wr * 64 + fr, col0 = u.ocol + wc * 32 + 4 * fq;
#pragma unroll
        EPI_LOOP_ROWS { float* rowp = C + (size_t)(row0 + ai * 128 + m * 16) * ldc + col0;
#pragma unroll
            for (int bj = 0; bj < 2; ++bj)
#pragma unroll
                for (int n = 0; n < 2; ++n) *(f32x4*)(rowp + bj * 128 + n * 16) = acc[ai][bj][m][n]; }
    }
};
struct EpiS5Y {
    static constexpr bool PERM = true, DRAIN = false;
    bf16_t* YG;
    __device__ __forceinline__ void operator()(const f32x4 (&acc)[2][2][4][2], const Unit& u, int wr, int wc, int fr, int fq) const {
        const int row0 = u.orow + wr * 64 + fr, col0 = u.ocol + wc * 32 + 8 * fq;
#pragma unroll
        EPI_LOOP_ROWS { const int chunk = row0 + ai * 128 + m * 16;
#pragma unroll
            for (int bj = 0; bj < 2; ++bj) { const int nn = col0 + bj * 128, t = nn >> 4, ho = nn & 15; const f32x4 v0 = acc[ai][bj][m][0], v1 = acc[ai][bj][m][1];
                u32x4 w; w.x = cvt_pk_bf16(gelu_tanh(v0[0]), gelu_tanh(v0[1])); w.y = cvt_pk_bf16(gelu_tanh(v0[2]), gelu_tanh(v0[3])); w.z = cvt_pk_bf16(gelu_tanh(v1[0]), gelu_tanh(v1[1])); w.w = cvt_pk_bf16(gelu_tanh(v1[2]), gelu_tanh(v1[3]));
                *(u32x4*)(YG + (size_t)(chunk * 64 + t) * 256 + u.aux * 16 + ho) = w; } }
    }
};
struct EpiGlu {
    static constexpr bool PERM = true, DRAIN = false;
    const bf16_t* YG; bf16_t* MIX;
    __device__ __forceinline__ void operator()(const f32x4 (&acc)[2][2][4][2], const Unit& u, int wr, int wc, int fr, int fq) const {
        const int row0 = u.orow + wr * 64 + fr, col0 = u.ocol + wc * 32 + 8 * fq;
        u32x4 yraw[2][4][2];
#pragma unroll
        EPI_LOOP_ROWS {
#pragma unroll
            for (int bj = 0; bj < 2; ++bj) yraw[ai][m][bj] = *(const u32x4*)(YG + (size_t)(row0 + ai * 128 + m * 16) * 256 + col0 + bj * 128); }
#pragma unroll
        EPI_LOOP_ROWS { const size_t row = (size_t)(row0 + ai * 128 + m * 16);
#pragma unroll
            for (int bj = 0; bj < 2; ++bj) { const int c = col0 + bj * 128; const u32x4 yv = yraw[ai][m][bj]; const f32x4 v0 = acc[ai][bj][m][0], v1 = acc[ai][bj][m][1];
                float y[8]; y[0] = __uint_as_float(yv.x << 16); y[1] = __uint_as_float(yv.x & 0xFFFF0000u); y[2] = __uint_as_float(yv.y << 16); y[3] = __uint_as_float(yv.y & 0xFFFF0000u);
                y[4] = __uint_as_float(yv.z << 16); y[5] = __uint_as_float(yv.z & 0xFFFF0000u); y[6] = __uint_as_float(yv.w << 16); y[7] = __uint_as_float(yv.w & 0xFFFF0000u);
                u32x4 w; w.x = cvt_pk_bf16(y[0] * sigmoidf_(v0[0]), y[1] * sigmoidf_(v0[1])); w.y = cvt_pk_bf16(y[2] * sigmoidf_(v0[2]), y[3] * sigmoidf_(v0[3]));
                w.z = cvt_pk_bf16(y[4] * sigmoidf_(v1[0]), y[5] * sigmoidf_(v1[1])); w.w = cvt_pk_bf16(y[6] * sigmoidf_(v1[2]), y[7] * sigmoidf_(v1[3]));
                *(u32x4*)(MIX + row * 1024 + c) = w; } }
    }
};
struct EpiWout {
    static constexpr bool PERM = false, DRAIN = false;
    bf16_t* X; const float* gate;
    __device__ __forceinline__ void operator()(const f32x4 (&acc)[2][2][4][2], const Unit& u, int wr, int wc, int fr, int fq) const {
        const int row0 = u.orow + wr * 64 + fr, col0 = u.ocol + wc * 32 + 4 * fq; const int b = u.orow >> 12;
        f32x4 gv[2][2];
#pragma unroll
        for (int bj = 0; bj < 2; ++bj)
#pragma unroll
            for (int n = 0; n < 2; ++n) gv[bj][n] = *(const f32x4*)(gate + (size_t)b * 6144 + col0 + bj * 128 + n * 16);
        u32x2 old[2][4][2][2];
#pragma unroll
        for (int ai = 0; ai < 2; ++ai)
#pragma unroll
            for (int m = 0; m < 4; ++m)
#pragma unroll
                for (int bj = 0; bj < 2; ++bj)
#pragma unroll
                    for (int n = 0; n < 2; ++n) old[ai][m][bj][n] = *(const u32x2*)(X + (size_t)(row0 + ai * 128 + m * 16) * 1024 + col0 + bj * 128 + n * 16);
#pragma unroll
        for (int ai = 0; ai < 2; ++ai)
#pragma unroll
            for (int m = 0; m < 4; ++m)
#pragma unroll
                for (int bj = 0; bj < 2; ++bj)
#pragma unroll
                    for (int n = 0; n < 2; ++n) *(u32x2*)(X + (size_t)(row0 + ai * 128 + m * 16) * 1024 + col0 + bj * 128 + n * 16) = f32_to_bf4(bf4_to_f32(old[ai][m][bj][n]) + gv[bj][n] * acc[ai][bj][m][n]);
    }
};
struct EpiSwiglu {
    static constexpr bool PERM = true, DRAIN = false;
    bf16_t* HH; const float* b1;
    __device__ __forceinline__ void operator()(const f32x4 (&acc)[2][2][4][2], const Unit& u, int wr, int wc, int fr, int fq) const {
        const int row0 = u.orow + wr * 64 + fr, col0 = u.ocol + wc * 32 + 8 * fq;
        f32x4 bv[2][2];
#pragma unroll
        for (int bj = 0; bj < 2; ++bj)
#pragma unroll
            for (int n = 0; n < 2; ++n) bv[bj][n] = *(const f32x4*)(b1 + (size_t)u.aux * 2048 + col0 + bj * 128 + 4 * n);
#pragma unroll
        EPI_LOOP_ROWS { bf16_t* rowp = HH + (size_t)(row0 + ai * 128 + m * 16) * 1024 + (col0 >> 1);
#pragma unroll
            for (int bj = 0; bj < 2; ++bj) { const f32x4 v0 = acc[ai][bj][m][0] + bv[bj][0], v1 = acc[ai][bj][m][1] + bv[bj][1];
                float o[4];
#pragma unroll
                for (int j = 0; j < 4; ++j) { const float g = fminf(j < 2 ? v0[2 * j] : v1[2 * j - 4], 7.0f); const float li = fminf(fmaxf(j < 2 ? v0[2 * j + 1] : v1[2 * j - 3], -7.0f), 7.0f);
                    o[j] = g * sigmoidf_(1.702f * g) * (li + 1.0f); }
                u32x2 w; w.x = cvt_pk_bf16(o[0], o[1]); w.y = cvt_pk_bf16(o[2], o[3]);
                *(u32x2*)(rowp + bj * 64) = w; } }
    }
};

struct S5SOrder {
    static constexpr bool GATHER = false; __device__ __forceinline__ unsigned tok_off(int, int) const { return 0u; }
    const char* A; const char* B; int G, c;
    __device__ __forceinline__ bool next(int i, Unit& u) const { const int L = i * G + c; if (L >= 16) return false;
        u.a = A + (size_t)L * 256 * 1280 * 2; u.b = B + (size_t)L * 256 * 1024 * 2; u.orow = L * 256; u.ocol = 0; u.aux = L; return true; }
};
struct S5YOrder {
    static constexpr bool GATHER = false; __device__ __forceinline__ unsigned tok_off(int, int) const { return 0u; }
    const char* A; const char* B; int G, c;
    __device__ __forceinline__ bool next(int i, Unit& u) const { const int L = i * G + c; if (L >= 64) return false; const int g = L >> 2, pn = L & 3;
        u.a = A + (size_t)g * 256 * 1280 * 2; u.b = B + (size_t)(g * 1024 + pn * 256) * 1280 * 2; u.orow = 0; u.ocol = pn * 256; u.aux = g; return true; }
};
template <bool GATHER_> struct MoeOrderT {
    static constexpr bool GATHER = GATHER_;
    const LAS int* pre; const char* A; const char* B; int G, c, npn; size_t tB; const LAS unsigned* tokl;
    __device__ __forceinline__ unsigned tok_off(int ui, int r) const { return tokl[ui * 256 + r]; }
    __device__ __forceinline__ bool next(int i, Unit& u) const {
        int rbg, pn;
        if (G == 256) { const int xcd = c & 7, j = c >> 3; if (npn == 8) { rbg = i * 32 + xcd * 4 + (j & 3); pn = j >> 2; } else { rbg = i * 64 + xcd * 8 + (j & 7); pn = j >> 3; } }
        else { const int L = i * G + c; rbg = L / npn; pn = L - rbg * npn; }
        if (rbg >= pre[32]) return false;
        int e = 0;
#pragma unroll 1
        for (int s = 16; s > 0; s >>= 1) if (pre[e + s] <= rbg) e += s;
        const int rb = rbg - pre[e];
        u.a = GATHER_ ? A : A + (size_t)(e * 64 + rb) * (256 * 1024 * 2); u.b = B + (size_t)(e * npn + pn) * tB; u.orow = (e * 64 + rb) * 256; u.ocol = pn * 256; u.aux = e; return true;
    }
};
constexpr int CONV_EARLY = 336;
constexpr int MOE_NTAB = 14;

#define WSP(off, type) ((type*)(p.ws + (off)))

__device__ __forceinline__ void ph_mod(const P& p, unsigned char* lds, int tid, int blk, int G) {
    float* cond = (float*)lds;
    float* red = cond + 4096;
    for (int i = tid; i < 4096; i += NTHREADS) { const float c = p.in[1][i]; cond[i] = c / (1.0f + __expf(-c)); }
    __syncthreads();
    float* MOD = WSP(O_MOD, float);
    for (int item = blk; item < 256; item += G) {
        const int l = item >> 6, cb = item & 63;
        const int col = tid % 96, part = tid / 96;
        if (part < 5) {
            float a0 = 0.f, a1 = 0.f, a2 = 0.f, a3 = 0.f;
            const int d0 = part * 205, d1 = min(1024, d0 + 205);
            const float* w = p.in[2] + (size_t)l * 1024 * 6144 + cb * 96 + col;
            for (int db = d0; db < d1; db += 32) {
                float wv[32];
#pragma unroll
                for (int u = 0; u < 32; ++u) { const int d = min(db + u, d1 - 1); wv[u] = w[(size_t)d * 6144]; }
#pragma unroll
                for (int u = 0; u < 32; ++u) { const int d = db + u; const float x = d < d1 ? wv[u] : 0.f; const int dc = min(d, 1023); a0 += cond[dc] * x; a1 += cond[1024 + dc] * x; a2 += cond[2048 + dc] * x; a3 += cond[3072 + dc] * x; } }
            red[(part * 4 + 0) * 96 + col] = a0; red[(part * 4 + 1) * 96 + col] = a1; red[(part * 4 + 2) * 96 + col] = a2; red[(part * 4 + 3) * 96 + col] = a3;
        }
        __syncthreads();
        if (tid < 384) { const int b = tid / 96, c2 = tid % 96; float s = 0.f;
            for (int q = 0; q < 5; ++q) s += red[(q * 4 + b) * 96 + c2];
            MOD[(size_t)(l * 4 + b) * 6144 + cb * 96 + c2] = s + p.in[3][l * 6144 + cb * 96 + c2]; }
        __syncthreads();
    }
}

struct ConvTile { const float* src; bf16_t* dst; int N, kt, nt; };
__device__ __forceinline__ void conv_load(const ConvTile& t, int tid, f32x4 (&r)[8]) {
#pragma unroll
    for (int i = 0; i < 8; ++i) { const int idx = i * NTHREADS + tid, kk = idx >> 6, n = t.nt * 256 + (idx & 63) * 4;
        r[i] = (f32x4){0.f, 0.f, 0.f, 0.f};
        if (n < t.N) r[i] = __builtin_nontemporal_load((const f32x4*)(t.src + (size_t)(t.kt * 64 + kk) * t.N + n)); }
}
__device__ __forceinline__ void conv_to_lds(int tid, const f32x4 (&r)[8], float* tile) {
#pragma unroll
    for (int i = 0; i < 8; ++i) { const int idx = i * NTHREADS + tid, kk = idx >> 6, n4 = (idx & 63) * 4; float* d = tile + kk * 257 + n4; d[0] = r[i][0]; d[1] = r[i][1]; d[2] = r[i][2]; d[3] = r[i][3]; }
}
__device__ __forceinline__ void conv_from_lds(const ConvTile& t, int tid, const float* tile) {
    const int n = tid >> 1, kh = tid & 1; bf16_t* d = t.dst + (size_t)(t.nt * 256 + n) * 1024 + t.kt * 64 + kh * 32;
#pragma unroll
    for (int q = 0; q < 4; ++q) { float f[8];
#pragma unroll
        for (int j = 0; j < 8; ++j) f[j] = tile[(kh * 32 + q * 8 + j) * 257 + n];
        u32x4 w; w.x = cvt_pk_bf16(f[0], f[1]); w.y = cvt_pk_bf16(f[2], f[3]); w.z = cvt_pk_bf16(f[4], f[5]); w.w = cvt_pk_bf16(f[6], f[7]);
        *(u32x4*)(d + q * 8) = w; }
}
__device__ __forceinline__ bool conv_tile_a(const P& p, int g, ConvTile& t) {
    if (g < NL * 192) { const int l = g / 192, r = g % 192; t.src = p.in[6] + (size_t)l * 1024 * 2944; t.dst = WSP(O_WIN, bf16_t) + (size_t)l * 3072 * 1024; t.N = 2944; t.kt = r / 12; t.nt = r % 12; return true; }
    g -= NL * 192;
    if (g < NL * 64) { const int l = g >> 6, r = g & 63; t.src = p.in[7] + (size_t)l * 1024 * 1024; t.dst = WSP(O_WOUT, bf16_t) + (size_t)l * 1024 * 1024; t.N = 1024; t.kt = r >> 2; t.nt = r & 3; return true; }
    return false;
}
__device__ __forceinline__ bool conv_tile_b(const P& p, int l, int g, ConvTile& t) {
    if (g < 4096) { const int e = g >> 7, r = g & 127; t.src = p.in[36] + (size_t)(l * NE + e) * 1024 * 2048; t.dst = WSP(O_EW1, bf16_t) + (size_t)(l * NE + e) * 2048 * 1024; t.N = 2048; t.kt = r >> 3; t.nt = r & 7; return true; }
    g -= 4096;
    if (g < 2048) { const int e = g >> 6, r = g & 63; t.src = p.in[38] + (size_t)(l * NE + e) * 1024 * 1024; t.dst = WSP(O_EW2, bf16_t) + (size_t)(l * NE + e) * 1024 * 1024; t.N = 1024; t.kt = r >> 2; t.nt = r & 3; return true; }
    return false;
}
template <bool LIST_B> __device__ __forceinline__ void ph_convert(const P& p, int l, unsigned char* lds, int tid, int cblk, int CG, int g0, int g1) {
    float* tile = (float*)lds;
    ConvTile ta, tb, tc, tn; f32x4 ra[8], rb[8], rc[8];
    int g = g0 + cblk;
#define CONV_NEXT(t, has) do { has = g < g1 && (LIST_B ? conv_tile_b(p, l, g, t) : conv_tile_a(p, g, t)); g += CG; } while (0)
    bool ha, hb, hc, hn;
    CONV_NEXT(ta, ha); CONV_NEXT(tb, hb); CONV_NEXT(tc, hc);
    if (ha) conv_load(ta, tid, ra);
    if (hb) conv_load(tb, tid, rb);
    if (hc) conv_load(tc, tid, rc);
#define CONV_STEP(t, r, h) do { conv_to_lds(tid, r, tile); CONV_NEXT(tn, hn); if (hn) conv_load(tn, tid, r); LDS_BARRIER(); conv_from_lds(t, tid, tile); LDS_BARRIER(); t = tn; h = hn; } while (0)
#pragma unroll 1
    while (ha) {
        CONV_STEP(ta, ra, ha);
        if (!hb) break;
        CONV_STEP(tb, rb, hb);
        if (!hc) break;
        CONV_STEP(tc, rc, hc);
    }
#undef CONV_NEXT
#undef CONV_STEP
}
__device__ __forceinline__ void ph_smallw(const P& p, int tid, int blk, int G) {
    bf16_t* W1C = WSP(O_W1C, bf16_t); bf16_t* W2B = WSP(O_W2B, bf16_t); bf16_t* WGLU = WSP(O_WGLU, bf16_t);
    const int gt = blk * NTHREADS + tid, gs = G * NTHREADS;
    for (int idx = gt; idx < NL * 512 * 384; idx += gs) { const int l = idx / (512 * 384), r = idx % (512 * 384), n = r / 384, k = r % 384; float v = 0.f;
        if (n < 64) v = p.in[19][((size_t)(l * 2 + 0) * 384 + k) * 64 + n];
        else if (n < 128) v = p.in[19][((size_t)(l * 2 + 1) * 384 + k) * 64 + n - 64];
        else if (n < 192) v = p.in[22][((size_t)(l * 2 + 0) * 384 + k) * 64 + n - 128];
        else if (n < 256) v = p.in[22][((size_t)(l * 2 + 1) * 384 + k) * 64 + n - 192];
        else if (n < 384) v = p.in[24][((size_t)l * 384 + k) * 128 + n - 256];
        W1C[idx] = f2bf(v); }
    for (int idx = gt; idx < NL * 2048 * 384; idx += gs) { const int l = idx / (2048 * 384), r = idx % (2048 * 384), n = r / 384, k = r % 384; float v = 0.f;
        if (n < 1920) { const int seg = n / 384, cc = n % 384;
            if (seg == 0) { if (k < 64) v = p.in[20][((size_t)(l * 2 + 0) * 64 + k) * 384 + cc]; }
            else if (seg == 1) { if (k >= 64 && k < 128) v = p.in[20][((size_t)(l * 2 + 1) * 64 + k - 64) * 384 + cc]; }
            else if (seg == 2) { if (k >= 128 && k < 192) v = p.in[23][((size_t)(l * 2 + 0) * 64 + k - 128) * 384 + cc]; }
            else if (seg == 3) { if (k >= 192 && k < 256) v = p.in[23][((size_t)(l * 2 + 1) * 64 + k - 192) * 384 + cc]; }
            else { if (k >= 256) v = p.in[25][((size_t)l * 128 + k - 256) * 384 + cc]; } }
        W2B[idx] = f2bf(v); }
    for (int idx = gt; idx < NL * 256 * 256; idx += gs) { const int l = idx >> 16, n = (idx >> 8) & 255, k = idx & 255; WGLU[idx] = f2bf(p.in[16][((size_t)l * 256 + k) * 256 + n]); }
}
__device__ __forceinline__ void cpowz(double zre, double zim, int n, float& ore, float& oim) {
    const float mag = __expf((float)(zre * (double)n));
    double rev = zim * (double)n * 0.15915494309189535; rev -= rint(rev);
    const float r = (float)rev;
    ore = mag * __builtin_amdgcn_cosf(r); oim = mag * __builtin_amdgcn_sinf(r);
}
__device__ __forceinline__ void ph_s5ops(const P& p, unsigned char* lds, int tid, int blk, int G) {
    double* zr = (double*)lds;
    double* zi = zr + 128;
    float* qre = (float*)(zi + 128);
    float* qim = qre + 128;
    float* bbr = qim + 128;
    float* bbi = bbr + 2048;
    float* ccr = bbi + 2048;
    float* cci = ccr + 2048;
    float* pwr = cci + 2048;
    float* pwi = pwr + 320;
    float* kt = pwi + 320;
    const int nit = (G == 256) ? 16 : (NL * 16 * 64 - blk + G - 1) / G; int lgcur = -1;
    for (int k_ = 0; k_ < nit; ++k_) { const int item = (G == 256) ? blk * 16 + k_ : blk + k_ * G;
        const int l = item >> 10, g = (item >> 6) & 15, j = item & 63;
        if ((item >> 6) != lgcur) { lgcur = item >> 6;
        if (tid < 128) { const int dir = tid >> 6, pp = tid & 63; const int li = ((l * 2 + dir) * 16 + g) * 64 + pp;
            const double lre = (double)p.in[8][li], lim = (double)p.in[9][li]; const double dt = exp((double)p.in[10][(l * 2 + dir) * 16 + g]);
            const double zre = lre * dt, zim = lim * dt; zr[tid] = zre; zi[tid] = zim;
            float er, ei; cpowz(zre, zim, 1, er, ei);
            const double nr = (double)er - 1.0, ni = (double)ei, den = lre * lre + lim * lim;
            qre[tid] = (float)((nr * lre + ni * lim) / den); qim[tid] = (float)((ni * lre - nr * lim) / den);
            if (j == 0) { float m64r, m64i; cpowz(zre, zim, 64, m64r, m64i); float* S5M = WSP(O_S5M, float); S5M[(size_t)li * 2] = m64r; S5M[(size_t)li * 2 + 1] = m64i; } }
        __syncthreads();
        { float brv[4], biv[4], crv[4], civ[4];
#pragma unroll
          for (int k = 0; k < 4; ++k) { const int i = k * NTHREADS + tid; const int dir = i >> 10, pp = (i >> 4) & 63;
            const size_t gi = ((size_t)((l * 2 + dir) * 16 + g) * 64 + pp) * 16 + (i & 15);
            const int ho = (i >> 6) & 15, p2 = i & 63;
            const size_t ci = ((size_t)((l * 2 + dir) * 16 + g) * 16 + ho) * 64 + p2;
            brv[k] = p.in[11][gi]; biv[k] = p.in[12][gi]; crv[k] = p.in[13][ci]; civ[k] = p.in[14][ci]; }
#pragma unroll
          for (int k = 0; k < 4; ++k) { const int i = k * NTHREADS + tid; const int dir = i >> 10, pp = (i >> 4) & 63;
            const float qr = qre[dir * 64 + pp], qi = qim[dir * 64 + pp];
            bbr[i] = qr * brv[k] - qi * biv[k]; bbi[i] = qr * biv[k] + qi * brv[k]; ccr[i] = crv[k]; cci[i] = civ[k]; } }
        }
        if (tid < 320) { const int tb = tid >> 6, pp = tid & 63; float a, b;
            if (tb < 2) cpowz(zr[tb * 64 + pp], zi[tb * 64 + pp], j, a, b);
            else if (tb == 2) cpowz(zr[pp], zi[pp], j + 1, a, b);
            else if (tb == 3) cpowz(zr[64 + pp], zi[64 + pp], 64 - j, a, b);
            else cpowz(zr[pp], zi[pp], 63 - j, a, b);
            pwr[tid] = a; pwi[tid] = b; }
        __syncthreads();
        bf16_t* Wy = WSP(O_WS5Y, bf16_t) + (size_t)(l * 16 + g) * 1024 * 1280;
        bf16_t* Ws = WSP(O_WS5S, bf16_t) + (size_t)(l * 16 + g) * 256 * 1024;
        if (tid < 128) { const int dir = tid >> 6, ln = tid & 63, i16 = ln & 15, kq = ln >> 4;
            f32x4 acc = {0.f, 0.f, 0.f, 0.f};
#pragma unroll 4
            for (int st = 0; st < 16; ++st) { const int pp = 4 * st + kq;
                const float cr = ccr[(dir * 16 + i16) * 64 + pp], ci = cci[(dir * 16 + i16) * 64 + pp], wr_ = pwr[dir * 64 + pp], wi_ = pwi[dir * 64 + pp];
                const float tr = cr * wr_ - ci * wi_, ti = cr * wi_ + ci * wr_;
                acc = __builtin_amdgcn_mfma_f32_16x16x4f32(tr, bbr[(dir * 64 + pp) * 16 + i16], acc, 0, 0, 0);
                acc = __builtin_amdgcn_mfma_f32_16x16x4f32(-ti, bbi[(dir * 64 + pp) * 16 + i16], acc, 0, 0, 0); }
            float* KT = WSP(O_KT, float) + ((size_t)((l * 16 + g) * 2 + dir) * 64 + j) * 256;
#pragma unroll
            for (int r = 0; r < 4; ++r) KT[(4 * kq + r) * 16 + i16] = acc[r]; }
        { const int kp = tid & 255, dir = kp >> 7, comp = (kp >> 6) & 1, pp = kp & 63; const float wr_ = pwr[(2 + dir) * 64 + pp], wi_ = pwi[(2 + dir) * 64 + pp];
#pragma unroll
          for (int q = 0; q < 8; ++q) { const int ho = (tid >> 8) * 8 + q; const float cr = ccr[(dir * 16 + ho) * 64 + pp], ci = cci[(dir * 16 + ho) * 64 + pp];
              const float gr = cr * wr_ - ci * wi_, gi = cr * wi_ + ci * wr_;
              Wy[(size_t)(j * 16 + ho) * 1280 + 1024 + kp] = f2bf(comp == 0 ? gr : -gi); } }
        { const int kp = tid & 255, dir = kp >> 7, comp = (kp >> 6) & 1, pp = kp & 63; const int tb = dir == 0 ? 4 : 1; const float wr_ = pwr[tb * 64 + pp], wi_ = pwi[tb * 64 + pp];
          float f[8];
#pragma unroll
          for (int q = 0; q < 8; ++q) { const int hi = (tid >> 8) * 8 + q; const float br = bbr[(dir * 64 + pp) * 16 + hi], bi = bbi[(dir * 64 + pp) * 16 + hi];
              f[q] = comp == 0 ? (wr_ * br - wi_ * bi) : (wr_ * bi + wi_ * br); }
          u32x4 w; w.x = cvt_pk_bf16(f[0], f[1]); w.y = cvt_pk_bf16(f[2], f[3]); w.z = cvt_pk_bf16(f[4], f[5]); w.w = cvt_pk_bf16(f[6], f[7]);
          *(u32x4*)(Ws + (size_t)kp * 1024 + j * 16 + (tid >> 8) * 8) = w; }
        __syncthreads();
    }
}

__device__ __forceinline__ void ph_s5fill(const P& p, int tid, int blk, int G, int l0, int l1) {
    const float* KT = WSP(O_KT, float);
    for (int item = blk; item < (l1 - l0) * 16 * 64; item += G) {
        const int l = l0 + (item >> 10), g = (item >> 6) & 15, t = item & 63;
        bf16_t* Wy = WSP(O_WS5Y, bf16_t) + (size_t)(l * 16 + g) * 1024 * 1280;
        const float* kf = KT + (size_t)((l * 16 + g) * 2 + 0) * 64 * 256; const float* kr = KT + (size_t)((l * 16 + g) * 2 + 1) * 64 * 256;
        f32x4 va[4][2], vb[4][2];
#pragma unroll
        for (int r = 0; r < 4; ++r) { const int idx = r * NTHREADS + tid, ho = idx >> 7, k8 = idx & 127, sI = k8 >> 1, hi0 = (k8 & 1) * 8;
            const float* qa = kf + (size_t)max(t - sI, 0) * 256 + ho * 16 + hi0; const float* qb = kr + (size_t)max(sI - t, 0) * 256 + ho * 16 + hi0;
            va[r][0] = *(const f32x4*)qa; va[r][1] = *(const f32x4*)(qa + 4); vb[r][0] = *(const f32x4*)qb; vb[r][1] = *(const f32x4*)(qb + 4); }
#pragma unroll
        for (int r = 0; r < 4; ++r) { const int idx = r * NTHREADS + tid, ho = idx >> 7, k8 = idx & 127, sI = k8 >> 1, hi0 = (k8 & 1) * 8;
            const float fa = sI <= t ? 1.0f : 0.f, fb = sI >= t ? 1.0f : 0.f;
            f32x4 v0 = va[r][0] * fa + vb[r][0] * fb, v1 = va[r][1] * fa + vb[r][1] * fb;
            const float dd = sI == t ? p.in[15][(l * 16 + g) * 16 + ho] : 0.f; const int dpos = ho - hi0;
#pragma unroll
            for (int e = 0; e < 4; ++e) { v0[e] += (dpos == e) ? dd : 0.f; v1[e] += (dpos == e + 4) ? dd : 0.f; }
            u32x4 w; w.x = cvt_pk_bf16(v0[0], v0[1]); w.y = cvt_pk_bf16(v0[2], v0[3]); w.z = cvt_pk_bf16(v1[0], v1[1]); w.w = cvt_pk_bf16(v1[2], v1[3]);
            *(u32x4*)(Wy + (size_t)(t * 16 + ho) * 1280 + sI * 16 + hi0) = w; }
    }
}

__device__ __forceinline__ void ph_combine_norm(const P& p, int lsrc, int ldst, int lane, int wave, int blk, int G, bf16_t* xrdst) {
    const float* MOD = WSP(O_MOD, float);
    const bf16_t* Y = WSP(O_XS, bf16_t); const int* SLOT = WSP(O_SLOT, int); const float* GV = WSP(O_GV, float);
    bf16_t* H1 = WSP(O_H1, bf16_t);
    f32x4 gw[4], gfv[4], shv[4], scv[4]; int bcur = -1;
    if (ldst < NL) {
#pragma unroll
        for (int i = 0; i < 4; ++i) gw[i] = *(const f32x4*)(p.in[4] + ldst * 1024 + i * 256 + lane * 4); }
    for (int row = blk * 8 + wave; row < T; row += G * 8) {
        const int b = row >> 12;
        if (b != bcur) { bcur = b;
#pragma unroll
            for (int i = 0; i < 4; ++i) { const int c = i * 256 + lane * 4;
                if (lsrc >= 0) gfv[i] = *(const f32x4*)(MOD + (size_t)(lsrc * 4 + b) * 6144 + 5120 + c);
                if (ldst < NL) { shv[i] = *(const f32x4*)(MOD + (size_t)(ldst * 4 + b) * 6144 + c); scv[i] = *(const f32x4*)(MOD + (size_t)(ldst * 4 + b) * 6144 + 1024 + c) + 1.0f; } } }
        f32x4 x[4];
        if (lsrc < 0) {
#pragma unroll
            for (int i = 0; i < 4; ++i) x[i] = *(const f32x4*)(p.in[0] + (size_t)row * 1024 + i * 256 + lane * 4);
        } else { u32x2 xb[4];
#pragma unroll
            for (int i = 0; i < 4; ++i) xb[i] = *(const u32x2*)(WSP(O_XR, bf16_t) + (size_t)row * 1024 + i * 256 + lane * 4);
#pragma unroll
            for (int i = 0; i < 4; ++i) x[i] = bf4_to_f32(xb[i]); }
        if (lsrc >= 0) {
            f32x4 acc[4] = {{0.f, 0.f, 0.f, 0.f}, {0.f, 0.f, 0.f, 0.f}, {0.f, 0.f, 0.f, 0.f}, {0.f, 0.f, 0.f, 0.f}};
#pragma unroll
            for (int k = 0; k < 4; ++k) { const int slot = SLOT[row * 4 + k]; const float gk = GV[row * 4 + k]; const bf16_t* yr = Y + (size_t)slot * 1024;
#pragma unroll
                for (int i = 0; i < 4; ++i) { const u32x2 v = *(const u32x2*)(yr + i * 256 + lane * 4);
                    acc[i][0] += gk * __uint_as_float(v.x << 16); acc[i][1] += gk * __uint_as_float(v.x & 0xFFFF0000u); acc[i][2] += gk * __uint_as_float(v.y << 16); acc[i][3] += gk * __uint_as_float(v.y & 0xFFFF0000u); } }
#pragma unroll
            for (int i = 0; i < 4; ++i) x[i] = x[i] + gfv[i] * acc[i];
        }
        if (ldst < NL) {
#pragma unroll
            for (int i = 0; i < 4; ++i) { const u32x2 w = f32_to_bf4(x[i]); *(u32x2*)(xrdst + (size_t)row * 1024 + i * 256 + lane * 4) = w; x[i] = bf4_to_f32(w); }
        } else {
#pragma unroll
            for (int i = 0; i < 4; ++i) *(f32x4*)(p.out + (size_t)row * 1024 + i * 256 + lane * 4) = x[i];
        }
        if (ldst < NL) {
            float ss = 0.f;
#pragma unroll
            for (int i = 0; i < 4; ++i) ss += x[i][0] * x[i][0] + x[i][1] * x[i][1] + x[i][2] * x[i][2] + x[i][3] * x[i][3];
            ss = wave_sum_all(ss); const float rstd = rsqrtf(ss * (1.0f / 1024.0f) + 1e-6f);
#pragma unroll
            for (int i = 0; i < 4; ++i) { const int c = i * 256 + lane * 4;
                const f32x4 h = x[i] * rstd * gw[i] * scv[i] + shv[i];
                u32x2 w; w.x = cvt_pk_bf16(h[0], h[1]); w.y = cvt_pk_bf16(h[2], h[3]); *(u32x2*)(H1 + (size_t)row * 1024 + c) = w; }
        }
    }
}

__device__ __forceinline__ void ph_prepass(const P& p, int l, int lane, int wave, int blk, int G) {
    const bf16_t* PROJ = WSP(O_PROJ, bf16_t);
    bf16_t* ZS = WSP(O_ZS, bf16_t); bf16_t* QN = WSP(O_QN, bf16_t); bf16_t* KN = WSP(O_KN, bf16_t); bf16_t* AS5 = WSP(O_AS5, bf16_t);
    bf16_t* R = WSP(O_R, bf16_t); bf16_t* K = WSP(O_K, bf16_t); bf16_t* V = WSP(O_V, bf16_t); bf16_t* A = WSP(O_A, bf16_t); float* RKB = WSP(O_RKB, float);
    const float* mu = p.in[17] + l * 1536; const float* k_k = p.in[26] + l * 384; const float* r_k = p.in[28] + l * 384;
    const int r4 = lane >> 4, j4 = (lane & 15) * 4;
    const f32x4 qg = *(const f32x4*)(p.in[31] + l * 64 + j4), kg = *(const f32x4*)(p.in[32] + l * 64 + j4);
    const int c0 = r4 * 64 + j4, c1 = min(4 + r4, 5) * 64 + j4;
    f32x4 muv[2][4], kkv[2], rkv2[2];
#pragma unroll
    for (int pass = 0; pass < 2; ++pass) { const int c = pass ? c1 : c0;
#pragma unroll
        for (int part = 0; part < 4; ++part) muv[pass][part] = *(const f32x4*)(mu + part * 384 + c);
        kkv[pass] = *(const f32x4*)(k_k + c); rkv2[pass] = *(const f32x4*)(r_k + c); }
#pragma unroll 1
    for (int run = blk * 8 + wave; run < T / 8; run += G * 8) {
        const int base = run * 8, t0 = base & 4095;
        u32x2 rows[4][2][4], aux[2][5];
#define PP_ROW(slot, tk, valid) do { _Pragma("unroll") for (int part_ = 0; part_ < 4; ++part_) { const bf16_t* s0_ = PROJ + (size_t)(tk) * NPROJ + 256 + part_ * 384; \
            rows[slot][0][part_] = (valid) ? *(const u32x2*)(s0_ + c0) : (u32x2){0u, 0u}; rows[slot][1][part_] = (valid) ? *(const u32x2*)(s0_ + c1) : (u32x2){0u, 0u}; } } while (0)
#define PP_AUX(slot, tk) do { const bf16_t* s0_ = PROJ + (size_t)(tk) * NPROJ; aux[slot][0] = *(const u32x2*)(s0_ + lane * 4); aux[slot][1] = *(const u32x2*)(s0_ + 1792 + c0); aux[slot][2] = *(const u32x2*)(s0_ + 2176 + c0); \
            aux[slot][3] = *(const u32x2*)(s0_ + 1792 + c1); aux[slot][4] = *(const u32x2*)(s0_ + 2176 + c1); } while (0)
        PP_ROW(0, base - 1, t0 > 0); PP_ROW(1, base, true); PP_ROW(2, base + 1, true); PP_AUX(0, base);
#pragma unroll
        for (int it = 0; it < 8; ++it) {
            const int tok = base + it; const int sp = it & 3, sc = (it + 1) & 3, sn = (it + 2) & 3, snn = (it + 3) & 3;
            if (it < 7) { PP_ROW(snn, tok + 2, t0 + it + 2 <= 4095); PP_AUX((it + 1) & 1, tok + 1); }
            { const int g = lane >> 2, hi0 = (lane & 3) * 4; *(u32x2*)(AS5 + ((size_t)g * 256 + (tok >> 6)) * 1280 + (tok & 63) * 16 + hi0) = aux[it & 1][0]; }
#pragma unroll
            for (int pass = 0; pass < 2; ++pass) {
                const int hd_ = pass * 4 + r4; const bool act = hd_ < 6; const int hd = act ? hd_ : 5; const int c = hd * 64 + j4;
                f32x4 xs[4];
#pragma unroll
                for (int part = 0; part < 4; ++part) { const f32x4 cur = bf4_to_f32(rows[sc][pass][part]), pv = bf4_to_f32(rows[sp][pass][part]), nx = bf4_to_f32(rows[sn][pass][part]);
                    xs[part] = cur + ((pv + nx) * 0.5f - cur) * muv[pass][part]; }
                const f32x4 kr = xs[1] * kkv[pass];
                const float n2 = row16_sum(hsum4(kr * kr)); const float rk = row16_sum(hsum4(xs[0] * xs[1] * rkv2[pass]));
                const f32x4 qv = bf4_to_f32(aux[it & 1][1 + 2 * pass]), kv = bf4_to_f32(aux[it & 1][2 + 2 * pass]);
                const float mq = row16_sum(hsum4(qv * qv)) * (1.0f / 64.0f), mk = row16_sum(hsum4(kv * kv)) * (1.0f / 64.0f);
                if (act) { const size_t o = (size_t)tok * 384 + c;
                    *(u32x2*)(R + o) = f32_to_bf4(xs[0]); *(u32x2*)(K + o) = f32_to_bf4(xs[1]); *(u32x2*)(V + o) = f32_to_bf4(xs[2]); *(u32x2*)(ZS + o) = f32_to_bf4(xs[3]);
                    *(u32x2*)(A + o) = f32_to_bf4(kr * (-1.0f / fmaxf(sqrtf(n2), 1e-12f)));
                    if ((lane & 15) == 0) RKB[tok * 8 + hd] = rk;
                    *(u32x2*)(QN + o) = f32_to_bf4(qv * (rsqrtf(mq + 1e-6f) * 0.125f) * qg); *(u32x2*)(KN + o) = f32_to_bf4(kv * rsqrtf(mk + 1e-6f) * kg); }
            }
        }
#undef PP_ROW
#undef PP_AUX
    }
}

__device__ __forceinline__ void ph_na(const P& p, int l, unsigned char* lds, int tid, int lane, int wave, int blk, int G) {
    float* rpb = (float*)lds;
    unsigned char* vb = lds + 11264 + wave * 4608;
    { float rv[6];
#pragma unroll
      for (int k = 0; k < 6; ++k) { const int i = k * NTHREADS + tid; rv[k] = p.in[33][l * 2790 + (i < 2790 ? i : 0)]; }
#pragma unroll
      for (int k = 0; k < 6; ++k) { const int i = k * NTHREADS + tid; if (i < 2790) rpb[i] = rv[k]; } }
    __syncthreads();
    const bf16_t* QN = WSP(O_QN, bf16_t); const bf16_t* KN = WSP(O_KN, bf16_t); const bf16_t* PROJ = WSP(O_PROJ, bf16_t); bf16_t* MIX = WSP(O_MIX, bf16_t);
    const int q16 = lane & 15, g = lane >> 4;
    const unsigned vaddr = (unsigned)(size_t)(LAS unsigned char*)vb + (unsigned)((4 * g + (q16 >> 2)) * 144 + (q16 & 3) * 8);
    for (int unit = blk * 8 + wave; unit < 6144; unit += G * 8) {
        const int nb = unit & 3, r = (unit >> 2) & 63, bh = unit >> 8, h = bh % 6, b = bh / 6;
        const int rs = min(max(r - 4, 0), 56), kb0 = min(max(16 * nb - 8, 0), 32);
        const int tq = b * 4096 + r * 64 + 16 * nb + q16;
        const bf16x8 qf0 = *(const bf16x8*)(QN + (size_t)tq * 384 + h * 64 + 8 * g), qf1 = *(const bf16x8*)(QN + (size_t)tq * 384 + h * 64 + 32 + 8 * g);
        f32x4 s[16];
        bf16x8 kf[2][4][2];
#define NA_KLOAD(set, gi) do { _Pragma("unroll") for (int jj = 0; jj < 4; ++jj) { const int j_ = (gi) * 4 + jj; const int tk = b * 4096 + (rs + (j_ >> 1)) * 64 + kb0 + (j_ & 1) * 16 + q16; \
            const bf16_t* kp = KN + (size_t)tk * 384 + h * 64 + 8 * g; kf[set][jj][0] = *(const bf16x8*)kp; kf[set][jj][1] = *(const bf16x8*)(kp + 32); } } while (0)
        NA_KLOAD(0, 0);
        u32x4 vr[2][4];
#define NA_VLOAD(set, s2_) do { const int tv = b * 4096 + (rs + (s2_)) * 64 + kb0 + (lane >> 1); const bf16_t* vp = PROJ + (size_t)tv * NPROJ + 2560 + h * 64 + (lane & 1) * 32; \
            vr[set][0] = *(const u32x4*)vp; vr[set][1] = *(const u32x4*)(vp + 8); vr[set][2] = *(const u32x4*)(vp + 16); vr[set][3] = *(const u32x4*)(vp + 24); } while (0)
#pragma unroll
        for (int gi = 0; gi < 4; ++gi) {
            if (gi < 3) NA_KLOAD((gi + 1) & 1, gi + 1); else NA_VLOAD(0, 0);
#pragma unroll
            for (int jj = 0; jj < 4; ++jj) { f32x4 z = {0.f, 0.f, 0.f, 0.f};
                z = __builtin_amdgcn_mfma_f32_16x16x32_bf16(kf[gi & 1][jj][0], qf0, z, 0, 0, 0); z = __builtin_amdgcn_mfma_f32_16x16x32_bf16(kf[gi & 1][jj][1], qf1, z, 0, 0, 0); s[gi * 4 + jj] = z; }
            __builtin_amdgcn_sched_barrier(0); }
        const int qc = 16 * nb + q16, cst = min(max(qc - 8, 0), 48);
        float mx = -3.0e38f;
#pragma unroll
        for (int j = 0; j < 16; ++j)
#pragma unroll
            for (int i = 0; i < 4; ++i) { const int kc = kb0 + (j & 1) * 16 + 4 * g + i; const bool valid = (kc >= cst) && (kc < cst + 16);
                const int dy = rs + (j >> 1) - r + 7, dx = min(max(kc - qc + 15, 0), 30);
                const float v = valid ? s[j][i] + rpb[(h * 15 + dy) * 31 + dx] : -3.0e38f; s[j][i] = v; mx = fmaxf(mx, v); }
        { float a = mx, b = mx; swap16(a, b); mx = fmaxf(a, b); } { float a = mx, b = mx; swap32(a, b); mx = fmaxf(a, b); }
        float sum = 0.f;
#pragma unroll
        for (int j = 0; j < 16; ++j)
#pragma unroll
            for (int i = 0; i < 4; ++i) { const float e = __expf(s[j][i] - mx); s[j][i] = e; sum += e; }
        { float a = sum, b = sum; swap16(a, b); sum = a + b; } { float a = sum, b = sum; swap32(a, b); sum = a + b; }
        const float inv = 1.0f / sum;
        f32x4 o[4] = {{0.f, 0.f, 0.f, 0.f}, {0.f, 0.f, 0.f, 0.f}, {0.f, 0.f, 0.f, 0.f}, {0.f, 0.f, 0.f, 0.f}};
#pragma unroll
        for (int s2 = 0; s2 < 8; ++s2) {
            if (s2 < 7) NA_VLOAD((s2 + 1) & 1, s2 + 1);
            unsigned char* vw = vb + (lane >> 1) * 144 + (lane & 1) * 64;
            *(u32x4*)vw = vr[s2 & 1][0]; *(u32x4*)(vw + 16) = vr[s2 & 1][1]; *(u32x4*)(vw + 32) = vr[s2 & 1][2]; *(u32x4*)(vw + 48) = vr[s2 & 1][3];
            s16x4 lo[4], hi[4];
            asm volatile("s_waitcnt lgkmcnt(0)\n\t"
                         "ds_read_b64_tr_b16 %0, %8\n\tds_read_b64_tr_b16 %1, %8 offset:32\n\tds_read_b64_tr_b16 %2, %8 offset:64\n\tds_read_b64_tr_b16 %3, %8 offset:96\n\t"
                         "ds_read_b64_tr_b16 %4, %8 offset:2304\n\tds_read_b64_tr_b16 %5, %8 offset:2336\n\tds_read_b64_tr_b16 %6, %8 offset:2368\n\tds_read_b64_tr_b16 %7, %8 offset:2400\n\t"
                         "s_waitcnt lgkmcnt(0)"
                         : "=&v"(lo[0]), "=&v"(lo[1]), "=&v"(lo[2]), "=&v"(lo[3]), "=&v"(hi[0]), "=&v"(hi[1]), "=&v"(hi[2]), "=&v"(hi[3]) : "v"(vaddr) : "memory");
            bf16x8 pa;
            { const f32x4 a = s[2 * s2] * inv, c = s[2 * s2 + 1] * inv; u32x4 w; w.x = cvt_pk_bf16(a[0], a[1]); w.y = cvt_pk_bf16(a[2], a[3]); w.z = cvt_pk_bf16(c[0], c[1]); w.w = cvt_pk_bf16(c[2], c[3]); pa = __builtin_bit_cast(bf16x8, w); }
#pragma unroll
            for (int nt = 0; nt < 4; ++nt) { bf16x8 bfr; bfr[0] = lo[nt][0]; bfr[1] = lo[nt][1]; bfr[2] = lo[nt][2]; bfr[3] = lo[nt][3]; bfr[4] = hi[nt][0]; bfr[5] = hi[nt][1]; bfr[6] = hi[nt][2]; bfr[7] = hi[nt][3];
                o[nt] = __builtin_amdgcn_mfma_f32_16x16x32_bf16(pa, bfr, o[nt], 0, 0, 0); }
        }
#undef NA_KLOAD
#undef NA_VLOAD
#pragma unroll
        for (int nt = 0; nt < 4; ++nt)
#pragma unroll
            for (int i = 0; i < 4; ++i) MIX[(size_t)(b * 4096 + r * 64 + 16 * nb + 4 * g + i) * 1024 + 640 + h * 64 + 16 * nt + q16] = f2bf(o[nt][i]);
    }
    __syncthreads();
}

__device__ __forceinline__ void ph_s5carry(const P& p, int l, int tid, int blk) {
    if (blk >= 16) return;
    const int g = blk, b = tid >> 7, dir = (tid >> 6) & 1, pp = tid & 63;
    const int li = ((l * 2 + dir) * 16 + g) * 64 + pp;
    const float mr = WSP(O_S5M, float)[(size_t)li * 2], mi = WSP(O_S5M, float)[(size_t)li * 2 + 1];
    const float* SL = WSP(O_SLOC, float) + (size_t)g * 256 * 256; bf16_t* AS = WSP(O_AS5, bf16_t) + (size_t)g * 256 * 1280;
    float hr = 0.f, hi = 0.f;
#pragma unroll 1
    for (int c0 = 0; c0 < 64; c0 += 16) {
        float sr[16], si[16];
#pragma unroll
        for (int u = 0; u < 16; ++u) { const int cc = c0 + u, c = dir == 0 ? cc : 63 - cc, chunk = b * 64 + c;
            sr[u] = SL[(size_t)chunk * 256 + dir * 128 + pp]; si[u] = SL[(size_t)chunk * 256 + dir * 128 + 64 + pp]; }
#pragma unroll
        for (int u = 0; u < 16; ++u) { const int cc = c0 + u, c = dir == 0 ? cc : 63 - cc, chunk = b * 64 + c;
            AS[(size_t)chunk * 1280 + 1024 + dir * 128 + pp] = f2bf(hr); AS[(size_t)chunk * 1280 + 1024 + dir * 128 + 64 + pp] = f2bf(hi);
            const float nr = mr * hr - mi * hi + sr[u], ni = mr * hi + mi * hr + si[u]; hr = nr; hi = ni; }
    }
}

constexpr int XB = 8192;
#define XOFF(row, col) ((row) * 128 + (((((col) >> 3) ^ (((row) >> 1) & 7))) << 4) + ((col) & 7) * 2)
__device__ __forceinline__ void nt2(const LAS unsigned char* X, const LAS unsigned char* Y, int tm, int tn0, int m16, int g, f32x4 (&acc)[2]) {
    const int ra_ = 16 * tm + m16;
    const bf16x8 a0 = *(const LAS bf16x8*)(X + XOFF(ra_, 8 * g)), a1 = *(const LAS bf16x8*)(X + XOFF(ra_, 32 + 8 * g));
#pragma unroll
    for (int q = 0; q < 2; ++q) { const int rb_ = 16 * (tn0 + q) + m16;
        const bf16x8 b0 = *(const LAS bf16x8*)(Y + XOFF(rb_, 8 * g)), b1 = *(const LAS bf16x8*)(Y + XOFF(rb_, 32 + 8 * g));
        acc[q] = __builtin_amdgcn_mfma_f32_16x16x32_bf16(a0, b0, acc[q], 0, 0, 0); acc[q] = __builtin_amdgcn_mfma_f32_16x16x32_bf16(a1, b1, acc[q], 0, 0, 0); }
}
struct XF { bf16x8 a0, a1, b00, b01, b10, b11; };
__device__ __forceinline__ void xload(XF& f, const LAS unsigned char* X, const LAS unsigned char* Y, int tm, int tn0, int m16, int g) {
    const int ra_ = 16 * tm + m16, rb0_ = 16 * tn0 + m16, rb1_ = rb0_ + 16;
    f.a0 = *(const LAS bf16x8*)(X + XOFF(ra_, 8 * g)); f.a1 = *(const LAS bf16x8*)(X + XOFF(ra_, 32 + 8 * g));
    f.b00 = *(const LAS bf16x8*)(Y + XOFF(rb0_, 8 * g)); f.b01 = *(const LAS bf16x8*)(Y + XOFF(rb0_, 32 + 8 * g));
    f.b10 = *(const LAS bf16x8*)(Y + XOFF(rb1_, 8 * g)); f.b11 = *(const LAS bf16x8*)(Y + XOFF(rb1_, 32 + 8 * g)); }
__device__ __forceinline__ void xmma(const XF& f, f32x4 (&acc)[2]) {
    acc[0] = __builtin_amdgcn_mfma_f32_16x16x32_bf16(f.a0, f.b00, (f32x4){0.f, 0.f, 0.f, 0.f}, 0, 0, 0); acc[1] = __builtin_amdgcn_mfma_f32_16x16x32_bf16(f.a0, f.b10, (f32x4){0.f, 0.f, 0.f, 0.f}, 0, 0, 0);
    acc[0] = __builtin_amdgcn_mfma_f32_16x16x32_bf16(f.a1, f.b01, acc[0], 0, 0, 0); acc[1] = __builtin_amdgcn_mfma_f32_16x16x32_bf16(f.a1, f.b11, acc[1], 0, 0, 0); }
#define X1_L(f, Xb, Yb) xload(f, BUF(Yb), BUF(Xb), tm, tn0, m16, g)
#define X1_M(f, acc) xmma(f, acc)
#define X1_PROD(Xb, Yb) do { acc[0] = (f32x4){0.f, 0.f, 0.f, 0.f}; acc[1] = (f32x4){0.f, 0.f, 0.f, 0.f}; nt2(BUF(Yb), BUF(Xb), tm, tn0, m16, g, acc); } while (0)
#define X1_Q(q, mrow) _Pragma("unroll") for (int q = 0; q < 2; ++q) { const int mrow = 16 * (tn0 + q) + m16; (void)mrow;
#define X1_END }
#define X1_ST4(buf, mrow, v4) (*(LAS u32x2*)(BUF(buf) + XOFF(mrow, nc0)) = f32_to_bf4(v4))
#define X1_LD4(buf, mrow) bf4_to_f32(*(const LAS u32x2*)(BUF(buf) + XOFF(mrow, nc0)))
__device__ __forceinline__ void ph_x1(const P& p, unsigned char* lds_, int tid, int lane, int wave, int ublk, int ustride, int u0, int u1) {
    LAS unsigned char* LB = (LAS unsigned char*)lds_;
#define BUF(i) (LB + (i) * XB)
    LAS float* Gm = (LAS float*)BUF(8);
    LAS float* gC = (LAS float*)(LB + LDS_X);
    const int m16 = lane & 15, g = lane >> 4, tm = wave >> 1, tn0 = (wave & 1) * 2, nc0 = 16 * tm + 4 * g;
    const int half = tid >> 8, s0 = ((tid & 255) >> 4) * 4, j4 = (tid & 15) * 4;
    u32x2 inr[3][4];
#define X1_LOAD(unit) do { const int ch_ = (unit) >> 6, c_ = (unit) & 63, b_ = ch_ / 12, h_ = (ch_ % 12) >> 1, dir_ = ch_ & 1; \
        const bf16_t* f0_ = half ? WSP(O_KD, bf16_t) + (size_t)dir_ * T * 384 : WSP(O_A, bf16_t); const bf16_t* f2_ = half ? WSP(O_V, bf16_t) : WSP(O_BV, bf16_t) + (size_t)dir_ * T * 384; const bf16_t* f1_ = half ? WSP(O_R, bf16_t) : WSP(O_DEC, bf16_t) + (size_t)dir_ * T * 384; \
        _Pragma("unroll") for (int r_ = 0; r_ < 4; ++r_) { const int t_ = dir_ ? (4095 - (64 * c_ + s0 + r_)) : (64 * c_ + s0 + r_); const size_t o_ = (size_t)(b_ * 4096 + t_) * 384 + h_ * 64 + j4; \
            inr[0][r_] = *(const u32x2*)(f0_ + o_); inr[2][r_] = *(const u32x2*)(f2_ + o_); inr[1][r_] = *(const u32x2*)(f1_ + o_); } } while (0)
    int unit = u0 + ublk;
    if (unit < u1) X1_LOAD(unit);
#pragma unroll 1
    for (; unit < u1; unit += ustride) {
        if (half == 0) {
#pragma unroll
            for (int r = 0; r < 4; ++r) *(LAS f32x4*)(Gm + (s0 + r) * 68 + j4) = h4_to_f32(inr[1][r]); }
        LDS_BARRIER();
        { const int jch = tid & 63, seg = tid >> 6; LAS float* segT = (LAS float*)BUF(11);
          float gv[8];
#pragma unroll
          for (int u = 0; u < 8; ++u) gv[u] = Gm[(seg * 8 + u) * 68 + jch];
#pragma unroll
          for (int u = 1; u < 8; ++u) gv[u] = gv[u] * gv[u - 1];
          segT[seg * 64 + jch] = gv[7];
          LDS_BARRIER();
          float pre = 1.0f;
#pragma unroll
          for (int u = 0; u < 7; ++u) { const float tv = segT[u * 64 + jch]; if (u < seg) pre *= tv; }
#pragma unroll
          for (int u = 0; u < 8; ++u) Gm[(seg * 8 + u) * 68 + jch] = gv[u] * pre;
          if (seg == 7) gC[jch] = gv[7] * pre; }
        LDS_BARRIER();
        { f32x4 gg[4], gp;
#pragma unroll
          for (int r = 0; r < 4; ++r) gg[r] = *(const LAS f32x4*)(Gm + (s0 + r) * 68 + j4);
          gp = s0 > 0 ? *(const LAS f32x4*)(Gm + (s0 - 1) * 68 + j4) : (f32x4){1.f, 1.f, 1.f, 1.f};
          f32x4 m0[4], m2[4], m1[4];
#pragma unroll
          for (int r = 0; r < 4; ++r) { f32x4 gi; gi[0] = frcp(gg[r][0]); gi[1] = frcp(gg[r][1]); gi[2] = frcp(gg[r][2]); gi[3] = frcp(gg[r][3]);
              const f32x4 i0 = bf4_to_f32(inr[0][r]), i2 = bf4_to_f32(inr[2][r]);
              if (half == 0) { m0[r] = i0 * (r == 0 ? gp : gg[r - 1]); m2[r] = i2 * gi; m1[r] = m0[r]; }
              else { m0[r] = i0 * gi; m1[r] = bf4_to_f32(inr[1][r]) * gg[r]; m2[r] = i2; } }
          const int bA = half ? 2 : 0, bAT = half ? 6 : 4;
#pragma unroll
          for (int r = 0; r < 4; ++r) *(LAS u32x2*)(BUF(bA) + XOFF(s0 + r, j4)) = f32_to_bf4(m0[r]);
#pragma unroll
          for (int q = 0; q < 4; ++q) *(LAS u32x2*)(BUF(bAT) + XOFF(j4 + q, s0)) = f32_to_bf4((f32x4){m0[0][q], m0[1][q], m0[2][q], m0[3][q]});
          if (half == 0) {
#pragma unroll
              for (int r = 0; r < 4; ++r) *(LAS u32x2*)(BUF(1) + XOFF(s0 + r, j4)) = f32_to_bf4(m2[r]);
#pragma unroll
              for (int q = 0; q < 4; ++q) *(LAS u32x2*)(BUF(5) + XOFF(j4 + q, s0)) = f32_to_bf4((f32x4){m2[0][q], m2[1][q], m2[2][q], m2[3][q]});
          } else {
#pragma unroll
              for (int r = 0; r < 4; ++r) *(LAS u32x2*)(BUF(3) + XOFF(s0 + r, j4)) = f32_to_bf4(m1[r]);
#pragma unroll
              for (int q = 0; q < 4; ++q) *(LAS u32x2*)(BUF(7) + XOFF(j4 + q, s0)) = f32_to_bf4((f32x4){m2[0][q], m2[1][q], m2[2][q], m2[3][q]});
          } }
        LDS_BARRIER();
        { const int un = unit + ustride; if (un < u1) X1_LOAD(un); }
        XF fa, fb, fc, fd; f32x4 acc[2], acb[2], acd[2], ace[2];
        X1_L(fa, 0, 1); X1_L(fb, 1, 0); X1_L(fc, 2, 0);
        X1_M(fa, acc); X1_M(fb, acb); X1_M(fc, acd);
        X1_L(fa, 3, 1); X1_L(fb, 3, 2);
        X1_Q(q, mrow) f32x4 v, w, vt, vk;
#pragma unroll
            for (int i = 0; i < 4; ++i) { v[i] = (nc0 + i) < mrow ? acc[q][i] : 0.f; w[i] = v[i] + ((nc0 + i) == mrow ? 1.0f : 0.f); vt[i] = mrow < (nc0 + i) ? acb[q][i] : 0.f; vk[i] = mrow < (nc0 + i) ? acd[q][i] : 0.f; }
            X1_ST4(8, mrow, v); X1_ST4(13, mrow, w); X1_ST4(9, mrow, vt); X1_ST4(10, mrow, vk); X1_END
        X1_M(fa, acc); X1_M(fb, acb);
        X1_Q(q, mrow) f32x4 v, w;
#pragma unroll
            for (int i = 0; i < 4; ++i) { v[i] = (nc0 + i) <= mrow ? acc[q][i] : 0.f; w[i] = (nc0 + i) <= mrow ? acb[q][i] : 0.f; }
            X1_ST4(11, mrow, v); X1_ST4(12, mrow, w); X1_END
        LDS_BARRIER();
#define X1_DSTAGE(pi, pti, po, pto, wantP, li, lpt, lo, hasL) do { \
            if (wantP) X1_L(fa, pi, pti); X1_L(fb, pti, pi); if (hasL) X1_L(fc, li, lpt); \
            f32x4 lold[2]; if (hasL) { X1_Q(q, mrow) lold[q] = X1_LD4(li, mrow); X1_END } \
            if (wantP) X1_M(fa, acc); X1_M(fb, acb); if (hasL) X1_M(fc, acd); \
            X1_Q(q, mrow) if (wantP) X1_ST4(po, mrow, acc[q]); X1_ST4(pto, mrow, acb[q]); if (hasL) X1_ST4(lo, mrow, acd[q] + lold[q]); X1_END } while (0)
        X1_DSTAGE(8, 9, 0, 1, true, 0, 0, 0, false); LDS_BARRIER();
        X1_DSTAGE(0, 1, 8, 9, true, 13, 1, 2, true); LDS_BARRIER();
        X1_DSTAGE(8, 9, 0, 1, true, 2, 9, 13, true); LDS_BARRIER();
        X1_DSTAGE(0, 1, 8, 9, true, 13, 1, 2, true); LDS_BARRIER();
        X1_DSTAGE(8, 9, 0, 1, false, 2, 9, 13, true); LDS_BARRIER();
        { X1_L(fc, 13, 1); f32x4 lold[2]; X1_Q(q, mrow) lold[q] = X1_LD4(13, mrow); X1_END X1_M(fc, acd); X1_Q(q, mrow) X1_ST4(2, mrow, acd[q] + lold[q]); X1_END }
        LDS_BARRIER();
        X1_L(fa, 4, 2); X1_L(fb, 10, 2); X1_M(fa, acc); X1_M(fb, acb);
        X1_Q(q, mrow) X1_ST4(8, mrow, acc[q]); X1_ST4(9, mrow, acb[q]); X1_END
        LDS_BARRIER();
        const int udir = (unit >> 6) & 1;
        { bf16_t* PHI = WSP(O_PHI, bf16_t) + (size_t)unit * 4096; bf16_t* GMo = WSP(O_GM, bf16_t) + (size_t)unit * 4096;
          X1_L(fa, 5, 8); X1_L(fb, 5, 9); X1_L(fc, 11, 8); X1_L(fd, 11, 9);
          f32x4 ek[2], gr[2], hk[2];
          X1_Q(q, mrow) ek[q] = X1_LD4(6, mrow); gr[q] = X1_LD4(3, mrow); hk[q] = X1_LD4(12, mrow); X1_END
          X1_M(fa, acc); X1_M(fb, acb); X1_M(fc, acd); X1_M(fd, ace);
          X1_Q(q, mrow) f32x4 v; const float gc = gC[mrow];
#pragma unroll
              for (int i = 0; i < 4; ++i) v[i] = gc * (acc[q][i] + ((nc0 + i) == mrow ? 1.0f : 0.f));
              *(u32x2*)(PHI + mrow * 64 + nc0) = f32_to_bf4(v);
              X1_ST4(0, mrow, acb[q] + ek[q]);
              *(u32x2*)(GMo + (udir ? 63 - mrow : mrow) * 64 + nc0) = f32_to_bf4(acd[q] + gr[q]);
              X1_ST4(1, mrow, ace[q] + hk[q]); X1_END }
        LDS_BARRIER();
        { float* PSIT = WSP(O_PSIT, float) + (size_t)unit * 4096; bf16_t* YLT = WSP(O_YLT, bf16_t) + (size_t)unit * 4096;
          const f32x4 gc4 = *(const LAS f32x4*)(gC + nc0);
          X1_L(fa, 7, 0); X1_L(fb, 1, 7); X1_M(fa, acc); X1_M(fb, acb);
          X1_Q(q, mrow) *(f32x4*)(PSIT + mrow * 64 + nc0) = acc[q] * gc4;
              *(u32x2*)(YLT + (udir ? 63 - mrow : mrow) * 64 + nc0) = f32_to_bf4(acb[q]); X1_END }
    }
#undef BUF
#undef X1_LOAD
#undef X1_DSTAGE
}
__device__ __forceinline__ void ph_x2a(const P& p, LAS unsigned char* lds, int tid, int lane, int wave, int blk) {
    if (blk >= 48) return;
    constexpr int SLOT = 24576, NSLOT = 5;
    const int ch = blk;
    const char* PHI = (const char*)(WSP(O_PHI, bf16_t) + (size_t)ch * 64 * 4096); const char* PSIT = (const char*)(WSP(O_PSIT, float) + (size_t)ch * 64 * 4096);
    if (wave >= 4) {
        const int lw = wave - 4;
        unsigned so[6];
#pragma unroll
        for (int q = 0; q < 6; ++q) { const int piece = lw + 4 * q;
            if (piece < 8) { const int row = piece * 8 + (lane >> 3), cp = lane & 7; so[q] = (unsigned)(row * 128 + ((cp ^ (row & 7)) << 4)); }
            else { const int row = (piece - 8) * 4 + (lane >> 4), cp = lane & 15; so[q] = (unsigned)(row * 256 + ((cp ^ (row & 15)) << 4)); } }
#define X2A_ISSUE(c) do { const int cc_ = (c) < 64 ? (c) : 63; const int sl_ = (c) % NSLOT; \
        _Pragma("unroll") for (int q = 0; q < 6; ++q) { const int piece = lw + 4 * q; \
            const char* src_ = piece < 8 ? PHI + (size_t)cc_ * 8192 + so[q] : PSIT + (size_t)cc_ * 16384 + so[q]; \
            __builtin_amdgcn_global_load_lds((const unsigned*)src_, (LAS unsigned*)(lds + sl_ * SLOT + piece * 1024), 16, 0, 0); } } while (0)
        X2A_ISSUE(0); X2A_ISSUE(1); X2A_ISSUE(2); X2A_ISSUE(3);
        asm volatile("s_waitcnt vmcnt(18)" ::: "memory");
        __builtin_amdgcn_s_barrier(); asm volatile("" ::: "memory");
#pragma unroll 1
        for (int c = 0; c < 64; ++c) {
            X2A_ISSUE(c + 4);
            asm volatile("s_waitcnt vmcnt(18)" ::: "memory");
            __builtin_amdgcn_s_barrier(); asm volatile("" ::: "memory");
        }
        asm volatile("s_waitcnt vmcnt(0)" ::: "memory");
#undef X2A_ISSUE
    } else {
        const int vt = wave, m16 = lane & 15, g = lane >> 4;
        u32x4* SB = (u32x4*)(p.ws + O_SB) + (size_t)ch * 64 * 512 + vt * 128 + lane;
        f32x4 D[4] = {{0.f, 0.f, 0.f, 0.f}, {0.f, 0.f, 0.f, 0.f}, {0.f, 0.f, 0.f, 0.f}, {0.f, 0.f, 0.f, 0.f}};
        __builtin_amdgcn_s_barrier(); asm volatile("" ::: "memory");
#pragma unroll 1
        for (int c = 0; c < 64; ++c) {
            const LAS unsigned char* sl = lds + (c % NSLOT) * SLOT;
            bf16x8 bk[2];
#pragma unroll
            for (int ks = 0; ks < 2; ++ks) { u32x4 w; w.x = cvt_pk_bf16(D[2 * ks][0], D[2 * ks][1]); w.y = cvt_pk_bf16(D[2 * ks][2], D[2 * ks][3]); w.z = cvt_pk_bf16(D[2 * ks + 1][0], D[2 * ks + 1][1]); w.w = cvt_pk_bf16(D[2 * ks + 1][2], D[2 * ks + 1][3]);
                bk[ks] = __builtin_bit_cast(bf16x8, w); SB[(size_t)c * 512 + ks * 64] = w; }
#pragma unroll
            for (int tj = 0; tj < 4; ++tj) { const int row = 16 * tj + m16, rx = row & 7;
                u32x2 f[2][2];
#pragma unroll
                for (int ks = 0; ks < 2; ++ks)
#pragma unroll
                    for (int hh = 0; hh < 2; ++hh) { const int o = 64 * ks + 8 * g + 32 * hh; f[ks][hh] = *(const LAS u32x2*)(sl + row * 128 + (((o >> 4) ^ rx) << 4) + (o & 15)); }
                const int prow = 16 * vt + m16; const int pc = 4 * tj + g;
                f32x4 z = *(const LAS f32x4*)(sl + 8192 + prow * 256 + ((pc ^ (prow & 15)) << 4));
                u32x4 a0; a0.x = f[0][0].x; a0.y = f[0][0].y; a0.z = f[0][1].x; a0.w = f[0][1].y;
                u32x4 a1; a1.x = f[1][0].x; a1.y = f[1][0].y; a1.z = f[1][1].x; a1.w = f[1][1].y;
                z = __builtin_amdgcn_mfma_f32_16x16x32_bf16(__builtin_bit_cast(bf16x8, a0), bk[0], z, 0, 0, 0); z = __builtin_amdgcn_mfma_f32_16x16x32_bf16(__builtin_bit_cast(bf16x8, a1), bk[1], z, 0, 0, 0); D[tj] = z; }
            asm volatile("s_waitcnt lgkmcnt(0)" ::: "memory");
            __builtin_amdgcn_s_barrier(); asm volatile("" ::: "memory");
        }
    }
}
__device__ __forceinline__ void ph_x2b_post(const P& p, int l, LAS unsigned char* lds, int lane, int wave, int blk, int G) {
    (void)lds;
    const int m16 = lane & 15, g = lane >> 4;
    const bf16_t* V = WSP(O_V, bf16_t); const bf16_t* GATE = WSP(O_GATE, bf16_t); const float* RKB = WSP(O_RKB, float); bf16_t* MIX = WSP(O_MIX, bf16_t);
#pragma unroll 1
    for (int task = blk * 8 + wave; task < 6144; task += G * 8) {
        const int tt = task & 3, c = (task >> 2) & 63, bh = task >> 8, b = bh / 6, h = bh % 6; const int tok = b * 4096 + 64 * c + 16 * tt + m16;
        u32x2 gm[2][4]; u32x4 sb[2][8]; u32x2 yl[2][4];
#pragma unroll
        for (int dir = 0; dir < 2; ++dir) {
            const int unit = ((b * 6 + h) * 2 + dir) * 64 + (dir ? 63 - c : c);
            const bf16_t* GMi = WSP(O_GM, bf16_t) + (size_t)unit * 4096 + (16 * tt + m16) * 64 + 4 * g; const bf16_t* YL = WSP(O_YLT, bf16_t) + (size_t)unit * 4096 + (16 * tt + m16) * 64 + 4 * g;
            const u32x4* SB = (const u32x4*)(p.ws + O_SB) + (size_t)unit * 512 + lane;
#pragma unroll
            for (int k = 0; k < 4; ++k) gm[dir][k] = *(const u32x2*)(GMi + 16 * k);
#pragma unroll
            for (int k = 0; k < 8; ++k) sb[dir][k] = SB[k * 64];
#pragma unroll
            for (int vt = 0; vt < 4; ++vt) yl[dir][vt] = *(const u32x2*)(YL + 16 * vt);
        }
        u32x2 vin[4], gin[4]; f32x4 lw[4], lb[4];
#pragma unroll
        for (int vt = 0; vt < 4; ++vt) { const size_t o = (size_t)tok * 384 + h * 64 + 16 * vt + 4 * g; vin[vt] = *(const u32x2*)(V + o); gin[vt] = *(const u32x2*)(GATE + o);
            lw[vt] = *(const f32x4*)(p.in[29] + l * 384 + h * 64 + 16 * vt + 4 * g); lb[vt] = *(const f32x4*)(p.in[30] + l * 384 + h * 64 + 16 * vt + 4 * g); }
        const float rkv = RKB[tok * 8 + h];
        f32x4 yy[4]; float s = 0.f;
#pragma unroll
        for (int vt = 0; vt < 4; ++vt) { f32x4 z = bf4_to_f32(yl[0][vt]) + bf4_to_f32(yl[1][vt]);
#pragma unroll
            for (int dir = 0; dir < 2; ++dir) {
                u32x4 g0; g0.x = gm[dir][0].x; g0.y = gm[dir][0].y; g0.z = gm[dir][1].x; g0.w = gm[dir][1].y; u32x4 g1; g1.x = gm[dir][2].x; g1.y = gm[dir][2].y; g1.z = gm[dir][3].x; g1.w = gm[dir][3].y;
                z = __builtin_amdgcn_mfma_f32_16x16x32_bf16(__builtin_bit_cast(bf16x8, sb[dir][2 * vt]), __builtin_bit_cast(bf16x8, g0), z, 0, 0, 0);
                z = __builtin_amdgcn_mfma_f32_16x16x32_bf16(__builtin_bit_cast(bf16x8, sb[dir][2 * vt + 1]), __builtin_bit_cast(bf16x8, g1), z, 0, 0, 0); }
            yy[vt] = z; s += hsum4(z); }
        s += xchg16(s, lane); s += xchg32(s, lane);
        const float mean = s * (1.0f / 64.0f); float q = 0.f;
#pragma unroll
        for (int vt = 0; vt < 4; ++vt) { yy[vt] = yy[vt] - mean; q += hsum4(yy[vt] * yy[vt]); }
        q += xchg16(q, lane); q += xchg32(q, lane);
        const float rstd = rsqrtf(q * (1.0f / 64.0f) + 64e-5f);
#pragma unroll
        for (int vt = 0; vt < 4; ++vt) { const f32x4 vv = bf4_to_f32(vin[vt]), gg = bf4_to_f32(gin[vt]);
            const f32x4 out = (yy[vt] * rstd * lw[vt] + lb[vt] + rkv * vv) * gg;
            *(u32x2*)(MIX + (size_t)tok * 1024 + 256 + h * 64 + 16 * vt + 4 * g) = f32_to_bf4(out); }
    }
}

__device__ __forceinline__ void ph_router(const P& p, int l, unsigned char* lds, int tid, int lane, int wave, int blk, int G, int cnt_off) {
    constexpr int WTS = 1028;
    float* WT = (float*)lds;
    constexpr int RM = LDS_X + 512;
    int* sel = (int*)(lds + RM);
    float* gat = (float*)(lds + RM + 1024);
    int* lpos = (int*)(lds + RM + 2048);
    float* rstd_s = (float*)(lds + RM + 3072);
    int* lcnt = (int*)(lds + RM + 3328);
    int* gbase = (int*)(lds + RM + 3456);
    float* bpart = (float*)(lds + RM + 12288);
    const float* rw = p.in[34] + (size_t)l * 1024 * 32;
    const float* MOD = WSP(O_MOD, float);
    unsigned* CNT = WSP(O_CTL, unsigned) + CW_CNT + l * 64 + cnt_off;
    bf16_t* XS = WSP(O_XS, bf16_t); int* SLOT = WSP(O_SLOT, int); float* GV = WSP(O_GV, float); int* TOKT = WSP(O_YS, int);
    float* lgt = (float*)(lds + RM + 4096);
    const int m16 = lane & 15, kq = lane >> 4, ttile = wave >> 1, etile = wave & 1;
    int fb = -1;
    for (int item = blk; item < T / 64; item += G) {
        const int b = item >> 6;
        const float* m = MOD + (size_t)(l * 4 + b) * 6144;
        if (b != fb) {
            if (fb >= 0) __syncthreads();
            fb = b;
            float bs[4] = {0.f, 0.f, 0.f, 0.f};
#pragma unroll 1
            for (int i0 = 0; i0 < 16; i0 += 8) {
                f32x4 v[8]; float g2v[8], scv[8], shv[8];
#pragma unroll
                for (int i = 0; i < 8; ++i) { const int idx4 = (i0 + i) * NTHREADS + tid, d = idx4 >> 3, e4 = (idx4 & 7) * 4; v[i] = *(const f32x4*)(rw + d * 32 + e4);
                    g2v[i] = p.in[5][l * 1024 + d]; scv[i] = m[4096 + d]; shv[i] = m[3072 + d]; }
#pragma unroll
                for (int i = 0; i < 8; ++i) { const int idx4 = (i0 + i) * NTHREADS + tid, d = idx4 >> 3, e4 = (idx4 & 7) * 4; const float gm = g2v[i] * (scv[i] + 1.0f), sh = shv[i];
                    WT[(e4 + 0) * WTS + d] = v[i][0] * gm; WT[(e4 + 1) * WTS + d] = v[i][1] * gm; WT[(e4 + 2) * WTS + d] = v[i][2] * gm; WT[(e4 + 3) * WTS + d] = v[i][3] * gm;
                    bs[0] += sh * v[i][0]; bs[1] += sh * v[i][1]; bs[2] += sh * v[i][2]; bs[3] += sh * v[i][3]; } }
#pragma unroll
            for (int j = 0; j < 4; ++j) { float s = dpp_add<0x128>(bs[j]); s += xchg16(s, lane); s += xchg32(s, lane); bs[j] = s; }
            if (lane < 8) { bpart[wave * 32 + lane * 4 + 0] = bs[0]; bpart[wave * 32 + lane * 4 + 1] = bs[1]; bpart[wave * 32 + lane * 4 + 2] = bs[2]; bpart[wave * 32 + lane * 4 + 3] = bs[3]; }
        }
        if (tid < 32) lcnt[tid] = 0;
        __syncthreads();
        { const int tl = ttile * 16 + m16, row = item * 64 + tl;
          const bf16_t* xr = WSP(O_XR, bf16_t) + (size_t)row * 1024 + kq * 256; const float* wt = WT + (etile * 16 + m16) * WTS + kq * 256;
          f32x4 acc = {0.f, 0.f, 0.f, 0.f}, acc1 = {0.f, 0.f, 0.f, 0.f}; float ss = 0.f;
          u32x2 xa[8], xb[8];
#define RT_LOAD(buf, j0) do { _Pragma("unroll") for (int u_ = 0; u_ < 8; ++u_) buf[u_] = *(const u32x2*)(xr + 4 * ((j0) + u_)); } while (0)
#define RT_MMA(buf, j0) do { _Pragma("unroll") for (int u_ = 0; u_ < 8; ++u_) { const f32x4 xv = bf4_to_f32(buf[u_]); const f32x4 wv = *(const f32x4*)(wt + 4 * ((j0) + u_)); \
              ss += xv[0] * xv[0] + xv[1] * xv[1] + xv[2] * xv[2] + xv[3] * xv[3]; \
              acc = __builtin_amdgcn_mfma_f32_16x16x4f32(xv[0], wv[0], acc, 0, 0, 0); acc1 = __builtin_amdgcn_mfma_f32_16x16x4f32(xv[1], wv[1], acc1, 0, 0, 0); \
              acc = __builtin_amdgcn_mfma_f32_16x16x4f32(xv[2], wv[2], acc, 0, 0, 0); acc1 = __builtin_amdgcn_mfma_f32_16x16x4f32(xv[3], wv[3], acc1, 0, 0, 0); } } while (0)
          RT_LOAD(xa, 0); RT_LOAD(xb, 8);
#pragma unroll
          for (int jb = 0; jb < 64; jb += 16) {
              RT_MMA(xa, jb); __builtin_amdgcn_sched_barrier(0); if (jb + 16 < 64) RT_LOAD(xa, jb + 16); __builtin_amdgcn_sched_barrier(0);
              RT_MMA(xb, jb + 8); __builtin_amdgcn_sched_barrier(0); if (jb + 24 < 64) RT_LOAD(xb, jb + 24); __builtin_amdgcn_sched_barrier(0); }
#undef RT_LOAD
#undef RT_MMA
          acc = acc + acc1;
          ss += xchg16(ss, lane); ss += xchg32(ss, lane);
          if (etile == 0 && kq == 0) rstd_s[tl] = rsqrtf(ss * (1.0f / 1024.0f) + 1e-6f);
#pragma unroll
          for (int i = 0; i < 4; ++i) lgt[(ttile * 16 + 4 * kq + i) * 32 + etile * 16 + m16] = acc[i]; }
        __syncthreads();
        { const int me = lane >> 1; float rbias = p.in[35][l * 32 + me];
#pragma unroll
          for (int w = 0; w < 8; ++w) rbias += bpart[w * 32 + me];
#pragma unroll 1
          for (int it = 0; it < 8; ++it) {
            const int tl = wave * 8 + it;
            float val = lgt[tl * 32 + me] * rstd_s[tl] + rbias;
            float tv[4]; int te[4];
#pragma unroll
            for (int k = 0; k < 4; ++k) { const float mxv = wave_max_all(val); const int idx = wave_min_all(val == mxv ? me : 64); tv[k] = mxv; te[k] = idx; if (me == idx) val = -3.0e38f; }
            const float e1 = __expf(tv[1] - tv[0]), e2 = __expf(tv[2] - tv[0]), e3 = __expf(tv[3] - tv[0]); const float inv = 1.0f / (1.0f + e1 + e2 + e3);
            if (lane == 0) {
                const float gg[4] = {inv, e1 * inv, e2 * inv, e3 * inv};
#pragma unroll
                for (int k = 0; k < 4; ++k) { sel[tl * 4 + k] = te[k]; gat[tl * 4 + k] = gg[k]; lpos[tl * 4 + k] = atomicAdd(&lcnt[te[k]], 1); } }
          } }
        __syncthreads();
        if (tid < 32) gbase[tid] = (int)__hip_atomic_fetch_add(CNT + tid, (unsigned)lcnt[tid], __ATOMIC_RELAXED, __HIP_MEMORY_SCOPE_AGENT);
        __syncthreads();
        { f32x4 gmv[4], shv[4], scv_[4];
#pragma unroll
          for (int i = 0; i < 4; ++i) { const int c = i * 256 + lane * 4; gmv[i] = *(const f32x4*)(p.in[5] + l * 1024 + c); scv_[i] = *(const f32x4*)(m + 4096 + c); shv[i] = *(const f32x4*)(m + 3072 + c); }
#pragma unroll
          for (int i = 0; i < 4; ++i) gmv[i] = gmv[i] * (scv_[i] + 1.0f);
#pragma unroll 1
          for (int it0 = 0; it0 < 8; it0 += 4) {
            u32x2 xrow[4][4];
#pragma unroll
            for (int u = 0; u < 4; ++u)
#pragma unroll
                for (int i = 0; i < 4; ++i) xrow[u][i] = *(const u32x2*)(WSP(O_XR, bf16_t) + (size_t)(item * 64 + wave * 8 + it0 + u) * 1024 + i * 256 + lane * 4);
#pragma unroll
          for (int u = 0; u < 4; ++u) { const int it = it0 + u;
            const int tl = wave * 8 + it, row = item * 64 + tl; const float rstd = rstd_s[tl];
            u32x2 w[4];
#pragma unroll
            for (int i = 0; i < 4; ++i) { const f32x4 x = bf4_to_f32(xrow[u][i]);
                const f32x4 hh = x * rstd * gmv[i] + shv[i];
                w[i].x = cvt_pk_bf16(hh[0], hh[1]); w[i].y = cvt_pk_bf16(hh[2], hh[3]); }
#pragma unroll
            for (int i = 0; i < 4; ++i) *(u32x2*)(XS + (size_t)row * 1024 + i * 256 + lane * 4) = w[i];
            if (lane < 4) { const int k = lane; const int e = sel[tl * 4 + k]; const int slot = e * CAP + gbase[e] + lpos[tl * 4 + k];
                SLOT[row * 4 + k] = slot; GV[row * 4 + k] = gat[tl * 4 + k]; TOKT[slot] = row; }
          } } }
        __syncthreads();
    }
}


#if defined(__HIP_DEVICE_COMPILE__)
typedef const __attribute__((address_space(4))) P* KargPtr;
__device__ __forceinline__ P load_params() { KargPtr kp = (KargPtr)__builtin_amdgcn_kernarg_segment_ptr(); asm volatile("" : "+s"(kp)); P r;
    for (int i = 0; i < 40; ++i) r.in[i] = kp->in[i];
    r.out = kp->out; r.ws = kp->ws; r.lo = kp->lo; r.hi = kp->hi; return r; }
#else
__device__ __forceinline__ P load_params() { return P{}; }
#endif
__device__ __forceinline__ int fresh_tid(int wave_s) { asm volatile("" : "+s"(wave_s)); int ln = __builtin_amdgcn_mbcnt_hi(~0u, __builtin_amdgcn_mbcnt_lo(~0u, 0u)); asm volatile("" : "+v"(ln)); return wave_s * 64 + ln; }
#define PHASE_ENV() const P q = load_params(); int blk = blk0, G = G0; asm volatile("" : "+s"(blk), "+s"(G)); const int tid = fresh_tid(wave_s0), lane = tid & 63, wave = __builtin_amdgcn_readfirstlane(tid >> 6); (void)lane; (void)wave

constexpr int PH_PER_LAYER = 12, N_PHASES = 2 + NL * PH_PER_LAYER + 1;
__global__ void __launch_bounds__(NTHREADS, 2) enc_fwd(P p) {
    extern __shared__ __attribute__((aligned(16))) unsigned char lds[];
    const int blk0 = blockIdx.x, G0 = gridDim.x, wave_s0 = __builtin_amdgcn_readfirstlane(threadIdx.x >> 6);
    LAS unsigned char* ldsl = (LAS unsigned char*)lds;
    volatile LAS unsigned* MISC = (volatile LAS unsigned*)(ldsl + LDS_MISC);
    LAS int* moe_pre = (LAS int*)(ldsl + LDS_MISC - 256); LAS int* moe_cnt = (LAS int*)(ldsl + LDS_MISC - 512);
    if (threadIdx.x < 64) MISC[threadIdx.x] = 0u;
    __syncthreads();
#if MK_LAUNCH_PER_PHASE
#define GRID_BAR() do { } while (0)
#else
    XcdBarrier bar = xcd_barrier_post((unsigned*)(p.ws + O_CTL) + CW_BAR, MISC + 8);
#define GRID_BAR() xcd_barrier(bar)
#endif
    const int lo = p.lo, hi = p.hi;
#ifndef EN_MASK
#define EN_MASK 0xFFFFFFFFu
#endif
#define EN(j) ((EN_MASK >> (j)) & 1u)
#ifndef REP_MASK
#define REP_MASK 0u
#endif
#define PROBE_DUMMY(j) (((REP_MASK >> (j)) & 1u) && rep_ == 0)
#define REPS(j) for (int rep_ = 0; rep_ <= (int)((REP_MASK >> (j)) & 1u); ++rep_)
#define IN(k) (lo <= (k) && (k) < hi)
#define SEAM(k) do { if (IN((k) + 1)) { GRID_BAR(); if ((REP_MASK >> 14) & 1u) GRID_BAR(); } } while (0)
#define QWS(off, type) ((type*)(q.ws + (off)))

    if (EN(20) && IN(0)) REPS(20) {
        if (blk0 & 1) { { PHASE_ENV(); ph_s5ops(q, lds, tid, blk, G); } __syncthreads(); { PHASE_ENV(); ph_smallw(q, tid, blk, G); } { PHASE_ENV(); ph_mod(q, lds, tid, blk, G); } __syncthreads(); { PHASE_ENV(); ph_convert<false>(q, 0, lds, tid, blk, G, 0, 1 << 30); } }
        else { { PHASE_ENV(); ph_mod(q, lds, tid, blk, G); } { PHASE_ENV(); ph_convert<false>(q, 0, lds, tid, blk, G, 0, 1 << 30); } { PHASE_ENV(); ph_smallw(q, tid, blk, G); } __syncthreads(); { PHASE_ENV(); ph_s5ops(q, lds, tid, blk, G); } }
        SEAM(0); }
    if (EN(22) && IN(1)) REPS(22) {
        if (blk0 & 1) { { PHASE_ENV(); ph_combine_norm(q, -1, 0, lane, wave, blk, G, QWS(O_XR, bf16_t)); } { PHASE_ENV(); ph_s5fill(q, tid, blk, G, 0, G == 256 ? 1 : NL); } }
        else { { PHASE_ENV(); ph_s5fill(q, tid, blk, G, 0, G == 256 ? 1 : NL); } { PHASE_ENV(); ph_combine_norm(q, -1, 0, lane, wave, blk, G, QWS(O_XR, bf16_t)); } }
        SEAM(1); }

#pragma unroll 1
    for (int l = 0; l < NL; ++l) {
        const int pb = 2 + l * PH_PER_LAYER;
        if (l > 0 && EN(0) && IN(pb + 0)) REPS(0) { PHASE_ENV(); ph_combine_norm(q, l - 1, l, lane, wave, blk, G, PROBE_DUMMY(0) ? QWS(O_HH, bf16_t) : QWS(O_XR, bf16_t)); SEAM(pb + 0); }
        if (EN(1) && IN(pb + 1)) REPS(1) { PHASE_ENV();
            pg8::GridOrder S; S.init(QWS(O_H1, bf16_t), 1024, QWS(O_WIN, bf16_t) + (size_t)l * 3072 * 1024, 1024, T, NPROJ, G, blk, 0);
            EpiBf16T<false> E{QWS(O_PROJ, bf16_t), NPROJ, nullptr, NPROJ, 0};
            pg8::gemm_phase(ldsl, 1024, 1024, 1024, S, E, tid);
            SEAM(pb + 1);
        }
        if (EN(2) && IN(pb + 2)) REPS(2) { PHASE_ENV(); ph_prepass(q, l, lane, wave, blk, G); SEAM(pb + 2); }
        if (EN(3) && IN(pb + 3)) REPS(3) {
            { PHASE_ENV(); pg8::GridOrder S; S.init(QWS(O_ZS, bf16_t), 384, QWS(O_W1C, bf16_t) + (size_t)l * 512 * 384, 384, T, 512, G, blk, 0);
              EpiLvl1 E{QWS(O_HID, bf16_t)};
              pg8::gemm_phase(ldsl, 384, 384, 384, S, E, tid); }
            { PHASE_ENV(); S5SOrder S{(const char*)QWS(O_AS5, bf16_t), (const char*)(QWS(O_WS5S, bf16_t) + (size_t)l * 16 * 256 * 1024), G, (blk - 128 + G) % G};
              EpiF32 E{QWS(O_SLOC, float), 256};
              pg8::gemm_phase(ldsl, 1024, 1280, 1024, S, E, tid); }
            { PHASE_ENV(); if (G == 256 && blk >= 144) ph_convert<true>(q, l, lds, tid, blk - 144, 112, 0, CONV_EARLY); }
            SEAM(pb + 3);
        }
        if (EN(4) && IN(pb + 4)) REPS(4) {
            { PHASE_ENV(); pg8::GridOrder S; S.init(QWS(O_HID, bf16_t), 384, QWS(O_W2B, bf16_t) + (size_t)l * 2048 * 384, 384, T, 2048, G, blk, 0);
              EpiLvl2 E{q.in[18] + l * 768, q.in[21] + l * 768, q.in[27] + l * 384, q.ws};
              pg8::gemm_phase(ldsl, 384, 384, 384, S, E, tid); }
            { PHASE_ENV(); ph_s5carry(q, l, tid, blk); }
            SEAM(pb + 4);
        }
        if (EN(5) && IN(pb + 5)) REPS(5) {
            { PHASE_ENV(); S5YOrder S{(const char*)QWS(O_AS5, bf16_t), (const char*)(QWS(O_WS5Y, bf16_t) + (size_t)l * 16 * 1024 * 1280), G, blk};
              EpiS5Y E{QWS(O_YG, bf16_t)};
              pg8::gemm_phase(ldsl, 1280, 1280, 1280, S, E, tid); }
            { PHASE_ENV(); if (G > 64) { if (blk >= 64) ph_na(q, l, lds, tid, lane, wave, blk - 64, G - 64); } else ph_na(q, l, lds, tid, lane, wave, blk, G); }
            { PHASE_ENV(); if (G == 256) { if (blk < 64) ph_x1(q, lds, tid, lane, wave, blk, 64, 0, 896); else ph_x1(q, lds, tid, lane, wave, blk - 64, 192, 896, 3072); } else ph_x1(q, lds, tid, lane, wave, blk, G, 0, 3072); }
            SEAM(pb + 5);
        }
        if (EN(6) && IN(pb + 6)) REPS(6) {
            { PHASE_ENV(); ph_x2a(q, ldsl, tid, lane, wave, blk); }
            { PHASE_ENV(); pg8::GridOrder S; S.init(QWS(O_YG, bf16_t), 256, QWS(O_WGLU, bf16_t) + (size_t)l * 65536, 256, T, 256, G, blk, 192 % G);
              EpiGlu E{QWS(O_YG, bf16_t), QWS(O_MIX, bf16_t)};
              pg8::gemm_phase(ldsl, 256, 256, 256, S, E, tid); }
            { PHASE_ENV();
              if (G == 256) { constexpr int t0 = CONV_EARLY, rr = 6144 - t0, ta = t0 + (336 * rr) / 6144, tb = t0 + (1936 * rr) / 6144;
                  if (blk < 48) ph_convert<true>(q, l, lds, tid, blk, 48, t0, ta); else if (blk >= 192) ph_convert<true>(q, l, lds, tid, blk - 192, 64, ta, tb); else ph_convert<true>(q, l, lds, tid, blk - 48, 144, tb, 6144); }
              else if (G > 48) { if (blk >= 48) ph_convert<true>(q, l, lds, tid, blk - 48, G - 48, 480, 6144); else ph_convert<true>(q, l, lds, tid, blk, 48, 0, 480); } else ph_convert<true>(q, l, lds, tid, blk, G, 0, 6144); }
            SEAM(pb + 6);
        }
        if (EN(7) && IN(pb + 7)) REPS(7) { PHASE_ENV(); ph_x2b_post(q, l, ldsl, lane, wave, blk, G); SEAM(pb + 7); }
        if (EN(8) && IN(pb + 8)) REPS(8) { PHASE_ENV();
            pg8::GridOrder S; S.init(QWS(O_MIX, bf16_t), 1024, QWS(O_WOUT, bf16_t) + (size_t)l * 1024 * 1024, 1024, T, 1024, G, blk, 0);
            EpiWout E{PROBE_DUMMY(8) ? QWS(O_HH, bf16_t) : QWS(O_XR, bf16_t), QWS(O_MOD, float) + (size_t)(l * 4) * 6144 + 2048};
            pg8::gemm_phase(ldsl, 1024, 1024, 1024, S, E, tid);
            SEAM(pb + 8);
        }
        if (EN(9) && IN(pb + 9)) REPS(9) { PHASE_ENV(); ph_router(q, l, lds, tid, lane, wave, blk, G, PROBE_DUMMY(9) ? 32 : 0); SEAM(pb + 9); }
        if ((EN(10) && IN(pb + 10)) || (EN(11) && IN(pb + 11))) {
            PHASE_ENV();
            if (tid < 32) moe_cnt[tid] = (int)__hip_atomic_load(QWS(O_CTL, unsigned) + CW_CNT + l * 64 + tid, __ATOMIC_RELAXED, __HIP_MEMORY_SCOPE_AGENT);
            __syncthreads();
            if (tid == 0) { int run = 0; for (int e = 0; e < 32; ++e) { moe_pre[e] = run; run += (moe_cnt[e] + 255) >> 8; } moe_pre[32] = run; }
            __syncthreads();
        }
        if (EN(10) && IN(pb + 10)) REPS(10) { PHASE_ENV();
            LAS unsigned* tokl = (LAS unsigned*)(ldsl + LDS_X);
            MoeOrderT<true> S{moe_pre, (const char*)QWS(O_XS, bf16_t), (const char*)(QWS(O_EW1, bf16_t) + (size_t)l * NE * 2048 * 1024), G, blk, 8, (size_t)256 * 1024 * 2, tokl};
            { const int* TOKT = QWS(O_YS, int);
              int tv_[MOE_NTAB / 2]; bool ok_[MOE_NTAB / 2];
#pragma unroll
              for (int k_ = 0; k_ < MOE_NTAB / 2; ++k_) { const int idx = k_ * NTHREADS + tid, ui_ = idx >> 8, r_ = idx & 255; Unit u_; const bool has_ = S.next(ui_, u_);
                  const int orow_ = has_ ? u_.orow : 0, e_ = has_ ? u_.aux : 0; ok_[k_] = has_ && ((orow_ & (CAP - 1)) + r_ < moe_cnt[e_]); tv_[k_] = TOKT[ok_[k_] ? orow_ + r_ : 0]; }
#pragma unroll
              for (int k_ = 0; k_ < MOE_NTAB / 2; ++k_) tokl[k_ * NTHREADS + tid] = ok_[k_] ? (unsigned)tv_[k_] * 2048u : 0u;
              __syncthreads(); }
            EpiSwiglu E{QWS(O_HH, bf16_t), q.in[37] + (size_t)l * NE * 2048};
            pg8::gemm_phase(ldsl, 1024, 1024, 1024, S, E, tid);
            if (G == 256 && l + 1 < NL && rep_ == 0) { PHASE_ENV(); const int nrb = moe_pre[32], rem_rb = nrb & 31, nshort = (32 - rem_rb) * 8; const int q_ = (blk & 7) * 4 + ((blk >> 3) & 3);
                if (rem_rb == 0 || nshort < 64) ph_s5fill(q, tid, blk, G, l + 1, l + 2);
                else if (q_ >= rem_rb) ph_s5fill(q, tid, (q_ - rem_rb) * 8 + (blk >> 5), nshort, l + 1, l + 2); }
            SEAM(pb + 10);
        }
        if (EN(11) && IN(pb + 11)) REPS(11) { PHASE_ENV();
            MoeOrderT<false> S{moe_pre, (const char*)QWS(O_HH, bf16_t), (const char*)(QWS(O_EW2, bf16_t) + (size_t)l * NE * 1024 * 1024), G, blk, 4, (size_t)256 * 1024 * 2, nullptr};
            EpiBf16T<true> E{QWS(O_XS, bf16_t), 1024, q.in[39] + (size_t)l * NE * 1024, 1024, 1024};
            pg8::gemm_phase(ldsl, 1024, 1024, 1024, S, E, tid);
            SEAM(pb + 11);
        }
    }
    if (EN(21) && IN(N_PHASES - 1)) { PHASE_ENV(); ph_combine_norm(q, NL - 1, NL, lane, wave, blk, G, nullptr); }
}

extern "C" void kernel_launch(void* const* d_in, const int* in_sizes, int n_in, void* d_out, int out_size, void* d_ws, size_t ws_size, hipStream_t stream) {
    static int grid = 0;
    if (grid == 0) {
        if (n_in != 40 || out_size != T * D || ws_size < WS_END) { fprintf(stderr, "kernel_launch: unexpected shapes (n_in %d out %d ws %zu)\n", n_in, out_size, ws_size); grid = -1; return; }
        int dev = 0, cus = 0, per_cu = 0;
        if (hipGetDevice(&dev) != hipSuccess || hipDeviceGetAttribute(&cus, hipDeviceAttributeMultiprocessorCount, dev) != hipSuccess) { grid = -1; return; }
        if (hipFuncSetAttribute((const void*)enc_fwd, hipFuncAttributeMaxDynamicSharedMemorySize, LDS_BYTES) != hipSuccess) { fprintf(stderr, "kernel_launch: hipFuncSetAttribute failed\n"); grid = -1; return; }
        if (hipOccupancyMaxActiveBlocksPerMultiprocessor(&per_cu, (const void*)enc_fwd, NTHREADS, LDS_BYTES) != hipSuccess || per_cu < 1) fprintf(stderr, "kernel_launch: occupancy query reports %d\n", per_cu);
        (void)hipGetLastError();
        if (cus * MOE_NTAB < 2304) { fprintf(stderr, "kernel_launch: %d CUs: too few for the expert GEMM's row-offset table\n", cus); grid = -1; return; }
        grid = cus;
    }
    if (grid < 0) return;
    (void)hipMemsetAsync((char*)d_ws + O_CTL, 0, CTL_BYTES, stream);
    P a{};
    for (int i = 0; i < 40; ++i) a.in[i] = (const float*)d_in[i];
    a.out = (float*)d_out; a.ws = (unsigned char*)d_ws;
#if MK_LAUNCH_PER_PHASE
    for (int ph = 0; ph < N_PHASES; ++ph) { a.lo = ph; a.hi = ph + 1; hipLaunchKernelGGL(enc_fwd, dim3(grid), dim3(NTHREADS), LDS_BYTES, stream, a); }
#else
    a.lo = 0; a.hi = N_PHASES;
    hipLaunchKernelGGL(enc_fwd, dim3(grid), dim3(NTHREADS), LDS_BYTES, stream, a);
#endif
}
```
